# Optimizing an MI355X kernel written in HIP

```python
import jax, jax.numpy as jnp
from jax import lax
import numpy as np

D_MODEL = 2048
BATCH = 2
SEQ = 4096
DEPTH = 2
DEC_BATCH = 8
DEC_SEQ = 4096
PAST_LEN = 128

D_FF = 5632
NORM_EPS = 1e-6

ATT_GROUPS = ((128, 1), (512, 4), (2048, 16))
N_ATT_GROUPS = 3
ATT_HEADS = 4
ATT_HEAD_DIM = 128
ATT_OUT_WIDTH = ATT_HEADS * ATT_HEAD_DIM
ATT_QKV_WIDTH = N_ATT_GROUPS * ATT_OUT_WIDTH

RET_HEADS = 4
RET_DK = 128
RET_DV = 256
RET_CHUNK = 128
RET_QK_WIDTH = RET_HEADS * RET_DK
RET_V_WIDTH = RET_HEADS * RET_DV
RET_NORM_EPS = 1e-5

RWKV_HEADS = 8
RWKV_N = 64
RWKV_WIDTH = RWKV_HEADS * RWKV_N
RWKV_DECAY_RANK = 64
RWKV_A_RANK = 64
RWKV_GATE_RANK = 128
RWKV_CONV = 3
RWKV_CONV_CH = 3 * RWKV_WIDTH + 2 * RWKV_DECAY_RANK + 2 * RWKV_A_RANK + RWKV_GATE_RANK
RWKV_NORM_EPS = 64e-5

N_BRANCH = 3
IN_SPLITS = (ATT_QKV_WIDTH, ATT_QKV_WIDTH, ATT_QKV_WIDTH, RET_QK_WIDTH, RET_QK_WIDTH, RET_V_WIDTH, RET_V_WIDTH, RWKV_CONV_CH, N_BRANCH * D_MODEL)
D_IN = 15744

kernel_name = 'hybrid_bidir_dilated_retention_rwkv7_encoder'


def _offsets(sizes):
    out, acc = [], 0
    for n in sizes[:-1]:
        acc += n
        out.append(acc)
    return out


def _rms_norm(x, gain):
    x32 = x.astype(jnp.float32)
    y = x32 * lax.rsqrt(jnp.mean(x32 * x32, axis=-1, keepdims=True) + NORM_EPS)
    return (y * gain.astype(jnp.float32)).astype(x.dtype)


def _head_norm(y, gain, eps):
    mu = jnp.mean(y, axis=-1, keepdims=True)
    var = jnp.mean(jnp.square(y - mu), axis=-1, keepdims=True)
    return (y - mu) * lax.rsqrt(var + eps) * gain.astype(jnp.float32)


def _swiglu(x, w_gate, w_up, w_down):
    return (jax.nn.silu(x @ w_gate) * (x @ w_up)) @ w_down


def _alibi_slopes():
    n = N_ATT_GROUPS * ATT_HEADS
    return jnp.asarray(np.power(np.float32(2.0), -8.0 * np.arange(1, n + 1, dtype=np.float32) / n), jnp.float32)


def _dilated_group_attention(q, k, v, window, dilation, slopes):
    b, s, h, dh = q.shape
    half = window // (2 * dilation)
    blk = half
    sub_len = s // dilation
    nb = -(-sub_len // blk)
    lp = nb * blk

    def to_phase(t):
        t = t.reshape(b, sub_len, dilation, h, dh).transpose(0, 2, 1, 3, 4)
        t = jnp.pad(t, ((0, 0), (0, 0), (0, lp - sub_len), (0, 0), (0, 0)))
        return t.reshape(b, dilation, nb, blk, h, dh)

    def band(t):
        tp = jnp.pad(t, ((0, 0), (0, 0), (1, 1), (0, 0), (0, 0), (0, 0)))
        return jnp.concatenate([tp[:, :, :-2], tp[:, :, 1:-1], tp[:, :, 2:]], axis=3)

    qb = to_phase(q)
    kband = band(to_phase(k))
    vband = band(to_phase(v))
    scores = jnp.einsum('bpnqhd,bpnkhd->bpnhqk', qb, kband, preferred_element_type=jnp.float32) * (dh ** -0.5)
    qi = jnp.arange(blk)[:, None]
    kj = jnp.arange(3 * blk)[None, :]
    rel = kj - blk - qi
    key_idx = jnp.arange(nb)[:, None, None] * blk + (kj - blk)[None]
    valid = (jnp.abs(rel)[None] <= half) & (key_idx >= 0) & (key_idx < sub_len)
    dist = (dilation * jnp.abs(rel)).astype(jnp.float32)
    bias = -slopes[:, None, None] * dist[None]
    scores = jnp.where(valid[None, None, :, None], scores + bias[None, None, None], -jnp.inf)
    lse = jax.nn.logsumexp(scores, axis=-1)
    probs = jnp.exp(scores - lse[..., None])
    out = jnp.einsum('bpnhqk,bpnkhd->bpnqhd', probs.astype(v.dtype), vband, preferred_element_type=jnp.float32)

    def from_phase(t):
        t = t.reshape((b, dilation, lp) + t.shape[4:])[:, :, :sub_len]
        t = jnp.swapaxes(t, 1, 2)
        return t.reshape((b, s) + t.shape[3:])

    return from_phase(out), from_phase(jnp.swapaxes(lse, 3, 4))


def _dilated_attention(q, k, v):
    slopes = _alibi_slopes()
    outs, lses = [], []
    for g, (window, dilation) in enumerate(ATT_GROUPS):
        o, l = _dilated_group_attention(q[:, :, g], k[:, :, g], v[:, :, g], window, dilation, slopes[g * ATT_HEADS:(g + 1) * ATT_HEADS])
        outs.append(o)
        lses.append(l)
    weights = jax.nn.softmax(jnp.stack(lses, axis=0), axis=0)
    return jnp.einsum('gbsh,gbshd->bshd', weights, jnp.stack(outs, axis=0))


def _retention(q, k, v, decay_logit):
    b, s, h, dk = q.shape
    dv = v.shape[-1]
    c = RET_CHUNK
    nc = s // c
    f32 = jnp.float32

    def both(t):
        t = t.astype(f32)
        return jnp.stack([t, t[:, ::-1]], axis=0).reshape(2, b, nc, c, h, t.shape[-1])

    qd, kd, vd = both(q), both(k * (dk ** -0.5)), both(v)
    log_g = jax.nn.log_sigmoid(decay_logit.astype(f32))
    pos = jnp.arange(c, dtype=f32)
    diff = pos[:, None] - pos[None, :]
    dmat = jnp.where(diff >= 0, jnp.exp(jnp.maximum(diff, 0.0)[None, None] * log_g[:, :, None, None]), 0.0)
    scores = jnp.einsum('zbnihd,zbnjhd->zbnhij', qd, kd) * dmat[:, None, None]
    inner = jnp.einsum('zbnhij,zbnjhe->zbnihe', scores, vd)
    zeta = jnp.exp((c - 1 - pos)[None, :, None] * log_g[:, None, :])
    xi = jnp.exp((pos + 1)[None, :, None] * log_g[:, None, :])
    chunk_kv = jnp.einsum('zbnjhd,zbnjhe,zjh->nzbhde', kd, vd, zeta)
    g_chunk = jnp.exp(c * log_g)[:, None, :, None, None]

    def step(state, kv):
        return g_chunk * state + kv, state

    _, prev = lax.scan(step, jnp.zeros((2, b, h, dk, dv), f32), chunk_kv)
    cross = jnp.einsum('zbnihd,nzbhde->zbnihe', qd, prev) * xi[:, None, None, :, :, None]
    ret = (inner + cross).reshape(2, b, s, h, dv)
    return ret[0] + ret[1][:, ::-1]


def _rwkv7(feats, p):
    b, s, _ = feats.shape
    f32 = jnp.float32
    dtype = feats.dtype
    feats = lax.conv_general_dilated(feats, p['rwkv_conv'][:, None, :].astype(dtype), window_strides=(1,), padding=((RWKV_CONV // 2, RWKV_CONV // 2),), dimension_numbers=('NWC', 'WIO', 'NWC'), feature_group_count=RWKV_CONV_CH)
    r, k, v, w_lo, a_lo, g_lo = jnp.split(feats, _offsets((RWKV_WIDTH, RWKV_WIDTH, RWKV_WIDTH, 2 * RWKV_DECAY_RANK, 2 * RWKV_A_RANK, RWKV_GATE_RANK)), axis=-1)
    w_lo = w_lo.reshape(b, s, 2, RWKV_DECAY_RANK).astype(f32)
    a_lo = a_lo.reshape(b, s, 2, RWKV_A_RANK).astype(f32)
    logw = -jax.nn.softplus(-(p['rwkv_w0'].astype(f32) + jnp.einsum('bszr,zrc->bszc', jnp.tanh(w_lo), p['rwkv_w2'].astype(f32)))) - 0.5
    decay = jnp.exp(-jnp.exp(logw))
    a = jax.nn.sigmoid(p['rwkv_a0'].astype(f32) + jnp.einsum('bszr,zrc->bszc', a_lo, p['rwkv_a2'].astype(f32)))
    g = jax.nn.sigmoid(g_lo.astype(f32)) @ p['rwkv_g2'].astype(f32)

    def heads(t):
        return t.reshape(t.shape[:-1] + (RWKV_HEADS, RWKV_N))

    k32 = k.astype(f32)
    kk = heads(k32 * p['rwkv_k_k'].astype(f32))
    kk = kk * lax.rsqrt(jnp.sum(kk * kk, axis=-1, keepdims=True) + 1e-12)
    k_dir = heads(k32[:, :, None, :] * (1.0 + (a - 1.0) * p['rwkv_k_a'].astype(f32)))
    r_h = heads(r.astype(f32))
    v_h = heads(v.astype(f32))

    def per_dir(t):
        t = jnp.transpose(t, (1, 2, 0, 3, 4))
        return jnp.stack([t[:, 0], t[::-1, 1]], axis=1)

    def shared(t):
        t = jnp.swapaxes(t, 0, 1)
        return jnp.stack([t, t[::-1]], axis=1)

    xs = (per_dir(heads(decay)), per_dir(k_dir), shared(v_h), shared(r_h), shared(kk), per_dir(heads(a)))

    def step(state, inp):
        w_t, k_t, v_t, r_t, kk_t, a_t = inp
        sa = jnp.einsum('zbhvk,zbhk->zbhv', state, -kk_t)
        state = state * w_t[..., None, :] + sa[..., :, None] * (kk_t * a_t)[..., None, :] + v_t[..., :, None] * k_t[..., None, :]
        return state, jnp.einsum('zbhvk,zbhk->zbhv', state, r_t)

    _, ys = lax.scan(step, jnp.zeros((2, b, RWKV_HEADS, RWKV_N, RWKV_N), f32), xs)
    y = jnp.swapaxes(ys[:, 0] + ys[::-1, 1], 0, 1)
    y = _head_norm(y, heads(p['rwkv_ln_w']), RWKV_NORM_EPS) + heads(p['rwkv_ln_b'].astype(f32))
    bonus = jnp.sum(r_h[:, :, None] * k_dir * p['rwkv_r_k'].astype(f32), axis=-1, keepdims=True)
    y = y + jnp.sum(bonus, axis=2) * v_h
    return (y.reshape(b, s, RWKV_WIDTH) * g).astype(dtype)


def _encoder_layer(x, p):
    b, s, _ = x.shape
    f32 = jnp.float32
    x = x + 0.5 * _swiglu(_rms_norm(x, p['ffn1_norm']), p['ffn1_w_gate'], p['ffn1_w_up'], p['ffn1_w_down'])
    u = _rms_norm(x, p['mix_norm'])
    proj = u @ p['w_in']
    aq, ak, av, rq, rk, rv, rg, cfeat, gate_logits = jnp.split(proj, _offsets(IN_SPLITS), axis=-1)
    att_shape = (b, s, N_ATT_GROUPS, ATT_HEADS, ATT_HEAD_DIM)
    y_a = _dilated_attention(aq.reshape(att_shape), ak.reshape(att_shape), av.reshape(att_shape))
    y_a = y_a.reshape(b, s, ATT_OUT_WIDTH).astype(x.dtype)
    ret = _retention(rq.reshape(b, s, RET_HEADS, RET_DK), rk.reshape(b, s, RET_HEADS, RET_DK), rv.reshape(b, s, RET_HEADS, RET_DV), p['ret_decay_logit'])
    y_b = (jax.nn.silu(rg.astype(f32)) * _head_norm(ret, p['ret_norm'], RET_NORM_EPS).reshape(b, s, RET_V_WIDTH)).astype(x.dtype)
    y_c = _rwkv7(cfeat, p)
    gates = jax.nn.sigmoid(gate_logits.reshape(b, s, N_BRANCH, D_MODEL))
    merged = (gates[:, :, 0] * (y_a @ p['w_branch_a']) + gates[:, :, 1] * (y_b @ p['w_branch_b']) + gates[:, :, 2] * (y_c @ p['w_branch_c']))
    x = x + merged @ p['w_out']
    x = x + 0.5 * _swiglu(_rms_norm(x, p['ffn2_norm']), p['ffn2_w_gate'], p['ffn2_w_up'], p['ffn2_w_down'])
    return x


def setup_inputs(seed: int = 0) -> dict:
    key = jax.random.key(seed)
    ks = iter(jax.random.split(key, 40))
    f32 = jnp.float32

    def nrm(shape, scale):
        return scale * jax.random.normal(next(ks), shape, f32)

    def gain(shape):
        return 1.0 + 0.02 * jax.random.normal(next(ks), shape, f32)

    ret_base = jnp.log(jnp.power(2.0, 5.0 + jnp.arange(RET_HEADS, dtype=f32)) - 1.0)
    conv_base = jnp.array([0.25, 0.5, 0.25], f32)[None, :, None]
    return {
        'x_prompt': nrm((BATCH, SEQ, D_MODEL), 1.0),
        'x_sample': nrm((DEC_BATCH, DEC_SEQ, D_MODEL), 1.0),
        'ffn1_norm': gain((DEPTH, D_MODEL)),
        'ffn1_w_gate': nrm((DEPTH, D_MODEL, D_FF), D_MODEL ** -0.5),
        'ffn1_w_up': nrm((DEPTH, D_MODEL, D_FF), D_MODEL ** -0.5),
        'ffn1_w_down': nrm((DEPTH, D_FF, D_MODEL), D_FF ** -0.5),
        'mix_norm': gain((DEPTH, D_MODEL)),
        'w_in': nrm((DEPTH, D_MODEL, D_IN), D_MODEL ** -0.5),
        'ret_decay_logit': ret_base[None, None, :] + nrm((DEPTH, 2, RET_HEADS), 0.1),
        'ret_norm': gain((DEPTH, RET_HEADS, RET_DV)),
        'rwkv_conv': conv_base + nrm((DEPTH, RWKV_CONV, RWKV_CONV_CH), 0.05),
        'rwkv_w0': jax.random.uniform(next(ks), (DEPTH, 2, RWKV_WIDTH), f32, -6.0, -1.0),
        'rwkv_w2': nrm((DEPTH, 2, RWKV_DECAY_RANK, RWKV_WIDTH), 0.1 * RWKV_DECAY_RANK ** -0.5),
        'rwkv_a0': nrm((DEPTH, 2, RWKV_WIDTH), 0.1),
        'rwkv_a2': nrm((DEPTH, 2, RWKV_A_RANK, RWKV_WIDTH), 0.1 * RWKV_A_RANK ** -0.5),
        'rwkv_g2': nrm((DEPTH, RWKV_GATE_RANK, RWKV_WIDTH), RWKV_GATE_RANK ** -0.5),
        'rwkv_k_k': 0.85 + nrm((DEPTH, RWKV_WIDTH), 0.05),
        'rwkv_k_a': 1.0 + nrm((DEPTH, RWKV_WIDTH), 0.05),
        'rwkv_r_k': nrm((DEPTH, RWKV_HEADS, RWKV_N), 0.1),
        'rwkv_ln_w': gain((DEPTH, RWKV_WIDTH)),
        'rwkv_ln_b': nrm((DEPTH, RWKV_WIDTH), 0.02),
        'w_branch_a': nrm((DEPTH, ATT_OUT_WIDTH, D_MODEL), ATT_OUT_WIDTH ** -0.5),
        'w_branch_b': nrm((DEPTH, RET_V_WIDTH, D_MODEL), RET_V_WIDTH ** -0.5),
        'w_branch_c': nrm((DEPTH, RWKV_WIDTH, D_MODEL), RWKV_WIDTH ** -0.5),
        'w_out': nrm((DEPTH, D_MODEL, D_MODEL), D_MODEL ** -0.5),
        'ffn2_norm': gain((DEPTH, D_MODEL)),
        'ffn2_w_gate': nrm((DEPTH, D_MODEL, D_FF), D_MODEL ** -0.5),
        'ffn2_w_up': nrm((DEPTH, D_MODEL, D_FF), D_MODEL ** -0.5),
        'ffn2_w_down': nrm((DEPTH, D_FF, D_MODEL), D_FF ** -0.5),
        'final_norm': gain((D_MODEL,)),
    }


def reference(x_prompt, x_sample, ffn1_norm, ffn1_w_gate, ffn1_w_up, ffn1_w_down, mix_norm, w_in, ret_decay_logit, ret_norm, rwkv_conv, rwkv_w0, rwkv_w2, rwkv_a0, rwkv_a2, rwkv_g2, rwkv_k_k, rwkv_k_a, rwkv_r_k, rwkv_ln_w, rwkv_ln_b, w_branch_a, w_branch_b, w_branch_c, w_out, ffn2_norm, ffn2_w_gate, ffn2_w_up, ffn2_w_down, final_norm):
    def run(x):
        for l in range(DEPTH):
            p = {
                'ffn1_norm': ffn1_norm[l], 'ffn1_w_gate': ffn1_w_gate[l], 'ffn1_w_up': ffn1_w_up[l], 'ffn1_w_down': ffn1_w_down[l],
                'mix_norm': mix_norm[l], 'w_in': w_in[l],
                'ret_decay_logit': ret_decay_logit[l], 'ret_norm': ret_norm[l],
                'rwkv_conv': rwkv_conv[l], 'rwkv_w0': rwkv_w0[l], 'rwkv_w2': rwkv_w2[l], 'rwkv_a0': rwkv_a0[l], 'rwkv_a2': rwkv_a2[l],
                'rwkv_g2': rwkv_g2[l], 'rwkv_k_k': rwkv_k_k[l], 'rwkv_k_a': rwkv_k_a[l], 'rwkv_r_k': rwkv_r_k[l],
                'rwkv_ln_w': rwkv_ln_w[l], 'rwkv_ln_b': rwkv_ln_b[l],
                'w_branch_a': w_branch_a[l], 'w_branch_b': w_branch_b[l], 'w_branch_c': w_branch_c[l], 'w_out': w_out[l],
                'ffn2_norm': ffn2_norm[l], 'ffn2_w_gate': ffn2_w_gate[l], 'ffn2_w_up': ffn2_w_up[l], 'ffn2_w_down': ffn2_w_down[l],
            }
            x = _encoder_layer(x, p)
        return _rms_norm(x, final_norm)

    y_prompt = run(x_prompt)
    y_sample = run(x_sample)
    return (y_prompt, y_sample)
```

```cpp
#include <hip/hip_runtime.h>
#include <cstdio>
#include <cstdint>

#ifndef MK_PER_PHASE_LAUNCH
#define MK_PER_PHASE_LAUNCH 0
#endif
#ifndef MK_REP_SCAN
#define MK_REP_SCAN 1
#endif
#ifndef MK_REP_ATT
#define MK_REP_ATT 1
#endif
#ifndef MK_REP_RET
#define MK_REP_RET 1
#endif
#ifndef MK_REP_EW
#define MK_REP_EW 1
#endif
#ifndef MK_REP_UP
#define MK_REP_UP 1
#endif
#ifndef MK_PROBE_RESID
#define MK_PROBE_RESID 0
#endif
#ifndef MK_REP_PROJ
#define MK_REP_PROJ 1
#endif
#ifndef MK_REP_MG
#define MK_REP_MG 1
#endif
#ifndef MK_REP_DN
#define MK_REP_DN 1
#endif
#ifndef MK_REP_OUT
#define MK_REP_OUT 1
#endif
#ifndef MK_REPMASK
#define MK_REPMASK 0
#endif
#ifndef MK_FUSED_RWKV
#define MK_FUSED_RWKV 1
#endif
#ifndef MK_WGM_DN
#define MK_WGM_DN 4
#endif
#ifndef MK_CHUNKED
#define MK_CHUNKED 1
#endif
#ifndef MK_MIXER
#define MK_MIXER 7
#endif

constexpr int T = 40960, D = 2048, FF = 5632, SEQ = 4096, NSEQ = 10, DEPTH = 2;
constexpr int NWAVES = 8, NTHR = 512;

#define GAS __attribute__((address_space(1)))
#define LAS __attribute__((address_space(3)))
typedef unsigned short bf16;
typedef unsigned v4u __attribute__((ext_vector_type(4)));
typedef unsigned v2u __attribute__((ext_vector_type(2)));
typedef float f32x4 __attribute__((ext_vector_type(4)));
typedef float f32x2 __attribute__((ext_vector_type(2)));
typedef float f32x16 __attribute__((ext_vector_type(16)));
typedef short bf16x8 __attribute__((ext_vector_type(8)));
typedef _Float16 h2 __attribute__((ext_vector_type(2)));
typedef GAS unsigned gu32;
#define RLX_AGENT __ATOMIC_RELAXED, __HIP_MEMORY_SCOPE_AGENT
#define LDS_WAIT() asm volatile("s_waitcnt lgkmcnt(0)" ::: "memory")
#define VM_WAIT() asm volatile("s_waitcnt vmcnt(0)" ::: "memory")
typedef __bf16 bf16v2_t __attribute__((ext_vector_type(2)));
__device__ __forceinline__ unsigned cvt_pk_bf16(float lo, float hi) { f32x2 v = {lo, hi}; bf16v2_t r = __builtin_convertvector(v, bf16v2_t); return __builtin_bit_cast(unsigned, r); }
__device__ __forceinline__ unsigned f2bf(float f) { return cvt_pk_bf16(f, f) & 0xffffu; }
__device__ __forceinline__ unsigned pk2(float lo, float hi) { return cvt_pk_bf16(lo, hi); }
__device__ __forceinline__ unsigned pkh2(float lo, float hi) { h2 v; v.x = (_Float16)lo; v.y = (_Float16)hi; return __builtin_bit_cast(unsigned, v); }
__device__ __forceinline__ float bf_lo(unsigned w) { return __builtin_bit_cast(float, w << 16); }
__device__ __forceinline__ float bf_hi(unsigned w) { return __builtin_bit_cast(float, w & 0xffff0000u); }
__device__ __forceinline__ float h_lo(unsigned w) { h2 v = __builtin_bit_cast(h2, w); return (float)v.x; }
__device__ __forceinline__ float h_hi(unsigned w) { h2 v = __builtin_bit_cast(h2, w); return (float)v.y; }
__device__ __forceinline__ float h1(unsigned short w) { return (float)__builtin_bit_cast(_Float16, w); }
__device__ __forceinline__ float fexp(float x) { return __builtin_amdgcn_exp2f(x * 1.44269504089f); }
__device__ __forceinline__ float fsigmoid(float x) { return __builtin_amdgcn_rcpf(1.0f + fexp(-x)); }
__device__ __forceinline__ unsigned long long opaque_u64(unsigned long long p) {
    const unsigned lo = __builtin_amdgcn_readfirstlane((unsigned)p), hi = __builtin_amdgcn_readfirstlane((unsigned)(p >> 32)); unsigned lo2, hi2;
    asm volatile("s_mov_b32 %0, %2\n\ts_mov_b32 %1, %3" : "=&s"(lo2), "=&s"(hi2) : "s"(lo), "s"(hi));
    return ((unsigned long long)hi2 << 32) | lo2;
}
__device__ __forceinline__ int lane_id() { int l; asm volatile("v_mbcnt_lo_u32_b32 %0, -1, 0\n\tv_mbcnt_hi_u32_b32 %0, -1, %0" : "=v"(l)); return l; }
__device__ __forceinline__ float shfl_xor_(float v, int m) { return __builtin_bit_cast(float, __builtin_amdgcn_ds_bpermute((lane_id() ^ m) << 2, __builtin_bit_cast(int, v))); }
__device__ __forceinline__ unsigned long long ld_karg64(int off) {
    unsigned long long r;
    asm volatile("s_load_dwordx2 %0, %1, %2\n\ts_waitcnt lgkmcnt(0)" : "=s"(r) : "s"(__builtin_amdgcn_kernarg_segment_ptr()), "n"(off) : "memory");
    return r;
}
__device__ __forceinline__ float wave_sum(float v) {
#pragma unroll
    for (int o = 1; o < 64; o <<= 1) v += shfl_xor_(v, o);
    return v;
}

#define XB_TMO      128
#define XB_XCNT(j)  (256  + 64 * (j))
#define XB_XSUB(j)  (1280 + 64 * (j))
#define XB_XGEN(j)  (2304 + 64 * (j))
#define XB_TOP      3328
#define XB_TOPGEN   3392
#define XCD_BAR_WORDS 3456
#define XB_SPIN_CAP (1u << 22)

__device__ __forceinline__ unsigned xb_ld(unsigned* p)              { return __hip_atomic_load(p, __ATOMIC_RELAXED, __HIP_MEMORY_SCOPE_AGENT); }
__device__ __forceinline__ unsigned xb_add(unsigned* p, unsigned v) { return __hip_atomic_fetch_add(p, v, __ATOMIC_RELAXED, __HIP_MEMORY_SCOPE_AGENT); }
__device__ __forceinline__ unsigned xb_xcc_id() { return (unsigned)__builtin_amdgcn_s_getreg((3 << 11) | 20) & 0xFu; }
#define XB_SPIN(cond, bar) do { unsigned _sp = 0; while (cond) { __builtin_amdgcn_s_sleep(1); \
    if ((++_sp & 255u) == 0u) { if (xb_ld(&(bar)[XB_TMO])) break; if (_sp > XB_SPIN_CAP) { atomicAdd(&(bar)[XB_TMO], 1u); break; } } } } while (0)

struct XcdBarrier { unsigned* bar; unsigned x; volatile LAS unsigned* st; };
__device__ __forceinline__ XcdBarrier xcd_barrier_post(unsigned* bar, volatile LAS unsigned* st) {
    XcdBarrier b; b.bar = bar; b.x = xb_xcc_id(); b.st = st;
    if (threadIdx.x == 0) (void)xb_add(&bar[XB_XCNT(b.x)], 1u);
    return b;
}
__device__ __forceinline__ void xcd_barrier_complete(unsigned* bar, unsigned x, unsigned& nloc, unsigned& nx) {
    const unsigned G = gridDim.x * gridDim.y * gridDim.z;
    unsigned sum, cnt, mine, sp = 0u;
    for (;;) {
        sum = 0u; cnt = 0u; mine = 0u;
#pragma unroll
        for (unsigned j = 0; j < 16; ++j) { const unsigned c = xb_ld(&bar[XB_XCNT(j)]); sum += c; cnt += (c > 0u) ? 1u : 0u; mine = (j == x) ? c : mine; }
        if (sum == G) break;
        __builtin_amdgcn_s_sleep(1);
        if ((++sp & 255u) == 0u) { if (xb_ld(&bar[XB_TMO])) break; if (sp > XB_SPIN_CAP) { atomicAdd(&bar[XB_TMO], 1u); break; } }
    }
    nloc = mine > 0u ? mine : 1u; nx = cnt > 0u ? cnt : 1u;
}
__device__ __forceinline__ void xcd_barrier(const XcdBarrier& b, bool thread0) {
    asm volatile("s_waitcnt vmcnt(0)" ::: "memory");
    __syncthreads();
    if (thread0) {
        unsigned* bar = (unsigned*)opaque_u64((unsigned long long)b.bar); const unsigned bx = xb_xcc_id();
        __builtin_amdgcn_s_waitcnt(0);
        unsigned nloc = b.st[0], nx = b.st[1];
        if (nloc == 0u) { xcd_barrier_complete(bar, bx, nloc, nx); b.st[0] = nloc; b.st[1] = nx; }
        const unsigned old = xb_add(&bar[XB_XSUB(bx)], 1u);
        const unsigned gen = old / nloc;
        if (old + 1u == (gen + 1u) * nloc) {
            __builtin_amdgcn_fence(__ATOMIC_RELEASE, "agent");
            asm volatile("s_waitcnt vmcnt(0)" ::: "memory");
            const unsigned og = xb_add(&bar[XB_TOP], 1u);
            const unsigned tg = og / nx;
            if (og + 1u == (tg + 1u) * nx) xb_add(&bar[XB_TOPGEN], 1u);
            else XB_SPIN(xb_ld(&bar[XB_TOPGEN]) == tg, bar);
            __builtin_amdgcn_fence(__ATOMIC_ACQUIRE, "agent");
            xb_add(&bar[XB_XGEN(bx)], 1u);
            asm volatile("s_waitcnt vmcnt(0)" ::: "memory");
        } else {
            XB_SPIN(xb_ld(&bar[XB_XGEN(bx)]) == gen, bar);
            __builtin_amdgcn_fence(__ATOMIC_ACQUIRE, "agent");
            asm volatile("s_waitcnt vmcnt(0)" ::: "memory");
        }
    }
    __syncthreads();
}

namespace pg8 {
#define PG8_LAS __attribute__((address_space(3)))
constexpr int BM = 256, BK = 64, HALF = 128, HTB = HALF * BK * 2, STAGE_BYTES = 8 * HTB;
__host__ __device__ __forceinline__ int lds_byte(int r, int c) { const int st = (r >> 4) * 2 + (c >> 5), rr = r & 15, cc = c & 31, ob = rr * 64 + cc * 2; return st * 1024 + (ob ^ (((ob >> 9) & 1) << 5)); }
__host__ __device__ __forceinline__ void stage_rc(int b, int& R, int& C) { const int st = b / 1024, sb = b % 1024, swz = sb ^ (((sb >> 9) & 1) << 5); R = (st >> 1) * 16 + swz / 64; C = (st & 1) * 32 + (swz % 64) / 2; }
__host__ __device__ __forceinline__ int perm32(int rho) { const int n = rho >> 4, i = rho & 15; return 8 * (i >> 2) + 4 * n + (i & 3); }

struct UnitG { const char* A; const char* B; int lda, ldb, K; char* O; int ldo, kind, x0, x1; };

__device__ __forceinline__ void tile_map(int L, int nM, int nN, int& pm, int& pn, int wgm = 8) {
    const int nwg = nM * nN; int wgid = L;
    { const int q = nwg / 8, r = nwg % 8, xcd = wgid % 8, off = wgid / 8; wgid = (xcd < r ? xcd * (q + 1) : r * (q + 1) + (xcd - r) * q) + off; }
    const int nig = wgm * nN, gid = wgid / nig, fm = gid * wgm, gsz = (nM - fm) < wgm ? (nM - fm) : wgm;
    pm = fm + ((wgid % nig) % gsz); pn = (wgid % nig) / gsz;
}

template <class Epi, class Sched>
__device__ __forceinline__ void gemm_phase(PG8_LAS unsigned char* lds, const Sched& S, const Epi& E, int tid_in) {
    int tid_ = tid_in; asm volatile("" : "+v"(tid_));
    const int tid = tid_, wid = __builtin_amdgcn_readfirstlane(tid >> 6), lane = tid & 63, wr = wid >> 2, wc = wid & 3, fr = lane & 15, fq = lane >> 4;
    int sR, sC; stage_rc(tid * 16, sR, sC);
    const int sRb = Epi::PERM ? ((sR & ~31) + perm32(sR & 31)) : sR;
    const size_t kstep = (size_t)(BK * 2);
    const unsigned ldsw = (unsigned)wid * 1024u;
    const int aoff = lds_byte(wr * 64 + fr, fq * 8), boff = lds_byte(wc * 32 + fr, fq * 8);
#define PG8_SA(b, h) (((b) * 2 + (h)) * HTB)
#define PG8_SB(b, h) ((4 + (b) * 2 + (h)) * HTB)
#define PG8_STAGE(bufoff, gbase, voff, q64) do { _Pragma("unroll") for (int _i = 0; _i < 2; ++_i) \
        __builtin_amdgcn_global_load_lds((const unsigned*)((const char*)(gbase) + (size_t)_i * (q64) + (voff)), (PG8_LAS unsigned*)(lds + (bufoff) + ldsw + _i * 8192), 16, 0, 0); } while (0)
#define PG8_LDA(dst, b, h) do { _Pragma("unroll") for (int m = 0; m < 4; ++m) _Pragma("unroll") for (int k = 0; k < 2; ++k) dst[m][k] = *(const PG8_LAS bf16x8*)(lds + PG8_SA(b, h) + aoff + m * 2048 + k * 1024); } while (0)
#define PG8_LDB(dst, b, h) do { _Pragma("unroll") for (int n = 0; n < 2; ++n) _Pragma("unroll") for (int k = 0; k < 2; ++k) dst[n][k] = *(const PG8_LAS bf16x8*)(lds + PG8_SB(b, h) + boff + n * 2048 + k * 1024); } while (0)
#define PG8_MMA(ai, bj, At, Bt) do { __builtin_amdgcn_s_setprio(1); _Pragma("unroll") for (int m = 0; m < 4; ++m) _Pragma("unroll") for (int n = 0; n < 2; ++n) _Pragma("unroll") for (int k = 0; k < 2; ++k) \
        acc[ai][bj][m][n] = __builtin_amdgcn_mfma_f32_16x16x32_bf16(Bt[n][k], At[m][k], acc[ai][bj][m][n], 0, 0, 0); __builtin_amdgcn_s_setprio(0); } while (0)
#define PG8_WAIT_V(n) asm volatile("s_waitcnt vmcnt(" #n ")" ::: "memory")
#define PG8_WAIT_L(n) asm volatile("s_waitcnt lgkmcnt(" #n ")" ::: "memory")
#define PG8_WAIT_VP() asm volatile("s_waitcnt vmcnt(%0)" :: "n"(8 + Epi::NST) : "memory")
#define PG8_BAR __builtin_amdgcn_s_barrier()
#define PG8_SCHED __builtin_amdgcn_sched_barrier(0)
    UnitG cur, nxt; int ui = 0;
    if (!S.next(0, cur)) return;
    f32x4 acc[2][2][4][2];
#pragma unroll
    for (int a = 0; a < 2; ++a)
#pragma unroll
        for (int b = 0; b < 2; ++b)
#pragma unroll
            for (int m = 0; m < 4; ++m)
#pragma unroll
                for (int n = 0; n < 2; ++n) acc[a][b][m][n] = (f32x4){0.f, 0.f, 0.f, 0.f};
    bf16x8 At[4][2], B0[2][2], B1[2][2];
    const char* cA = cur.A; const char* cB = cur.B;
    unsigned vA = (unsigned)(sR * cur.lda + sC) * 2u, vB = (unsigned)(sRb * cur.ldb + sC) * 2u;
    unsigned qA = (unsigned)cur.lda * 128u, qB = (unsigned)cur.ldb * 128u;
#define hA (2u * qA)
#define hB (2u * qB)
    PG8_STAGE(PG8_SB(0, 0), cB, vB, qB); PG8_STAGE(PG8_SB(0, 1), cB + hB, vB, qB); PG8_STAGE(PG8_SA(0, 0), cA, vA, qA); PG8_STAGE(PG8_SA(0, 1), cA + hA, vA, qA);
    if (wr == 1) PG8_BAR;
    PG8_WAIT_V(2); PG8_BAR;
    PG8_STAGE(PG8_SB(1, 0), cB + kstep, vB, qB); PG8_STAGE(PG8_SA(1, 0), cA + kstep, vA, qA); PG8_STAGE(PG8_SB(1, 1), cB + hB + kstep, vB, qB);
    PG8_WAIT_V(0); PG8_BAR;
    for (;;) {
        const bool has_next = S.next(ui + 1, nxt);
        const char* nA = has_next ? nxt.A : cA; const char* nB = has_next ? nxt.B : cB;
        const int nlda = has_next ? nxt.lda : cur.lda, nldb = has_next ? nxt.ldb : cur.ldb;
        unsigned nvA, nvB; { int r2, c2; stage_rc((wid * 64 + lane_id()) * 16, r2, c2); const int rb2 = Epi::PERM ? ((r2 & ~31) + perm32(r2 & 31)) : r2;
            nvA = (unsigned)(r2 * nlda + c2) * 2u; nvB = (unsigned)(rb2 * nldb + c2) * 2u; }
        const unsigned nqA = (unsigned)nlda * 128u, nqB = (unsigned)nldb * 128u;
        const int nt = cur.K / BK;
#define PG8_KITER(WV) do { \
            const bool last = (t == nt - 2); \
            const char* a1 = cA + (size_t)(t + 1) * kstep; \
            const char* a2 = last ? nA : cA + (size_t)(t + 2) * kstep; const char* b2 = last ? nB : cB + (size_t)(t + 2) * kstep; \
            const char* a3 = a2 + kstep; const char* b3 = b2 + kstep; \
            const unsigned va2 = last ? nvA : vA, vb2 = last ? nvB : vB; \
            const unsigned qa2 = last ? nqA : qA, qb2 = last ? nqB : qB, ha2 = 2u * qa2, hb2 = 2u * qb2; \
              \
            PG8_LDB(B0, 0, 0); PG8_LDB(B1, 0, 1); PG8_SCHED; PG8_LDA(At, 0, 0); PG8_STAGE(PG8_SA(1, 1), a1 + hA, vA, qA); \
            WV; PG8_WAIT_L(0); PG8_BAR; PG8_MMA(0, 0, At, B0); PG8_MMA(0, 1, At, B1); PG8_BAR; PG8_SCHED; \
              \
            PG8_LDA(At, 0, 1); PG8_STAGE(PG8_SB(0, 0), b2, vb2, qb2); PG8_STAGE(PG8_SB(0, 1), b2 + hb2, vb2, qb2); PG8_STAGE(PG8_SA(0, 0), a2, va2, qa2); \
            WV; PG8_WAIT_L(0); PG8_BAR; PG8_MMA(1, 0, At, B0); PG8_MMA(1, 1, At, B1); PG8_BAR; PG8_SCHED; \
              \
            PG8_LDB(B0, 1, 0); PG8_LDB(B1, 1, 1); PG8_SCHED; PG8_LDA(At, 1, 0); PG8_STAGE(PG8_SA(0, 1), a2 + ha2, va2, qa2); \
            PG8_WAIT_V(8); PG8_WAIT_L(0); PG8_BAR; PG8_MMA(0, 0, At, B0); PG8_MMA(0, 1, At, B1); PG8_BAR; PG8_SCHED; \
              \
            PG8_LDA(At, 1, 1); PG8_STAGE(PG8_SB(1, 0), b3, vb2, qb2); PG8_STAGE(PG8_SB(1, 1), b3 + hb2, vb2, qb2); PG8_STAGE(PG8_SA(1, 0), a3, va2, qa2); \
            PG8_WAIT_V(8); PG8_WAIT_L(0); PG8_BAR; PG8_MMA(1, 0, At, B0); PG8_MMA(1, 1, At, B1); PG8_BAR; PG8_SCHED; } while (0)
        { const int t = 0; PG8_KITER(PG8_WAIT_VP()); }
        for (int t = 2; t < nt; t += 2) PG8_KITER(PG8_WAIT_V(8));
#undef PG8_KITER
        if (wr == 0) PG8_BAR;
        { const int l2 = lane_id(); int fr2 = l2 & 15, fq2 = l2 >> 4; asm volatile("" : "+v"(fr2), "+v"(fq2)); E(acc, cur, wr, wc, fr2, fq2); }
        if (!has_next) break;
#pragma unroll
        for (int a = 0; a < 2; ++a)
#pragma unroll
            for (int b = 0; b < 2; ++b)
#pragma unroll
                for (int m = 0; m < 4; ++m)
#pragma unroll
                    for (int n = 0; n < 2; ++n) acc[a][b][m][n] = (f32x4){0.f, 0.f, 0.f, 0.f};
        cA = nA; cB = nB; vA = nvA; vB = nvB; qA = nqA; qB = nqB; ++ui;
        { int u2 = ui; asm volatile("" : "+s"(u2)); (void)S.next(u2, cur); }
        if (wr == 1) PG8_BAR;
    }
    PG8_WAIT_V(0);
    PG8_BAR;
#undef hA
#undef hB
#undef PG8_SA
#undef PG8_SB
#undef PG8_STAGE
#undef PG8_LDA
#undef PG8_LDB
#undef PG8_MMA
#undef PG8_WAIT_V
#undef PG8_WAIT_VP
#undef PG8_WAIT_L
#undef PG8_BAR
#undef PG8_SCHED
}
}
using pg8::UnitG;

constexpr size_t MiB = 1u << 20;
constexpr size_t WS_CTL = 0, CTL_ZERO_BYTES = 1 * MiB;
constexpr size_t WS_WT = 2 * MiB;
constexpr size_t WO_UP1 = 0, WO_DN1 = 44 * MiB, WO_UP2 = 66 * MiB, WO_DN2 = 110 * MiB, WO_ATT = 132 * MiB, WO_RET = 150 * MiB, WO_CF = 162 * MiB,
                 WO_GATE = 170 * MiB, WO_BA = 194 * MiB, WO_BB = 196 * MiB, WO_BC = 200 * MiB, WO_OUT = 202 * MiB, WO_LR = 210 * MiB, WT_BYTES = 212 * MiB;
constexpr size_t WS_XN = WS_WT + WT_BYTES;
constexpr size_t WS_AR = WS_XN + 160 * MiB;
constexpr size_t AR_YC = 0, AR_YA = 40 * MiB, AR_YB = 80 * MiB;
constexpr int FFN_MC = 40960, FFN_NCK = (T + FFN_MC - 1) / FFN_MC;
constexpr size_t AR_H = 0;
constexpr size_t AR_CF = 160 * MiB, AR_RKVK = 320 * MiB, AR_LR = 480 * MiB, AR_EA = 512 * MiB, AR_GT = 672 * MiB, AR_YS = 160 * MiB, AR_PB = 160 * MiB, AR_YSB = 40 * MiB, AR_STS = 120 * MiB;
static_assert((size_t)160 * 64 * 12800 <= 160 * MiB, "PB");
constexpr size_t AR_QA = 160 * MiB, AR_KA = 280 * MiB, AR_VTA = 400 * MiB, AR_OA = 40 * MiB, AR_LSE = 680 * MiB;
constexpr size_t AR_RQ = 520 * MiB, AR_RK = 560 * MiB, AR_RKT = 600 * MiB, AR_RVT = 160 * MiB, AR_RG = 240 * MiB, AR_SB = 320 * MiB;
constexpr size_t AR_SCR = 160 * MiB, AR_MG = 288 * MiB;
constexpr size_t XB_OFF = 160 * MiB;
constexpr size_t AR_XF = 480 * MiB;
constexpr size_t WS_END = WS_AR + 712 * MiB;
constexpr int CW_BAR = 4096;

constexpr int RING_OFF = 0, RING_BYTES = 131072;
constexpr int LDSCTL_OFF = RING_BYTES, MISC_OFF = LDSCTL_OFF + 320;
constexpr int LDS_BYTES = 147456;

struct Args { const float* in[30]; float* out; unsigned char* ws; int ph_lo, ph_hi; };
static_assert(__builtin_offsetof(Args, out) == 240 && __builtin_offsetof(Args, ws) == 248, "ld_karg64 offsets");

struct Frame { LAS unsigned char* lds; unsigned char* ws; int tid, lane, wave, G, gw, NGW, bid, z; };

__device__ __forceinline__ void transpose_item(const float* W, int ldw, int k0, int n0, bf16* WT, int Kdst, int dst_row0, LAS float* scr, int lane) {
    float tv[32];
#pragma unroll
    for (int i = 0; i < 32; ++i) { const int kk = 2 * i + (lane >> 5); tv[i] = W[(size_t)(k0 + kk) * ldw + n0 + (lane & 31)]; }
#pragma unroll
    for (int i = 0; i < 32; ++i) { const int kk = 2 * i + (lane >> 5); scr[kk * 33 + (lane & 31)] = tv[i]; }
    LDS_WAIT(); asm volatile("" ::: "memory");
    const int c = lane & 7;
#pragma unroll
    for (int j = 0; j < 4; ++j) { const int n = (lane >> 3) + 8 * j; const LAS float* s = scr + (8 * c) * 33 + n;
        v4u o; o.x = pk2(s[0 * 33], s[1 * 33]); o.y = pk2(s[2 * 33], s[3 * 33]); o.z = pk2(s[4 * 33], s[5 * 33]); o.w = pk2(s[6 * 33], s[7 * 33]);
        *(v4u*)(WT + (size_t)(dst_row0 + n) * Kdst + k0 + 8 * c) = o; }
    LDS_WAIT(); asm volatile("" ::: "memory");
}

__device__ __forceinline__ void phase_wconv(const Frame& F, const Args& a, int l, unsigned char* wt, unsigned char* wth, int part) {
    LAS float* scr = (LAS float*)(F.lds + RING_OFF + F.wave * 16384);
    constexpr int I_FF = 5632, I_A = 6 * I_FF, I_IN = 32 * 492, I_BA = 512, I_BB = 1024, I_BC = 512, I_OUT = 2048;
    constexpr int NITEMS = I_A + I_IN + I_BA + I_BB + I_BC + I_OUT;
    for (int it = F.gw; it < NITEMS; it += F.NGW) {
        int r = it;
        if (r < I_A) {
            const int m = r / I_FF, q = r % I_FF, f = m / 3, mm = m % 3;
            if (!((f ? 2 : 1) & part)) continue;
            if (mm < 2) {
                const float* W = a.in[F.z + (f ? 26 : 3) + mm] + (size_t)l * D * FF;
                const int kb = q / 176, nb = q % 176, n0 = 32 * nb;
                bf16* dst = (bf16*)(f ? wth + WO_UP2 : wt + WO_UP1);
                transpose_item(W, FF, 64 * kb, n0, dst, D, (n0 / 128) * 256 + mm * 128 + (n0 % 128), scr, F.lane);
            } else {
                const float* W = a.in[F.z + (f ? 28 : 5)] + (size_t)l * FF * D;
                const int kb = q / 64, nb = q % 64, n0 = 32 * nb;
                bf16* dst = (bf16*)(f ? wth + WO_DN2 : wt + WO_DN1);
                transpose_item(W, D, 64 * kb, n0, dst, FF, n0, scr, F.lane);
            }
            continue;
        }
        r -= I_A;
        if (r < I_IN) {
            const float* W = a.in[F.z + 7] + (size_t)l * D * 15744;
            const int kb = r / 492, nb = r % 492, n0 = 32 * nb;
            if (!(((n0 >= 7680 && n0 < 9600) ? 1 : 2) & part)) continue;
            bf16* dst; int row;
            if (n0 < 4608) { dst = (bf16*)(wth + WO_ATT); row = n0; }
            else if (n0 < 7680) { dst = (bf16*)(wth + WO_RET); row = n0 - 4608; }
            else if (n0 < 9600) { dst = (bf16*)(wth + WO_CF); row = n0 - 7680; }
            else { dst = (bf16*)(wth + WO_GATE); row = n0 - 9600; }
            transpose_item(W, 15744, 64 * kb, n0, dst, D, row, scr, F.lane);
            continue;
        }
        r -= I_IN;
        if (!(part & 2)) break;
        if (r < I_BA) { const int kb = r / 64, nb = r % 64; transpose_item(a.in[F.z + 21] + (size_t)l * 512 * D, D, 64 * kb, 32 * nb, (bf16*)(wth + WO_BA), 512, 32 * nb, scr, F.lane); continue; }
        r -= I_BA;
        if (r < I_BB) { const int kb = r / 64, nb = r % 64; transpose_item(a.in[F.z + 22] + (size_t)l * 1024 * D, D, 64 * kb, 32 * nb, (bf16*)(wth + WO_BB), 1024, 32 * nb, scr, F.lane); continue; }
        r -= I_BB;
        if (r < I_BC) { const int kb = r / 64, nb = r % 64; transpose_item(a.in[F.z + 23] + (size_t)l * 512 * D, D, 64 * kb, 32 * nb, (bf16*)(wth + WO_BC), 512, 32 * nb, scr, F.lane); continue; }
        r -= I_BC;
        { const int kb = r / 64, nb = r % 64; transpose_item(a.in[F.z + 24] + (size_t)l * D * D, D, 64 * kb, 32 * nb, (bf16*)(wth + WO_OUT), D, 32 * nb, scr, F.lane); }
    }
    if (!(part & 1)) return;
    const int gt = F.bid * NTHR + F.tid, NGT = F.G * NTHR;
    bf16* lr = (bf16*)(wth + WO_LR);
    const float* w2 = a.in[F.z + 12] + (size_t)l * 2 * 64 * 512; const float* a2 = a.in[F.z + 14] + (size_t)l * 2 * 64 * 512; const float* g2 = a.in[F.z + 15] + (size_t)l * 128 * 512;
    for (int i = gt; i < 2560 * 384; i += NGT) {
        const int n = i / 384, k = i % 384; float v = 0.f;
        if (n < 1024) { const int z = n >> 9, c = n & 511; if (k >= 64 * z && k < 64 * z + 64) v = w2[((size_t)z * 64 + (k - 64 * z)) * 512 + c]; }
        else if (n < 2048) { const int z = (n - 1024) >> 9, c = n & 511; if (k >= 128 + 64 * z && k < 192 + 64 * z) v = a2[((size_t)z * 64 + (k - 128 - 64 * z)) * 512 + c]; }
        else { const int c = n - 2048; if (k >= 256) v = g2[(size_t)(k - 256) * 512 + c]; }
        lr[i] = (bf16)f2bf(v);
    }
    bf16* cfz = (bf16*)(wth + WO_CF) + (size_t)1920 * D;
    for (int i = gt; i < 128 * D; i += NGT) cfz[i] = 0;
}

__device__ __forceinline__ void phase_norm_in(const Frame& F, const float* xp, const float* xs, const float* gain, bf16* xn, bf16* xb) {
    for (int m = F.gw; m < T; m += F.NGW) {
        const float* src_row = m < 8192 ? xp + (size_t)m * D : xs + (size_t)(m - 8192) * D;
        const f32x4* xr = (const f32x4*)src_row + F.lane; const f32x4* gr = (const f32x4*)gain + F.lane;
        f32x4 v[8]; float s = 0.f;
#pragma unroll
        for (int j = 0; j < 8; ++j) { v[j] = xr[64 * j]; s += (v[j].x * v[j].x + v[j].y * v[j].y) + (v[j].z * v[j].z + v[j].w * v[j].w); }
        const float rstd = 1.0f / sqrtf(wave_sum(s) * (1.0f / D) + 1e-6f);
        v2u* o8 = (v2u*)(xn + (size_t)m * D) + F.lane; v2u* b8 = (v2u*)(xb + (size_t)m * D) + F.lane;
#pragma unroll
        for (int j = 0; j < 8; ++j) { const f32x4 g = gr[64 * j]; v2u w; w.x = pk2(v[j].x * rstd * g.x, v[j].y * rstd * g.y); w.y = pk2(v[j].z * rstd * g.z, v[j].w * rstd * g.w); o8[64 * j] = w;
            v2u b; b.x = pk2(v[j].x, v[j].y); b.y = pk2(v[j].z, v[j].w); b8[64 * j] = b; }
    }
}
__device__ __forceinline__ void phase_norm(const Frame& F, const bf16* x, const float* gain, bf16* xn) {
    for (int m = 2 * F.gw; m < T; m += 2 * F.NGW) {
        v4u v[2][4]; float s[2] = {0.f, 0.f};
#pragma unroll
        for (int r = 0; r < 2; ++r) { const v4u* xr = (const v4u*)(x + (size_t)(m + r) * D) + F.lane;
#pragma unroll
            for (int j = 0; j < 4; ++j) v[r][j] = xr[64 * j]; }
#pragma unroll
        for (int r = 0; r < 2; ++r)
#pragma unroll
            for (int j = 0; j < 4; ++j)
#pragma unroll
                for (int q = 0; q < 4; ++q) { const float a = bf_lo(v[r][j][q]), b = bf_hi(v[r][j][q]); s[r] += a * a + b * b; }
        const f32x4* gr = (const f32x4*)gain + 2 * F.lane;
#pragma unroll
        for (int r = 0; r < 2; ++r) {
            const float rstd = 1.0f / sqrtf(wave_sum(s[r]) * (1.0f / D) + 1e-6f);
            v4u* o = (v4u*)(xn + (size_t)(m + r) * D) + F.lane;
#pragma unroll
            for (int j = 0; j < 4; ++j) { const f32x4 g0 = gr[128 * j], g1 = gr[128 * j + 1]; const v4u w = v[r][j]; v4u ow;
                ow.x = pk2(bf_lo(w.x) * rstd * g0.x, bf_hi(w.x) * rstd * g0.y); ow.y = pk2(bf_lo(w.y) * rstd * g0.z, bf_hi(w.y) * rstd * g0.w);
                ow.z = pk2(bf_lo(w.z) * rstd * g1.x, bf_hi(w.z) * rstd * g1.y); ow.w = pk2(bf_lo(w.w) * rstd * g1.z, bf_hi(w.w) * rstd * g1.w);
                o[64 * j] = ow; }
        }
    }
}
__device__ __forceinline__ void phase_final_norm(const Frame& F, const bf16* x, const float* gain, float* out) {
    for (int m = F.gw; m < T; m += F.NGW) {
        const v4u* xr = (const v4u*)(x + (size_t)m * D) + F.lane;
        v4u v[4]; float s = 0.f;
#pragma unroll
        for (int j = 0; j < 4; ++j) v[j] = xr[64 * j];
#pragma unroll
        for (int j = 0; j < 4; ++j)
#pragma unroll
            for (int q = 0; q < 4; ++q) { const float a = bf_lo(v[j][q]), b = bf_hi(v[j][q]); s += a * a + b * b; }
        const float rstd = 1.0f / sqrtf(wave_sum(s) * (1.0f / D) + 1e-6f);
        const f32x4* gr = (const f32x4*)gain + 2 * F.lane; f32x4* o = (f32x4*)(out + (size_t)m * D) + 2 * F.lane;
#pragma unroll
        for (int j = 0; j < 4; ++j) { const f32x4 g0 = gr[128 * j], g1 = gr[128 * j + 1]; const v4u w = v[j];
            f32x4 o0, o1; o0.x = bf_lo(w.x) * rstd * g0.x; o0.y = bf_hi(w.x) * rstd * g0.y; o0.z = bf_lo(w.y) * rstd * g0.z; o0.w = bf_hi(w.y) * rstd * g0.w;
            o1.x = bf_lo(w.z) * rstd * g1.x; o1.y = bf_hi(w.z) * rstd * g1.y; o1.z = bf_lo(w.w) * rstd * g1.z; o1.w = bf_hi(w.w) * rstd * g1.w;
            o[128 * j] = o0; o[128 * j + 1] = o1; }
    }
}

struct SchedPlain {
    const char* A; const char* B; int lda, ldb, K, nM, nN, G, c, wgm;
    __device__ __forceinline__ bool next(int i, UnitG& u) const {
        const int L = i * G + c; if (L >= nM * nN) return false;
        int pm, pn; pg8::tile_map(L, nM, nN, pm, pn, wgm);
        u.A = A + (size_t)pm * 256 * lda * 2; u.B = B + (size_t)pn * 256 * ldb * 2; u.lda = lda; u.ldb = ldb; u.K = K; u.O = nullptr; u.ldo = 0; u.kind = 0; u.x0 = pm; u.x1 = pn; return true;
    }
};
struct EpiSwiglu {
    static constexpr bool PERM = true; static constexpr int NST = 8;
    bf16* H;
    __device__ __forceinline__ void operator()(const f32x4 (&acc)[2][2][4][2], const UnitG& u, int wr, int wc, int fr, int fq) const {
        const int row0 = u.x0 * 256 + wr * 64 + fr, col0 = u.x1 * 128 + wc * 32 + 8 * fq;
#pragma unroll
        for (int ai = 0; ai < 2; ++ai)
#pragma unroll
            for (int m = 0; m < 4; ++m) {
                float h[8];
#pragma unroll
                for (int n = 0; n < 2; ++n)
#pragma unroll
                    for (int e = 0; e < 4; ++e) { const float g = acc[ai][0][m][n][e], up = acc[ai][1][m][n][e]; h[4 * n + e] = g * fsigmoid(g) * up; }
                v4u w; w.x = cvt_pk_bf16(h[0], h[1]); w.y = cvt_pk_bf16(h[2], h[3]); w.z = cvt_pk_bf16(h[4], h[5]); w.w = cvt_pk_bf16(h[6], h[7]);
                *(v4u*)(H + (size_t)(row0 + ai * 128 + m * 16) * FF + col0) = w;
            }
    }
};
struct EpiResid {
    static constexpr bool PERM = true; static constexpr int NST = 16;
    bf16* X; const bf16* R; float scale;
    __device__ __forceinline__ void operator()(const f32x4 (&acc)[2][2][4][2], const UnitG& u, int wr, int wc, int fr, int fq) const {
        const int row0 = u.x0 * 256 + wr * 64 + fr, col0 = u.x1 * 256 + wc * 32 + 8 * fq;
        v4u xv[2][4][2];
#pragma unroll
        for (int ai = 0; ai < 2; ++ai)
#pragma unroll
            for (int m = 0; m < 4; ++m) { const bf16* rowp = R + (size_t)(row0 + ai * 128 + m * 16) * D + col0;
#pragma unroll
                for (int bj = 0; bj < 2; ++bj) xv[ai][m][bj] = *(const v4u*)(rowp + bj * 128); }
        asm volatile("" ::: "memory");
#pragma unroll
        for (int ai = 0; ai < 2; ++ai)
#pragma unroll
            for (int m = 0; m < 4; ++m) { bf16* rowp = X + (size_t)(row0 + ai * 128 + m * 16) * D + col0;
#pragma unroll
                for (int bj = 0; bj < 2; ++bj) { const f32x4 a0 = acc[ai][bj][m][0], a1 = acc[ai][bj][m][1]; const v4u r = xv[ai][m][bj]; v4u w;
                    w.x = cvt_pk_bf16(bf_lo(r.x) + a0.x * scale, bf_hi(r.x) + a0.y * scale); w.y = cvt_pk_bf16(bf_lo(r.y) + a0.z * scale, bf_hi(r.y) + a0.w * scale);
                    w.z = cvt_pk_bf16(bf_lo(r.z) + a1.x * scale, bf_hi(r.z) + a1.y * scale); w.w = cvt_pk_bf16(bf_lo(r.w) + a1.z * scale, bf_hi(r.w) + a1.w * scale);
                    *(v4u*)(rowp + bj * 128) = w; } }
        asm volatile("" ::: "memory");
    }
};
template <int KM>
struct EpiStore {
    static constexpr bool PERM = true; static constexpr int NST = 16;
    const float* b0; const float* b1; const float* dlog;
    __device__ __forceinline__ void operator()(const f32x4 (&acc)[2][2][4][2], const UnitG& u, int wr, int wc, int fr, int fq) const {
        const int row0 = wr * 64 + fr, col0 = wc * 32 + 8 * fq;
        bf16* O = (bf16*)u.O; const int kind = u.kind;
        float l2g[2] = {0.f, 0.f}, l2h[2] = {0.f, 0.f};
        if ((KM & 4) && kind == 2) {
#pragma unroll
            for (int ai = 0; ai < 2; ++ai) { const float lg = ((const GAS float*)dlog)[u.x0 + ai], lh = ((const GAS float*)dlog)[4 + u.x0 + ai];
                l2g[ai] = -__builtin_amdgcn_logf(1.0f + fexp(-lg)); l2h[ai] = -__builtin_amdgcn_logf(1.0f + fexp(-lh)); }
        }
#pragma unroll
        for (int ai = 0; ai < 2; ++ai)
#pragma unroll
            for (int m = 0; m < 4; ++m) { bf16* rowp = O + (size_t)(row0 + ai * 128 + m * 16) * u.ldo + col0;
#pragma unroll
                for (int bj = 0; bj < 2; ++bj) {
                    float v[8];
#pragma unroll
                    for (int n = 0; n < 2; ++n)
#pragma unroll
                        for (int e = 0; e < 4; ++e) v[4 * n + e] = acc[ai][bj][m][n][e];
                    v4u w;
                    if (!(KM & ~0x41) || kind == 0 || kind == 6) { }
                    else if ((KM & 2) && kind == 1) {
#pragma unroll
                        for (int e = 0; e < 8; ++e) v[e] *= 0.08838834764831845f;
                    } else if ((KM & 4) && kind == 2) {
                        float v1[8];
#pragma unroll
                        for (int e = 0; e < 8; ++e) { const int pos = (col0 + e) & 127; const float b = v[e] * 0.08838834764831845f;
                            v1[e] = b * __builtin_amdgcn_exp2f(l2h[ai] * (float)pos); v[e] = b * __builtin_amdgcn_exp2f(l2g[ai] * (float)(127 - pos)); }
                        v4u w1; w1.x = cvt_pk_bf16(v1[0], v1[1]); w1.y = cvt_pk_bf16(v1[2], v1[3]); w1.z = cvt_pk_bf16(v1[4], v1[5]); w1.w = cvt_pk_bf16(v1[6], v1[7]);
                        *(v4u*)(rowp + (size_t)512 * T + bj * 128) = w1;
                    } else if ((KM & 16) && kind == 4) {
                        const int c = u.x1 * 256 + bj * 128 + col0;
#pragma unroll
                        for (int e = 0; e < 8; ++e) { const float xx = -(v[e] + b0[c + e]); const float sp = (xx > 15.f) ? xx : __builtin_amdgcn_logf(1.0f + fexp(xx)) * 0.69314718056f; v[e] = fexp(-sp - 0.5f); }
                    } else if ((KM & 32) && kind == 5) {
                        const int c = u.x1 * 256 + bj * 128 + col0 - 1024;
#pragma unroll
                        for (int e = 0; e < 8; ++e) v[e] = fsigmoid(v[e] + b1[c + e]);
                    }
                    if ((KM & 48) && (kind == 4 || kind == 5)) { w.x = pkh2(v[0], v[1]); w.y = pkh2(v[2], v[3]); w.z = pkh2(v[4], v[5]); w.w = pkh2(v[6], v[7]); }
                    else { w.x = cvt_pk_bf16(v[0], v[1]); w.y = cvt_pk_bf16(v[2], v[3]); w.z = cvt_pk_bf16(v[4], v[5]); w.w = cvt_pk_bf16(v[6], v[7]); }
                    *(v4u*)(rowp + bj * 128) = w; } }
    }
};
struct SchedCF {
    SchedPlain P; char* O;
    __device__ __forceinline__ bool next(int i, UnitG& u) const { if (!P.next(i, u)) return false; u.O = O + ((size_t)u.x0 * 256 * 2048 + (size_t)u.x1 * 256) * 2; u.ldo = 2048; u.kind = 0; return true; }
};
struct SchedLR {
    SchedPlain P; char* EA; char* GT;
    __device__ __forceinline__ bool next(int i, UnitG& u) const {
        if (!P.next(i, u)) return false;
        if (u.x1 < 8) { u.O = EA + ((size_t)u.x0 * 256 * 2048 + (size_t)u.x1 * 256) * 2; u.ldo = 2048; u.kind = u.x1 < 4 ? 4 : 5; }
        else { u.O = GT + ((size_t)u.x0 * 256 * 512 + (size_t)(u.x1 - 8) * 256) * 2; u.ldo = 512; u.kind = 6; }
        { const int sl = u.x1 < 4 ? 0 : (u.x1 < 8 ? 1 : 2); u.A += sl * 256; u.B += sl * 256; u.K = 128; }
        return true;
    }
};
__device__ __forceinline__ int panel_tok0(int pn, int d) { const int n0 = pn * 256, seq = n0 >> 12, within = n0 & 4095, Lg = SEQ / d, p = within / Lg, s0 = within % Lg; return seq * SEQ + s0 * d + p; }
struct SchedAtt {
    const char* XN; const char* wt; char* ar; int G, c;
    __device__ __forceinline__ bool next(int i, UnitG& u) const {
        const int L = i * G + c; if (L >= 3840) return false;
        u.K = D; u.x0 = 0; u.x1 = 0;
        if (L < 2880) {
            const char* W = wt + WO_ATT;
            const int g = L / 960, rem = L % 960, d = (g == 0) ? 1 : (g == 1 ? 4 : 16);
            if (rem < 640) {
                int pm, pn; pg8::tile_map(rem, 160, 4, pm, pn);
                const int t0 = panel_tok0(pm, d);
                u.A = XN + (size_t)t0 * D * 2; u.lda = d * D;
                const int isk = pn >> 1, ct = pn & 1;
                u.B = W + (size_t)(isk * 1536 + g * 512 + ct * 256) * D * 2; u.ldb = D;
                u.O = ar + (isk ? AR_KA : AR_QA) + ((size_t)g * T * 512 + (size_t)pm * 256 * 512 + ct * 256) * 2; u.ldo = 512; u.kind = isk ? 0 : 1;
            } else {
                int pm, pn; pg8::tile_map(rem - 640, 2, 160, pm, pn);
                const int t0 = panel_tok0(pn, d);
                u.A = W + (size_t)(3072 + g * 512 + pm * 256) * D * 2; u.lda = D;
                u.B = XN + (size_t)t0 * D * 2; u.ldb = d * D;
                u.O = ar + AR_VTA + ((size_t)g * 512 * T + (size_t)pm * 256 * T + (size_t)pn * 256) * 2; u.ldo = T; u.kind = 0;
            }
        } else if (L < 3520) {
            const char* W = wt + WO_RET;
            int pm, pn; pg8::tile_map(L - 2880, 160, 4, pm, pn);
            u.A = XN + (size_t)pm * 256 * D * 2; u.lda = D; u.ldb = D; u.ldo = 512;
            if (pn < 2) { u.B = W + (size_t)(pn * 256) * D * 2; u.O = ar + AR_RQ + ((size_t)pm * 256 * 512 + pn * 256) * 2; u.kind = 0; }
            else { u.B = W + (size_t)(512 + (pn - 2) * 256) * D * 2; u.O = ar + AR_RK + ((size_t)pm * 256 * 512 + (pn - 2) * 256) * 2; u.kind = 1; }
        } else {
            const char* W = wt + WO_RET;
            int pm, pn; pg8::tile_map(L - 3520, 2, 160, pm, pn);
            u.B = XN + (size_t)pn * 256 * D * 2; u.ldb = D; u.lda = D; u.ldo = T;
            u.A = W + (size_t)(512 + pm * 256) * D * 2; u.O = ar + AR_RKT + ((size_t)(pm * 256) * T + (size_t)pn * 256) * 2; u.kind = 2; u.x0 = 2 * pm;
        }
        return true;
    }
};
struct SchedRet {
    const char* XN; const char* W; char* ar; int G, c;
    __device__ __forceinline__ bool next(int i, UnitG& u) const {
        const int L = i * G + c; if (L >= 1280) return false;
        u.K = D; u.x0 = 0; u.x1 = 0; u.kind = 0; u.lda = D; u.ldb = D;
        if (L < 640) {
            int pm, pn; pg8::tile_map(L, 4, 160, pm, pn);
            u.A = W + (size_t)(1024 + pm * 256) * D * 2; u.B = XN + (size_t)pn * 256 * D * 2;
            u.O = ar + AR_RVT + ((size_t)pm * 256 * T + (size_t)pn * 256) * 2; u.ldo = T;
        } else {
            int pm, pn; pg8::tile_map(L - 640, 160, 4, pm, pn);
            u.A = XN + (size_t)pm * 256 * D * 2; u.B = W + (size_t)(2048 + pn * 256) * D * 2;
            u.O = ar + AR_RG + ((size_t)pm * 256 * 1024 + pn * 256) * 2; u.ldo = 1024;
        }
        return true;
    }
};
struct SchedMerge {
    const char* XN; const char* ar; const char* wt; int G, c;
    __device__ __forceinline__ bool next(int i, UnitG& u) const {
        const int L = (i / 6) * G + c, su = i % 6; if (L >= 1280) return false;
        int pm, pn; pg8::tile_map(L, 160, 8, pm, pn);
        u.x0 = pm; u.x1 = pn; u.kind = su; u.O = nullptr; u.ldo = 0;
        const int b = su >> 1;
        if (su & 1) { u.A = XN + (size_t)pm * 256 * D * 2; u.lda = D; u.K = D; u.B = wt + WO_GATE + (size_t)(b * 2048 + pn * 256) * D * 2; u.ldb = D; }
        else {
            const int kb = 512 << (b == 1 ? 1 : 0);
            const size_t yoff = (size_t)((b + 1) % 3) * (40 * MiB);
            const size_t woff = WO_BA + (size_t)(2 * b + 2 * (b >> 1)) * MiB;
            u.A = ar + yoff + (size_t)pm * 256 * kb * 2; u.lda = kb; u.K = kb;
            u.B = wt + woff + (size_t)pn * 256 * kb * 2; u.ldb = kb;
        }
        return true;
    }
};
static_assert(AR_YA == 40 * MiB && AR_YB == 80 * MiB && AR_YC == 0 && WO_BB == WO_BA + 2 * MiB && WO_BC == WO_BA + 6 * MiB, "SchedMerge offsets");
struct EpiMerge {
    static constexpr bool PERM = true; static constexpr int NST = 16;
    v4u* scrP; v4u* scrM; bf16* MG;
    __device__ __forceinline__ void operator()(const f32x4 (&acc)[2][2][4][2], const UnitG& u, int wr, int wc, int fr, int fq) const {
        const int tid = (wr * 4 + wc) * 64 + fq * 16 + fr; const int su = u.kind;
        if ((su & 1) == 0) {
            GAS v4u* p = (GAS v4u*)scrP + tid;
#pragma unroll
            for (int ai = 0; ai < 2; ++ai)
#pragma unroll
                for (int bj = 0; bj < 2; ++bj)
#pragma unroll
                    for (int m = 0; m < 4; ++m) { const f32x4 a0 = acc[ai][bj][m][0], a1 = acc[ai][bj][m][1];
                        v4u w; w.x = cvt_pk_bf16(a0.x, a0.y); w.y = cvt_pk_bf16(a0.z, a0.w); w.z = cvt_pk_bf16(a1.x, a1.y); w.w = cvt_pk_bf16(a1.z, a1.w);
                        *p = w; p += NTHR; asm volatile("" : "+v"(p)); }
            return;
        }
        const int row0 = u.x0 * 256 + wr * 64 + fr, col0 = u.x1 * 256 + wc * 32 + 8 * fq;
        const GAS v4u* pp = (const GAS v4u*)scrP + tid; GAS v4u* pm_ = (GAS v4u*)scrM + tid;
#pragma unroll
        for (int ai = 0; ai < 2; ++ai)
#pragma unroll
            for (int bj = 0; bj < 2; ++bj)
#pragma unroll
                for (int m = 0; m < 4; ++m) {
                    const v4u pw = *pp; v4u mw = {0u, 0u, 0u, 0u}; if (su > 1) mw = *pm_;
                    const f32x4 g0 = acc[ai][bj][m][0], g1 = acc[ai][bj][m][1];
                    float v[8];
                    v[0] = fsigmoid(g0.x) * bf_lo(pw.x) + bf_lo(mw.x); v[1] = fsigmoid(g0.y) * bf_hi(pw.x) + bf_hi(mw.x);
                    v[2] = fsigmoid(g0.z) * bf_lo(pw.y) + bf_lo(mw.y); v[3] = fsigmoid(g0.w) * bf_hi(pw.y) + bf_hi(mw.y);
                    v[4] = fsigmoid(g1.x) * bf_lo(pw.z) + bf_lo(mw.z); v[5] = fsigmoid(g1.y) * bf_hi(pw.z) + bf_hi(mw.z);
                    v[6] = fsigmoid(g1.z) * bf_lo(pw.w) + bf_lo(mw.w); v[7] = fsigmoid(g1.w) * bf_hi(pw.w) + bf_hi(mw.w);
                    v4u w; w.x = cvt_pk_bf16(v[0], v[1]); w.y = cvt_pk_bf16(v[2], v[3]); w.z = cvt_pk_bf16(v[4], v[5]); w.w = cvt_pk_bf16(v[6], v[7]);
                    if (su < 5) *pm_ = w;
                    else *(v4u*)(MG + (size_t)(row0 + ai * 128 + m * 16) * D + col0 + bj * 128) = w;
                    pp += NTHR; pm_ += NTHR; asm volatile("" : "+v"(pp), "+v"(pm_) :: "memory");
                }
    }
};

#define MFMA32(a, b, c) __builtin_amdgcn_mfma_f32_32x32x16_bf16((a), (b), (c), 0, 0, 0)
__device__ __forceinline__ int rperm(int r) { return (r & 0x13) | ((r & 4) << 1) | ((r & 8) >> 1); }
__device__ __forceinline__ v4u pk8(const f32x16& o, int b) { v4u w; w.x = cvt_pk_bf16(o[b], o[b + 1]); w.y = cvt_pk_bf16(o[b + 2], o[b + 3]); w.z = cvt_pk_bf16(o[b + 4], o[b + 5]); w.w = cvt_pk_bf16(o[b + 6], o[b + 7]); return w; }
__device__ __forceinline__ void phase_rwkv_pre(const Frame& F, const Args& a, int l) {
    const bf16* CF = (const bf16*)(F.ws + WS_AR + AR_CF); unsigned short* RK = (unsigned short*)(F.ws + WS_AR + AR_RKVK); bf16* LR = (bf16*)(F.ws + WS_AR + AR_LR);
    const float* cw = a.in[F.z + 10] + (size_t)l * 3 * 1920; const float* kk_w = a.in[F.z + 16] + (size_t)l * 512;
    const int lane = F.lane;
    for (int t = F.gw; t < T; t += F.NGW) {
        const int s = t & 4095; const bool hp = s > 0, hn = s < 4095;
#pragma unroll
        for (int j = 0; j < 4; ++j) {
            if (j == 3 && lane >= 48) continue;
            const int cb = 512 * j + 8 * lane;
            const v4u zc = {0u, 0u, 0u, 0u};
            const v4u cur = *(const v4u*)(CF + (size_t)t * 2048 + cb);
            const v4u prv = hp ? *(const v4u*)(CF + (size_t)(t - 1) * 2048 + cb) : zc;
            const v4u nxt = hn ? *(const v4u*)(CF + (size_t)(t + 1) * 2048 + cb) : zc;
            float o[8];
#pragma unroll
            for (int q = 0; q < 4; ++q) {
                const unsigned wc_ = cur[q], wp = prv[q], wn = nxt[q];
                const int c = cb + 2 * q;
                o[2 * q] = cw[c] * bf_lo(wp) + cw[1920 + c] * bf_lo(wc_) + cw[3840 + c] * bf_lo(wn);
                o[2 * q + 1] = cw[c + 1] * bf_hi(wp) + cw[1920 + c + 1] * bf_hi(wc_) + cw[3840 + c + 1] * bf_hi(wn);
            }
            if (j < 3) {
                v4u w; w.x = pkh2(o[0], o[1]); w.y = pkh2(o[2], o[3]); w.z = pkh2(o[4], o[5]); w.w = pkh2(o[6], o[7]);
                *(v4u*)(RK + (size_t)t * 2048 + cb) = w;
                if (j == 1) {
                    float kv[8]; float ss = 0.f;
#pragma unroll
                    for (int e = 0; e < 8; ++e) { kv[e] = o[e] * kk_w[8 * lane + e]; ss += kv[e] * kv[e]; }
                    ss += shfl_xor_(ss, 1); ss += shfl_xor_(ss, 2); ss += shfl_xor_(ss, 4);
                    const float rn = 1.0f / sqrtf(ss + 1e-12f);
                    v4u w2; w2.x = pkh2(kv[0] * rn, kv[1] * rn); w2.y = pkh2(kv[2] * rn, kv[3] * rn); w2.z = pkh2(kv[4] * rn, kv[5] * rn); w2.w = pkh2(kv[6] * rn, kv[7] * rn);
                    *(v4u*)(RK + (size_t)t * 2048 + 1536 + 8 * lane) = w2;
                }
            } else {
                if (lane < 16) {
#pragma unroll
                    for (int e = 0; e < 8; ++e) { const float ex = fexp(2.0f * o[e]); o[e] = 1.0f - 2.0f / (ex + 1.0f); }
                } else if (lane >= 32) {
#pragma unroll
                    for (int e = 0; e < 8; ++e) o[e] = fsigmoid(o[e]);
                }
                v4u w; w.x = pk2(o[0], o[1]); w.y = pk2(o[2], o[3]); w.z = pk2(o[4], o[5]); w.w = pk2(o[6], o[7]);
                *(v4u*)(LR + (size_t)t * 384 + 8 * lane) = w;
            }
        }
    }
}

__device__ __forceinline__ float dpp_red16(float x) {
    x += __builtin_bit_cast(float, __builtin_amdgcn_update_dpp(0, __builtin_bit_cast(int, x), 0xB1, 0xF, 0xF, true));
    x += __builtin_bit_cast(float, __builtin_amdgcn_update_dpp(0, __builtin_bit_cast(int, x), 0x4E, 0xF, 0xF, true));
    x += __builtin_bit_cast(float, __builtin_amdgcn_update_dpp(0, __builtin_bit_cast(int, x), 0x141, 0xF, 0xF, true));
    x += __builtin_bit_cast(float, __builtin_amdgcn_update_dpp(0, __builtin_bit_cast(int, x), 0x140, 0xF, 0xF, true));
    return x;
}
__device__ __forceinline__ void phase_rwkv_scan(const Frame& F, const Args& a, int l) {
    const unsigned short* EA = (const unsigned short*)(F.ws + WS_AR + AR_EA); const unsigned short* RK = (const unsigned short*)(F.ws + WS_AR + AR_RKVK);
    float* YS = (float*)(F.ws + WS_AR + AR_YS);
    const float* k_a = a.in[F.z + 17] + (size_t)l * 512;
    constexpr int TB = 32, BUF_F = TB * 384;
    LAS float* buf = (LAS float*)(F.lds + RING_OFF);
    LAS float* yo = buf + 2 * BUF_F;
    const int tid = F.tid, kq = tid & 15, rp = tid >> 4, c = tid & 63, ts = tid >> 6;
    for (int sc = F.bid; sc < 160; sc += F.G) {
        const int seq = sc >> 4, h = (sc >> 1) & 7, z = sc & 1;
        const float ka = k_a[h * 64 + c];
        float st[2][4];
#pragma unroll
        for (int r = 0; r < 2; ++r)
#pragma unroll
            for (int i = 0; i < 4; ++i) st[r][i] = 0.f;
        unsigned short raw[4][6];
#define SCAN_LOAD(nb) do { _Pragma("unroll") for (int i = 0; i < 4; ++i) { const int tau = (nb) * TB + ts + 8 * i; const int pos = z ? (SEQ - 1 - tau) : tau; const size_t tok = (size_t)seq * SEQ + pos; \
            raw[i][0] = EA[tok * 2048 + z * 512 + h * 64 + c]; raw[i][1] = EA[tok * 2048 + 1024 + z * 512 + h * 64 + c]; \
            raw[i][2] = RK[tok * 2048 + h * 64 + c]; raw[i][3] = RK[tok * 2048 + 512 + h * 64 + c]; raw[i][4] = RK[tok * 2048 + 1024 + h * 64 + c]; raw[i][5] = RK[tok * 2048 + 1536 + h * 64 + c]; } } while (0)
#define SCAN_STAGE(bi) do { LAS float* b_ = buf + (bi) * BUF_F; _Pragma("unroll") for (int i = 0; i < 4; ++i) { const int tl = ts + 8 * i; \
            const float e_ = h1(raw[i][0]), a_ = h1(raw[i][1]), r_ = h1(raw[i][2]), k_ = h1(raw[i][3]), v_ = h1(raw[i][4]), kk_ = h1(raw[i][5]); \
            b_[tl * 384 + c] = kk_; b_[tl * 384 + 64 + c] = fexp(-e_); b_[tl * 384 + 128 + c] = kk_ * a_; b_[tl * 384 + 192 + c] = k_ * (1.0f + (a_ - 1.0f) * ka); b_[tl * 384 + 256 + c] = r_; b_[tl * 384 + 320 + c] = v_; } } while (0)
        __syncthreads();
        SCAN_LOAD(0); SCAN_STAGE(0);
        __syncthreads();
        constexpr int NB = SEQ / TB;
        for (int nb = 0; nb < NB; ++nb) {
            if (nb + 1 < NB) SCAN_LOAD(nb + 1);
            const LAS float* b_ = buf + (nb & 1) * BUF_F;
#pragma unroll 4
            for (int stp = 0; stp < TB; ++stp) {
                const LAS float* op = b_ + stp * 384;
                const f32x4 kk4 = *(const LAS f32x4*)(op + 4 * kq), w4 = *(const LAS f32x4*)(op + 64 + 4 * kq), ka4 = *(const LAS f32x4*)(op + 128 + 4 * kq),
                            kd4 = *(const LAS f32x4*)(op + 192 + 4 * kq), r4 = *(const LAS f32x4*)(op + 256 + 4 * kq);
                const f32x2 v2 = *(const LAS f32x2*)(op + 320 + 2 * rp);
#pragma unroll
                for (int r = 0; r < 2; ++r) {
                    float sa = (st[r][0] * kk4.x + st[r][1] * kk4.y) + (st[r][2] * kk4.z + st[r][3] * kk4.w);
                    sa = -dpp_red16(sa);
                    const float vv = r ? v2.y : v2.x;
                    st[r][0] = st[r][0] * w4.x + sa * ka4.x + vv * kd4.x; st[r][1] = st[r][1] * w4.y + sa * ka4.y + vv * kd4.y;
                    st[r][2] = st[r][2] * w4.z + sa * ka4.z + vv * kd4.z; st[r][3] = st[r][3] * w4.w + sa * ka4.w + vv * kd4.w;
                    float y = (st[r][0] * r4.x + st[r][1] * r4.y) + (st[r][2] * r4.z + st[r][3] * r4.w);
                    y = dpp_red16(y);
                    if (kq == 0) yo[stp * 64 + 2 * rp + r] = y;
                }
            }
            if (nb + 1 < NB) SCAN_STAGE((nb + 1) & 1);
            __syncthreads();
#pragma unroll
            for (int i = 0; i < 4; ++i) { const int tl = ts + 8 * i, tau = nb * TB + tl; const int pos = z ? (SEQ - 1 - tau) : tau; const size_t tok = (size_t)seq * SEQ + pos;
                YS[((size_t)z * T + tok) * 512 + h * 64 + c] = yo[tl * 64 + c]; }
            __syncthreads();
        }
#undef SCAN_LOAD
#undef SCAN_STAGE
    }
}

constexpr int RW_CS = 64, RW_NSEG = (SEQ / 16) / RW_CS, RW_PBB = 12800;
__device__ __forceinline__ unsigned lds_u16(const LAS bf16* p) { return (unsigned)*p; }
__device__ __forceinline__ void phase_rwkv_prep(const Frame& F, const Args& a, int l, int seg) {
    const unsigned short* EA = (const unsigned short*)(F.ws + WS_AR + AR_EA); const unsigned short* RK = (const unsigned short*)(F.ws + WS_AR + AR_RKVK);
    unsigned char* PB = F.ws + WS_AR + AR_PB;
    const float* k_a = a.in[F.z + 17] + (size_t)l * 512;
    constexpr int LDA = 72, GLD = 36, M2D = 24;
    LAS unsigned char* pw = F.lds + RING_OFF + F.wave * 15360;
    LAS bf16* AR = (LAS bf16*)pw; LAS bf16* BK = (LAS bf16*)(pw + 4608); LAS float* GL = (LAS float*)(pw + 9216); LAS bf16* VL = (LAS bf16*)(pw + 9216); LAS bf16* M2 = (LAS bf16*)(pw + 13824);
    const int L = F.lane, li = L & 31, hh = L >> 5;
#define PREP_LOAD(dst, it_, hb_) do { const int sc_ = (it_) / RW_CS, c_ = seg * RW_CS + (it_) % RW_CS, seq_ = sc_ >> 4, h_ = (sc_ >> 1) & 7, z_ = sc_ & 1; \
        _Pragma("unroll") for (int t8 = 0; t8 < 8; ++t8) { const int tau = 16 * c_ + 8 * (hb_) + t8, pos = z_ ? (SEQ - 1 - tau) : tau; const size_t tok = (size_t)seq_ * SEQ + pos; \
            dst[t8][0] = EA[tok * 2048 + z_ * 512 + h_ * 64 + L]; dst[t8][1] = EA[tok * 2048 + 1024 + z_ * 512 + h_ * 64 + L]; \
            dst[t8][2] = RK[tok * 2048 + h_ * 64 + L]; dst[t8][3] = RK[tok * 2048 + 512 + h_ * 64 + L]; dst[t8][4] = RK[tok * 2048 + 1024 + h_ * 64 + L]; dst[t8][5] = RK[tok * 2048 + 1536 + h_ * 64 + L]; } } while (0)
#define PREP_HALF(src_, hb_) do { _Pragma("unroll") for (int t8 = 0; t8 < 8; ++t8) { const int t = 8 * (hb_) + t8; \
            const float e_ = h1(src_[t8][0]), a_ = h1(src_[t8][1]), r_ = h1(src_[t8][2]), k_ = h1(src_[t8][3]), v_ = h1(src_[t8][4]), kk_ = h1(src_[t8][5]); \
            cum += e_; gam = fexp(-cum); const float ig = fexp(cum); \
            const float at = -kk_ * gprev, bt = kk_ * a_ * ig, kt = k_ * (1.0f + (a_ - 1.0f) * ka) * ig, rt = r_ * gam; \
            atf[t] = at; \
            AR[t * LDA + L] = (bf16)f2bf(at); AR[(16 + t) * LDA + L] = (bf16)f2bf(rt); BK[t * LDA + L] = (bf16)f2bf(bt); BK[(16 + t) * LDA + L] = (bf16)f2bf(kt); VL[t * LDA + L] = (bf16)f2bf(v_); \
            gprev = gam; } } while (0)
    unsigned short raw0[8][6], raw1[8][6];
    if (F.gw < 160 * RW_CS) PREP_LOAD(raw0, F.gw, 0);
    for (int item = F.gw; item < 160 * RW_CS; item += F.NGW) {
        const int sc = item / RW_CS, cl = item % RW_CS, h = (sc >> 1) & 7;
        unsigned char* rec = PB + (size_t)(sc * RW_CS + cl) * RW_PBB;
        const float ka = k_a[h * 64 + L];
        float atf[16]; float cum = 0.f, gprev = 1.f, gam = 1.f;
        PREP_LOAD(raw1, item, 1);
        asm volatile("" ::: "memory");
        PREP_HALF(raw0, 0);
        { const int nit = (item + F.NGW < 160 * RW_CS) ? item + F.NGW : item; PREP_LOAD(raw0, nit, 0); }
        asm volatile("" ::: "memory");
        PREP_HALF(raw1, 1);
        *(float*)(rec + 12288 + 4 * L) = gam;
        LDS_WAIT(); asm volatile("" ::: "memory");
#pragma unroll
        for (int vt = 0; vt < 2; ++vt) { v4u w;
#pragma unroll
            for (int q = 0; q < 4; ++q) w[q] = lds_u16(VL + (8 * hh + 2 * q) * LDA + 32 * vt + li) | (lds_u16(VL + (8 * hh + 2 * q + 1) * LDA + 32 * vt + li) << 16);
            *(v4u*)(rec + 10240 + vt * 1024 + 16 * L) = w; }
#pragma unroll
        for (int kt = 0; kt < 2; ++kt) { v4u w, w2;
#pragma unroll
            for (int q = 0; q < 4; ++q) { w[q] = lds_u16(BK + (16 + 8 * hh + 2 * q) * LDA + 32 * kt + li) | (lds_u16(BK + (16 + 8 * hh + 2 * q + 1) * LDA + 32 * kt + li) << 16);
                const int j0 = 2 * q, j1 = 2 * q + 1, s0 = 8 * (j0 >> 2) + 4 * hh + (j0 & 3), s1 = 8 * (j1 >> 2) + 4 * hh + (j1 & 3);
                w2[q] = lds_u16(BK + s0 * LDA + 32 * kt + li) | (lds_u16(BK + s1 * LDA + 32 * kt + li) << 16); }
            *(v4u*)(rec + 7168 + kt * 1024 + 16 * L) = w; *(v4u*)(rec + 5120 + kt * 1024 + 16 * L) = w2; }
        f32x16 g;
#pragma unroll
        for (int e = 0; e < 16; ++e) g[e] = 0.f;
#pragma unroll
        for (int ks = 0; ks < 4; ++ks) { const bf16x8 af = *(const LAS bf16x8*)(AR + li * LDA + 16 * ks + 8 * hh); const bf16x8 bf = *(const LAS bf16x8*)(BK + li * LDA + 16 * ks + 8 * hh); g = MFMA32(af, bf, g); }
        LDS_WAIT(); asm volatile("" ::: "memory");
#pragma unroll
        for (int e = 0; e < 16; ++e) GL[((e & 3) + 8 * (e >> 2) + 4 * hh) * GLD + li] = g[e];
        LDS_WAIT(); asm volatile("" ::: "memory");
        float y2[16];
#pragma unroll
        for (int t = 0; t < 16; ++t) y2[t] = (L < 16 && L < t) ? GL[t * GLD + 16 + (L & 15)] : 0.f;
#pragma unroll
        for (int t = 1; t < 16; ++t) {
            float cf[16];
#pragma unroll
            for (int q = 0; q < 4; ++q) { if (4 * q < t) { const f32x4 c4 = *(const LAS f32x4*)(GL + t * GLD + 4 * q); cf[4 * q] = c4.x; cf[4 * q + 1] = c4.y; cf[4 * q + 2] = c4.z; cf[4 * q + 3] = c4.w; } }
#pragma unroll
            for (int s = 0; s < 16; ++s) if (s < t) { atf[t] += cf[s] * atf[s]; y2[t] += cf[s] * y2[s]; }
        }
#pragma unroll
        for (int t = 0; t < 16; ++t) { AR[t * LDA + L] = (bf16)f2bf(atf[t]); if (L < 16) M2[t * M2D + L] = (bf16)f2bf(y2[t]); }
        { const int t = L >> 2, s0 = 4 * (L & 3); const f32x4 c4 = *(const LAS f32x4*)(GL + (16 + t) * GLD + 16 + s0);
          v2u w; w.x = pk2(s0 <= t ? c4.x : 0.f, s0 + 1 <= t ? c4.y : 0.f); w.y = pk2(s0 + 2 <= t ? c4.z : 0.f, s0 + 3 <= t ? c4.w : 0.f);
          *(LAS v2u*)(M2 + (16 + t) * M2D + s0) = w; }
        LDS_WAIT(); asm volatile("" ::: "memory");
#pragma unroll
        for (int ks = 0; ks < 4; ++ks) { const v2u p0 = *(const LAS v2u*)(AR + li * LDA + 16 * ks + 4 * hh), p1 = *(const LAS v2u*)(AR + li * LDA + 16 * ks + 8 + 4 * hh);
            v4u w; w.x = p0.x; w.y = p0.y; w.z = p1.x; w.w = p1.y; *(v4u*)(rec + ks * 1024 + 16 * L) = w; }
        *(v4u*)(rec + 4096 + 16 * L) = *(const LAS v4u*)(M2 + li * M2D + 8 * hh);
        { v4u w = {0u, 0u, 0u, 0u};
          if (li >= 16) { const int t = li - 16; const f32x4 c0 = *(const LAS f32x4*)(GL + (16 + t) * GLD + 4 * hh), c1 = *(const LAS f32x4*)(GL + (16 + t) * GLD + 8 + 4 * hh); const int s0 = 4 * hh, s1 = 8 + 4 * hh;
              w.x = pk2(s0 <= t ? c0.x : 0.f, s0 + 1 <= t ? c0.y : 0.f); w.y = pk2(s0 + 2 <= t ? c0.z : 0.f, s0 + 3 <= t ? c0.w : 0.f);
              w.z = pk2(s1 <= t ? c1.x : 0.f, s1 + 1 <= t ? c1.y : 0.f); w.w = pk2(s1 + 2 <= t ? c1.z : 0.f, s1 + 3 <= t ? c1.w : 0.f); }
          *(v4u*)(rec + 9216 + 16 * L) = w; }
        LDS_WAIT(); asm volatile("" ::: "memory");
    }
#undef PREP_LOAD
#undef PREP_HALF
}
__device__ __forceinline__ void phase_rwkv_fused(const Frame& F, const Args& a, int l) {
    if (F.bid >= 160) return;
    const int sc = F.bid, seq = sc >> 4, h = (sc >> 1) & 7, z = sc & 1;
    constexpr int NCH = SEQ / 16, FR_RING = 6 * 15360, FR_FLAGS = FR_RING + 3 * RW_PBB;
    LAS unsigned char* ring = F.lds + RING_OFF + FR_RING;
    volatile LAS unsigned* ready = (volatile LAS unsigned*)(F.lds + RING_OFF + FR_FLAGS);
    volatile LAS unsigned* done = ready + 4;
    bf16* YS = (bf16*)(F.ws + WS_AR + AR_YSB);
    __syncthreads();
    if (F.tid < 16) ready[F.tid] = 0u;
    __syncthreads();
    if (F.wave >= 2) {
    const unsigned short* EA = (const unsigned short*)(F.ws + WS_AR + AR_EA); const unsigned short* RK = (const unsigned short*)(F.ws + WS_AR + AR_RKVK);
    const float* k_a = a.in[F.z + 17] + (size_t)l * 512;
    constexpr int LDA = 72, GLD = 36, M2D = 24;
    LAS unsigned char* pw = F.lds + RING_OFF + (F.wave - 2) * 15360;
    LAS bf16* AR = (LAS bf16*)pw; LAS bf16* BK = (LAS bf16*)(pw + 4608); LAS float* GL = (LAS float*)(pw + 9216); LAS bf16* VL = (LAS bf16*)(pw + 9216); LAS bf16* M2 = (LAS bf16*)(pw + 13824);
    const int L = F.lane, li = L & 31, hh = L >> 5;
#define PREP_LOAD(dst, it_, hb_) do { const int c_ = (it_), seq_ = seq, h_ = h, z_ = z; \
        _Pragma("unroll") for (int t8 = 0; t8 < 8; ++t8) { const int tau = 16 * c_ + 8 * (hb_) + t8, pos = z_ ? (SEQ - 1 - tau) : tau; const size_t tok = (size_t)seq_ * SEQ + pos; \
            dst[t8][0] = EA[tok * 2048 + z_ * 512 + h_ * 64 + L]; dst[t8][1] = EA[tok * 2048 + 1024 + z_ * 512 + h_ * 64 + L]; \
            dst[t8][2] = RK[tok * 2048 + h_ * 64 + L]; dst[t8][3] = RK[tok * 2048 + 512 + h_ * 64 + L]; dst[t8][4] = RK[tok * 2048 + 1024 + h_ * 64 + L]; dst[t8][5] = RK[tok * 2048 + 1536 + h_ * 64 + L]; } } while (0)
#define PREP_HALF(src_, hb_) do { _Pragma("unroll") for (int t8 = 0; t8 < 8; ++t8) { const int t = 8 * (hb_) + t8; \
            const float e_ = h1(src_[t8][0]), a_ = h1(src_[t8][1]), r_ = h1(src_[t8][2]), k_ = h1(src_[t8][3]), v_ = h1(src_[t8][4]), kk_ = h1(src_[t8][5]); \
            cum += e_; gam = fexp(-cum); const float ig = fexp(cum); \
            const float at = -kk_ * gprev, bt = kk_ * a_ * ig, kt = k_ * (1.0f + (a_ - 1.0f) * ka) * ig, rt = r_ * gam; \
            atf[t] = at; \
            AR[t * LDA + L] = (bf16)f2bf(at); AR[(16 + t) * LDA + L] = (bf16)f2bf(rt); BK[t * LDA + L] = (bf16)f2bf(bt); BK[(16 + t) * LDA + L] = (bf16)f2bf(kt); VL[t * LDA + L] = (bf16)f2bf(v_); \
            gprev = gam; } } while (0)
    unsigned short raw0[8][6], raw1[8][6];
    const float ka_ = k_a[h * 64 + L];
    PREP_LOAD(raw0, F.wave - 2, 0); PREP_LOAD(raw1, F.wave - 2, 1);
    for (int item = F.wave - 2; item < NCH; item += 6) {
        v4u frv[2]; float gamC;
        const float ka = ka_;
        float atf[16]; float cum = 0.f, gprev = 1.f, gam = 1.f;
        asm volatile("" ::: "memory");
        PREP_HALF(raw0, 0);
        PREP_HALF(raw1, 1);
        gamC = gam;
        LDS_WAIT(); asm volatile("" ::: "memory");
#pragma unroll
        for (int vt = 0; vt < 2; ++vt) { v4u w;
#pragma unroll
            for (int q = 0; q < 4; ++q) w[q] = lds_u16(VL + (8 * hh + 2 * q) * LDA + 32 * vt + li) | (lds_u16(VL + (8 * hh + 2 * q + 1) * LDA + 32 * vt + li) << 16);
            frv[vt] = w; }
        f32x16 g;
#pragma unroll
        for (int e = 0; e < 16; ++e) g[e] = 0.f;
#pragma unroll
        for (int ks = 0; ks < 4; ++ks) { const bf16x8 af = *(const LAS bf16x8*)(AR + li * LDA + 16 * ks + 8 * hh); const bf16x8 bf = *(const LAS bf16x8*)(BK + li * LDA + 16 * ks + 8 * hh); g = MFMA32(af, bf, g); }
        LDS_WAIT(); asm volatile("" ::: "memory");
#pragma unroll
        for (int e = 0; e < 16; ++e) GL[((e & 3) + 8 * (e >> 2) + 4 * hh) * GLD + li] = g[e];
        LDS_WAIT(); asm volatile("" ::: "memory");
        float y2[16];
#pragma unroll
        for (int t = 0; t < 16; ++t) y2[t] = (L < 16 && L < t) ? GL[t * GLD + 16 + (L & 15)] : 0.f;
#pragma unroll
        for (int t = 1; t < 16; ++t) {
            float cf[16];
#pragma unroll
            for (int q = 0; q < 4; ++q) { if (4 * q < t) { const f32x4 c4 = *(const LAS f32x4*)(GL + t * GLD + 4 * q); cf[4 * q] = c4.x; cf[4 * q + 1] = c4.y; cf[4 * q + 2] = c4.z; cf[4 * q + 3] = c4.w; } }
#pragma unroll
            for (int s = 0; s < 16; ++s) if (s < t) { atf[t] += cf[s] * atf[s]; y2[t] += cf[s] * y2[s]; }
        }
#pragma unroll
        for (int t = 0; t < 16; ++t) { AR[t * LDA + L] = (bf16)f2bf(atf[t]); if (L < 16) M2[t * M2D + L] = (bf16)f2bf(y2[t]); }
        { const int t = L >> 2, s0 = 4 * (L & 3); const f32x4 c4 = *(const LAS f32x4*)(GL + (16 + t) * GLD + 16 + s0);
          v2u w; w.x = pk2(s0 <= t ? c4.x : 0.f, s0 + 1 <= t ? c4.y : 0.f); w.y = pk2(s0 + 2 <= t ? c4.z : 0.f, s0 + 3 <= t ? c4.w : 0.f);
          *(LAS v2u*)(M2 + (16 + t) * M2D + s0) = w; }
        LDS_WAIT(); asm volatile("" ::: "memory");
        { const int nit = (item + 6 < NCH) ? item + 6 : item; PREP_LOAD(raw0, nit, 0); PREP_LOAD(raw1, nit, 1); }
        asm volatile("" ::: "memory");
        const int slot = item % 3;
        if (item >= 3) { unsigned sp = 0; while ((done[slot * 2] < (unsigned)(item - 2) || done[slot * 2 + 1] < (unsigned)(item - 2)) && ++sp < (1u << 22)) __builtin_amdgcn_s_sleep(1); }
        asm volatile("" ::: "memory");
        LAS unsigned char* rp = ring + slot * RW_PBB;
#pragma unroll
        for (int ks = 0; ks < 4; ++ks) { const v2u p0 = *(const LAS v2u*)(AR + li * LDA + 16 * ks + 4 * hh), p1 = *(const LAS v2u*)(AR + li * LDA + 16 * ks + 8 + 4 * hh);
            v4u w; w.x = p0.x; w.y = p0.y; w.z = p1.x; w.w = p1.y; *(LAS v4u*)(rp + ks * 1024 + 16 * L) = w; }
        { const v4u w4 = *(const LAS v4u*)(M2 + li * M2D + 8 * hh); *(LAS v4u*)(rp + 4096 + 16 * L) = w4; }
        { v4u w = {0u, 0u, 0u, 0u};
          if (li >= 16) { const int t = li - 16; const f32x4 c0 = *(const LAS f32x4*)(GL + (16 + t) * GLD + 4 * hh), c1 = *(const LAS f32x4*)(GL + (16 + t) * GLD + 8 + 4 * hh); const int s0 = 4 * hh, s1 = 8 + 4 * hh;
              w.x = pk2(s0 <= t ? c0.x : 0.f, s0 + 1 <= t ? c0.y : 0.f); w.y = pk2(s0 + 2 <= t ? c0.z : 0.f, s0 + 3 <= t ? c0.w : 0.f);
              w.z = pk2(s1 <= t ? c1.x : 0.f, s1 + 1 <= t ? c1.y : 0.f); w.w = pk2(s1 + 2 <= t ? c1.z : 0.f, s1 + 3 <= t ? c1.w : 0.f); }
          *(LAS v4u*)(rp + 9216 + 16 * L) = w; }
#pragma unroll
        for (int kt = 0; kt < 2; ++kt) { v4u w, w2;
#pragma unroll
            for (int q = 0; q < 4; ++q) { w[q] = lds_u16(BK + (16 + 8 * hh + 2 * q) * LDA + 32 * kt + li) | (lds_u16(BK + (16 + 8 * hh + 2 * q + 1) * LDA + 32 * kt + li) << 16);
                const int j0 = 2 * q, j1 = 2 * q + 1, s0 = 8 * (j0 >> 2) + 4 * hh + (j0 & 3), s1 = 8 * (j1 >> 2) + 4 * hh + (j1 & 3);
                w2[q] = lds_u16(BK + s0 * LDA + 32 * kt + li) | (lds_u16(BK + s1 * LDA + 32 * kt + li) << 16); }
            *(LAS v4u*)(rp + 7168 + kt * 1024 + 16 * L) = w; *(LAS v4u*)(rp + 5120 + kt * 1024 + 16 * L) = w2; }
        LDS_WAIT(); asm volatile("" ::: "memory");
        *(LAS v4u*)(rp + 10240 + 16 * L) = frv[0]; *(LAS v4u*)(rp + 11264 + 16 * L) = frv[1];
        *(LAS float*)(rp + 12288 + 4 * L) = gamC;
        LDS_WAIT(); asm volatile("" ::: "memory");
        if (L == 0) ready[slot] = (unsigned)(item + 1);
    }
#undef PREP_LOAD
#undef PREP_HALF
        return;
    }
    const int L = F.lane, li = L & 31, hh = L >> 5, vt = F.wave;
    f32x16 st[2];
#pragma unroll
    for (int kt = 0; kt < 2; ++kt)
#pragma unroll
        for (int e = 0; e < 16; ++e) st[kt][e] = 0.f;
    for (int cl = 0; cl < NCH; ++cl) {
        const int slot = cl % 3;
        { unsigned sp = 0; while (ready[slot] != (unsigned)(cl + 1) && ++sp < (1u << 22)) __builtin_amdgcn_s_sleep(1); }
        asm volatile("" ::: "memory");
        const LAS unsigned char* rec = ring + slot * RW_PBB;
        bf16x8 a1[4], btf[2], ktf[2]; f32x4 gm[2][4];
#pragma unroll
        for (int ks = 0; ks < 4; ++ks) a1[ks] = *(const LAS bf16x8*)(rec + ks * 1024 + 16 * L);
        const bf16x8 a2 = *(const LAS bf16x8*)(rec + 4096 + 16 * L), mbr = *(const LAS bf16x8*)(rec + 9216 + 16 * L), vc = *(const LAS bf16x8*)(rec + 10240 + vt * 1024 + 16 * L);
#pragma unroll
        for (int kt = 0; kt < 2; ++kt) { btf[kt] = *(const LAS bf16x8*)(rec + 5120 + kt * 1024 + 16 * L); ktf[kt] = *(const LAS bf16x8*)(rec + 7168 + kt * 1024 + 16 * L);
#pragma unroll
            for (int q4 = 0; q4 < 4; ++q4) gm[kt][q4] = *(const LAS f32x4*)(rec + 12288 + 4 * (32 * kt + 8 * q4 + 4 * hh)); }
        LDS_WAIT(); asm volatile("" ::: "memory");
        if (L == 0) done[slot * 2 + vt] = (unsigned)(cl + 1);
        f32x16 acc;
#pragma unroll
        for (int e = 0; e < 16; ++e) acc[e] = 0.f;
        acc = MFMA32(a2, vc, acc);
#pragma unroll
        for (int ks = 0; ks < 4; ++ks) { const int kt = ks >> 1, b8 = 8 * (ks & 1);
            v4u w; w.x = cvt_pk_bf16(st[kt][b8], st[kt][b8 + 1]); w.y = cvt_pk_bf16(st[kt][b8 + 2], st[kt][b8 + 3]); w.z = cvt_pk_bf16(st[kt][b8 + 4], st[kt][b8 + 5]); w.w = cvt_pk_bf16(st[kt][b8 + 6], st[kt][b8 + 7]);
            acc = MFMA32(a1[ks], __builtin_bit_cast(bf16x8, w), acc); }
        v4u uw; uw.x = cvt_pk_bf16(acc[0], acc[1]); uw.y = cvt_pk_bf16(acc[2], acc[3]); uw.z = cvt_pk_bf16(acc[4], acc[5]); uw.w = cvt_pk_bf16(acc[6], acc[7]);
        const bf16x8 uf = __builtin_bit_cast(bf16x8, uw);
        acc = MFMA32(mbr, uf, acc);
#pragma unroll
        for (int kt = 0; kt < 2; ++kt) { st[kt] = MFMA32(btf[kt], uf, st[kt]); st[kt] = MFMA32(ktf[kt], vc, st[kt]);
#pragma unroll
            for (int q4 = 0; q4 < 4; ++q4) { st[kt][4 * q4] *= gm[kt][q4].x; st[kt][4 * q4 + 1] *= gm[kt][q4].y; st[kt][4 * q4 + 2] *= gm[kt][q4].z; st[kt][4 * q4 + 3] *= gm[kt][q4].w; } }
#pragma unroll
        for (int e = 8; e < 16; ++e) { const int t = (e & 3) + 8 * ((e >> 2) - 2) + 4 * hh, tau = 16 * cl + t, pos = z ? (SEQ - 1 - tau) : tau; const size_t tok = (size_t)seq * SEQ + pos;
            YS[((size_t)z * T + tok) * 512 + h * 64 + 32 * vt + li] = (bf16)f2bf(acc[e]); }
    }
}

__device__ __forceinline__ void phase_rwkv_cscan(const Frame& F, int seg) {
    if (F.bid >= 160) return;
    const unsigned char* PB = F.ws + WS_AR + AR_PB; bf16* YS = (bf16*)(F.ws + WS_AR + AR_YSB); float* STS = (float*)(F.ws + WS_AR + AR_STS);
    LAS unsigned char* ring = F.lds + RING_OFF;
    volatile LAS unsigned* ready = (volatile LAS unsigned*)(F.lds + RING_OFF + 8 * RW_PBB);
    volatile LAS unsigned* done = ready + 8;
    const int L = F.lane, li = L & 31, hh = L >> 5, sc = F.bid, seq = sc >> 4, h = (sc >> 1) & 7, z = sc & 1;
    __syncthreads();
    if (F.tid < 24) ready[F.tid] = 0u;
    __syncthreads();
    if (F.wave >= 2) {
        for (int cl = F.wave - 2; cl < RW_CS; cl += 6) {
            const int slot = cl & 7;
            if (cl >= 8) { unsigned sp = 0; while ((done[slot * 2] < (unsigned)(cl - 7) || done[slot * 2 + 1] < (unsigned)(cl - 7)) && ++sp < (1u << 22)) __builtin_amdgcn_s_sleep(1); }
            asm volatile("" ::: "memory");
            const unsigned char* rec = PB + (size_t)(sc * RW_CS + cl) * RW_PBB;
            v4u r[13];
#pragma unroll
            for (int i = 0; i < 13; ++i) { const int o = (i * 64 + L) * 16; r[i] = (o < RW_PBB) ? *(const v4u*)(rec + o) : (v4u){0u, 0u, 0u, 0u}; }
#pragma unroll
            for (int i = 0; i < 13; ++i) { const int o = (i * 64 + L) * 16; if (o < RW_PBB) *(LAS v4u*)(ring + slot * RW_PBB + o) = r[i]; }
            LDS_WAIT(); asm volatile("" ::: "memory");
            if (L == 0) ready[slot] = (unsigned)(cl + 1);
        }
        return;
    }
    const int vt = F.wave;
    f32x16 st[2];
    float* sts = STS + ((size_t)(sc * 2 + vt) * 2) * 1024 + L;
#pragma unroll
    for (int kt = 0; kt < 2; ++kt)
#pragma unroll
        for (int e = 0; e < 16; ++e) st[kt][e] = (seg == 0) ? 0.f : sts[(kt * 16 + e) * 64];
    for (int cl = 0; cl < RW_CS; ++cl) {
        const int slot = cl & 7;
        { unsigned sp = 0; while (ready[slot] != (unsigned)(cl + 1) && ++sp < (1u << 22)) __builtin_amdgcn_s_sleep(1); }
        asm volatile("" ::: "memory");
        const LAS unsigned char* rec = ring + slot * RW_PBB;
        bf16x8 a1[4], btf[2], ktf[2]; f32x4 gm[2][4];
#pragma unroll
        for (int ks = 0; ks < 4; ++ks) a1[ks] = *(const LAS bf16x8*)(rec + ks * 1024 + 16 * L);
        const bf16x8 a2 = *(const LAS bf16x8*)(rec + 4096 + 16 * L), mbr = *(const LAS bf16x8*)(rec + 9216 + 16 * L), vc = *(const LAS bf16x8*)(rec + 10240 + vt * 1024 + 16 * L);
#pragma unroll
        for (int kt = 0; kt < 2; ++kt) { btf[kt] = *(const LAS bf16x8*)(rec + 5120 + kt * 1024 + 16 * L); ktf[kt] = *(const LAS bf16x8*)(rec + 7168 + kt * 1024 + 16 * L);
#pragma unroll
            for (int q4 = 0; q4 < 4; ++q4) gm[kt][q4] = *(const LAS f32x4*)(rec + 12288 + 4 * (32 * kt + 8 * q4 + 4 * hh)); }
        LDS_WAIT(); asm volatile("" ::: "memory");
        if (L == 0) done[slot * 2 + vt] = (unsigned)(cl + 1);
        f32x16 acc;
#pragma unroll
        for (int e = 0; e < 16; ++e) acc[e] = 0.f;
        acc = MFMA32(a2, vc, acc);
#pragma unroll
        for (int ks = 0; ks < 4; ++ks) { const int kt = ks >> 1, b8 = 8 * (ks & 1);
            v4u w; w.x = cvt_pk_bf16(st[kt][b8], st[kt][b8 + 1]); w.y = cvt_pk_bf16(st[kt][b8 + 2], st[kt][b8 + 3]); w.z = cvt_pk_bf16(st[kt][b8 + 4], st[kt][b8 + 5]); w.w = cvt_pk_bf16(st[kt][b8 + 6], st[kt][b8 + 7]);
            acc = MFMA32(a1[ks], __builtin_bit_cast(bf16x8, w), acc); }
        v4u uw; uw.x = cvt_pk_bf16(acc[0], acc[1]); uw.y = cvt_pk_bf16(acc[2], acc[3]); uw.z = cvt_pk_bf16(acc[4], acc[5]); uw.w = cvt_pk_bf16(acc[6], acc[7]);
        const bf16x8 uf = __builtin_bit_cast(bf16x8, uw);
        acc = MFMA32(mbr, uf, acc);
#pragma unroll
        for (int kt = 0; kt < 2; ++kt) { st[kt] = MFMA32(btf[kt], uf, st[kt]); st[kt] = MFMA32(ktf[kt], vc, st[kt]);
#pragma unroll
            for (int q4 = 0; q4 < 4; ++q4) { st[kt][4 * q4] *= gm[kt][q4].x; st[kt][4 * q4 + 1] *= gm[kt][q4].y; st[kt][4 * q4 + 2] *= gm[kt][q4].z; st[kt][4 * q4 + 3] *= gm[kt][q4].w; } }
        const int c = seg * RW_CS + cl;
#pragma unroll
        for (int e = 8; e < 16; ++e) { const int t = (e & 3) + 8 * ((e >> 2) - 2) + 4 * hh, tau = 16 * c + t, pos = z ? (SEQ - 1 - tau) : tau; const size_t tok = (size_t)seq * SEQ + pos;
            YS[((size_t)z * T + tok) * 512 + h * 64 + 32 * vt + li] = (bf16)f2bf(acc[e]); }
    }
#pragma unroll
    for (int kt = 0; kt < 2; ++kt)
#pragma unroll
        for (int e = 0; e < 16; ++e) sts[(kt * 16 + e) * 64] = st[kt][e];
}

__device__ __forceinline__ void phase_rwkv_post(const Frame& F, const Args& a, int l) {
    const unsigned short* EA = (const unsigned short*)(F.ws + WS_AR + AR_EA); const unsigned short* RK = (const unsigned short*)(F.ws + WS_AR + AR_RKVK);
    const bf16* GT = (const bf16*)(F.ws + WS_AR + AR_GT); const float* YS = (const float*)(F.ws + WS_AR + AR_YS); const bf16* YSB = (const bf16*)(F.ws + WS_AR + AR_YSB); bf16* YC = (bf16*)(F.ws + WS_AR + AR_YC); (void)YS; (void)YSB;
    const float* k_a = a.in[F.z + 17] + (size_t)l * 512; const float* r_k = a.in[F.z + 18] + (size_t)l * 512; const float* ln_w = a.in[F.z + 19] + (size_t)l * 512; const float* ln_b = a.in[F.z + 20] + (size_t)l * 512;
    const int lane = F.lane, c0 = 8 * lane;
    for (int t = F.gw; t < T; t += F.NGW) {
        float y[8];
#if MK_CHUNKED
        { const v4u p = *(const v4u*)(YSB + (size_t)t * 512 + c0), q = *(const v4u*)(YSB + ((size_t)T + t) * 512 + c0);
#pragma unroll
          for (int i = 0; i < 4; ++i) { y[2 * i] = bf_lo(p[i]) + bf_lo(q[i]); y[2 * i + 1] = bf_hi(p[i]) + bf_hi(q[i]); } }
#else
        { const f32x4 p0 = *(const f32x4*)(YS + (size_t)t * 512 + c0), p1 = *(const f32x4*)(YS + (size_t)t * 512 + c0 + 4);
          const f32x4 q0 = *(const f32x4*)(YS + ((size_t)T + t) * 512 + c0), q1 = *(const f32x4*)(YS + ((size_t)T + t) * 512 + c0 + 4);
          y[0] = p0.x + q0.x; y[1] = p0.y + q0.y; y[2] = p0.z + q0.z; y[3] = p0.w + q0.w; y[4] = p1.x + q1.x; y[5] = p1.y + q1.y; y[6] = p1.z + q1.z; y[7] = p1.w + q1.w; }
#endif
        const v4u rr = *(const v4u*)(RK + (size_t)t * 2048 + c0), kk = *(const v4u*)(RK + (size_t)t * 2048 + 512 + c0), vv = *(const v4u*)(RK + (size_t)t * 2048 + 1024 + c0);
        const v4u a0 = *(const v4u*)(EA + (size_t)t * 2048 + 1024 + c0), a1 = *(const v4u*)(EA + (size_t)t * 2048 + 1536 + c0);
        const v4u gg = *(const v4u*)(GT + (size_t)t * 512 + c0);
        float r[8], k[8], v[8], aa0[8], aa1[8], g[8];
#pragma unroll
        for (int q = 0; q < 4; ++q) { r[2 * q] = h_lo(rr[q]); r[2 * q + 1] = h_hi(rr[q]); k[2 * q] = h_lo(kk[q]); k[2 * q + 1] = h_hi(kk[q]); v[2 * q] = h_lo(vv[q]); v[2 * q + 1] = h_hi(vv[q]);
            aa0[2 * q] = h_lo(a0[q]); aa0[2 * q + 1] = h_hi(a0[q]); aa1[2 * q] = h_lo(a1[q]); aa1[2 * q + 1] = h_hi(a1[q]); g[2 * q] = bf_lo(gg[q]); g[2 * q + 1] = bf_hi(gg[q]); }
        float s = 0.f, bon = 0.f;
#pragma unroll
        for (int e = 0; e < 8; ++e) { s += y[e]; const float kaa = k_a[c0 + e]; bon += r[e] * k[e] * r_k[c0 + e] * ((1.0f + (aa0[e] - 1.0f) * kaa) + (1.0f + (aa1[e] - 1.0f) * kaa)); }
        s += shfl_xor_(s, 1); s += shfl_xor_(s, 2); s += shfl_xor_(s, 4);
        bon += shfl_xor_(bon, 1); bon += shfl_xor_(bon, 2); bon += shfl_xor_(bon, 4);
        const float mu = s * (1.0f / 64.0f); float q2 = 0.f;
#pragma unroll
        for (int e = 0; e < 8; ++e) { const float d_ = y[e] - mu; q2 += d_ * d_; }
        q2 += shfl_xor_(q2, 1); q2 += shfl_xor_(q2, 2); q2 += shfl_xor_(q2, 4);
        const float rstd = 1.0f / sqrtf(q2 * (1.0f / 64.0f) + 64e-5f);
        float o[8];
#pragma unroll
        for (int e = 0; e < 8; ++e) o[e] = (((y[e] - mu) * rstd) * ln_w[c0 + e] + ln_b[c0 + e] + bon * v[e]) * g[e];
        v4u w; w.x = pk2(o[0], o[1]); w.y = pk2(o[2], o[3]); w.z = pk2(o[4], o[5]); w.w = pk2(o[6], o[7]);
        *(v4u*)(YC + (size_t)t * 512 + c0) = w;
    }
}

__device__ __forceinline__ void phase_attn(const Frame& F, const Args& a) {
    const bf16* QA = (const bf16*)(F.ws + WS_AR + AR_QA); const bf16* KA = (const bf16*)(F.ws + WS_AR + AR_KA); const bf16* VTA = (const bf16*)(F.ws + WS_AR + AR_VTA);
    bf16* OA = (bf16*)(F.ws + WS_AR + AR_OA); float* LSE = (float*)(F.ws + WS_AR + AR_LSE);
    constexpr int PLD = 336;
    LAS unsigned char* Pw = F.lds + RING_OFF + F.wave * (32 * PLD);
    const int lane = F.lane, li = lane & 31, hh = lane >> 5;
    for (int w = F.gw; w < 15360; w += F.NGW) {
        const int h = w & 3, pq = (w >> 2) & 127, rest = w >> 9, seq = rest % 10, g = rest / 10;
        const int d = (g == 0) ? 1 : (g == 1 ? 4 : 16), Lg = SEQ / d, nqb = Lg / 32, p = pq / nqb, qb = pq % nqb;
        const size_t base = (size_t)seq * SEQ + (size_t)p * Lg;
        const float slope = __builtin_amdgcn_exp2f(-8.0f * (float)(g * 4 + h + 1) / 12.0f) * (float)d;
        const bf16* Qg = QA + (size_t)g * T * 512; const bf16* Kg = KA + (size_t)g * T * 512; const bf16* Vg = VTA + (size_t)g * 512 * T;
        f32x16 x[5]; bool tv[5]; int sc_[5];
#pragma unroll
        for (int kt = 0; kt < 5; ++kt) { const int s_t = 32 * qb - 64 + 32 * kt; tv[kt] = (s_t >= 0) && (s_t < Lg); sc_[kt] = tv[kt] ? s_t : 32 * qb;
#pragma unroll
            for (int e = 0; e < 16; ++e) x[kt][e] = 0.f; }
        { bf16x8 ka[8], kb[8];
          { bf16x8 qf[8];
#pragma unroll
            for (int ks = 0; ks < 8; ++ks) qf[ks] = *(const bf16x8*)(Qg + (base + 32 * qb + li) * 512 + h * 128 + 16 * ks + 8 * hh);
#pragma unroll
            for (int ks = 0; ks < 8; ++ks) *(LAS bf16x8*)(Pw + li * PLD + (16 * ks + 8 * hh) * 2) = qf[ks]; }
#pragma unroll
          for (int ks = 0; ks < 8; ++ks) { ka[ks] = *(const bf16x8*)(Kg + (base + sc_[0] + li) * 512 + h * 128 + 16 * ks + 8 * hh); kb[ks] = *(const bf16x8*)(Kg + (base + sc_[1] + li) * 512 + h * 128 + 16 * ks + 8 * hh); }
          asm volatile("" ::: "memory");
          LDS_WAIT(); asm volatile("" ::: "memory");
#pragma unroll
          for (int ks = 0; ks < 8; ++ks) { const bf16x8 q = *(const LAS bf16x8*)(Pw + li * PLD + (16 * ks + 8 * hh) * 2); x[0] = MFMA32(ka[ks], q, x[0]); x[1] = MFMA32(kb[ks], q, x[1]); }
#pragma unroll
          for (int ks = 0; ks < 8; ++ks) { ka[ks] = *(const bf16x8*)(Kg + (base + sc_[2] + li) * 512 + h * 128 + 16 * ks + 8 * hh); kb[ks] = *(const bf16x8*)(Kg + (base + sc_[3] + li) * 512 + h * 128 + 16 * ks + 8 * hh); }
          asm volatile("" ::: "memory");
#pragma unroll
          for (int ks = 0; ks < 8; ++ks) { const bf16x8 q = *(const LAS bf16x8*)(Pw + li * PLD + (16 * ks + 8 * hh) * 2); x[2] = MFMA32(ka[ks], q, x[2]); x[3] = MFMA32(kb[ks], q, x[3]); }
#pragma unroll
          for (int ks = 0; ks < 8; ++ks) ka[ks] = *(const bf16x8*)(Kg + (base + sc_[4] + li) * 512 + h * 128 + 16 * ks + 8 * hh);
          asm volatile("" ::: "memory");
#pragma unroll
          for (int ks = 0; ks < 8; ++ks) { const bf16x8 q = *(const LAS bf16x8*)(Pw + li * PLD + (16 * ks + 8 * hh) * 2); x[4] = MFMA32(ka[ks], q, x[4]); }
          LDS_WAIT(); asm volatile("" ::: "memory");
        }
#define ATT_VLOAD(VF, dt_) do { _Pragma("unroll") for (int kt = 0; kt < 5; ++kt) _Pragma("unroll") for (int k2 = 0; k2 < 2; ++k2) \
            VF[kt][k2] = *(const bf16x8*)(Vg + (size_t)(h * 128 + (dt_) * 32 + li) * T + base + sc_[kt] + 16 * k2 + 8 * hh); } while (0)
        bf16x8 vfA[5][2], vfB[5][2];
        ATT_VLOAD(vfA, 0); asm volatile("" ::: "memory");
        float mx = -1e30f;
#pragma unroll
        for (int kt = 0; kt < 5; ++kt)
#pragma unroll
            for (int e = 0; e < 16; ++e) { const int j = (e & 3) + 8 * (e >> 2) + 4 * hh; const int rel = 32 * kt - 64 + j - li; const int ar = rel < 0 ? -rel : rel;
                const bool ok = tv[kt] && ar <= 64; const float sv = ok ? (x[kt][e] - slope * (float)ar) : -1e30f; x[kt][e] = sv; mx = fmaxf(mx, sv); }
        mx = fmaxf(mx, shfl_xor_(mx, 32));
        float sum = 0.f;
#pragma unroll
        for (int kt = 0; kt < 5; ++kt)
#pragma unroll
            for (int e = 0; e < 16; ++e) { const float pv = (x[kt][e] > -1e29f) ? fexp(x[kt][e] - mx) : 0.f; x[kt][e] = pv; sum += pv; }
        sum += shfl_xor_(sum, 32);
        const float inv = 1.0f / sum;
        if (hh == 0) { const size_t tok = (size_t)seq * SEQ + (size_t)(32 * qb + li) * d + p; LSE[((size_t)g * T + tok) * 4 + h] = mx + __builtin_amdgcn_logf(sum) * 0.69314718056f; }
#pragma unroll
        for (int kt = 0; kt < 5; ++kt)
#pragma unroll
            for (int q4 = 0; q4 < 4; ++q4) { v2u pw; pw.x = cvt_pk_bf16(x[kt][4 * q4] * inv, x[kt][4 * q4 + 1] * inv); pw.y = cvt_pk_bf16(x[kt][4 * q4 + 2] * inv, x[kt][4 * q4 + 3] * inv);
                *(LAS v2u*)(Pw + li * PLD + (kt * 32 + 8 * q4 + 4 * hh) * 2) = pw; }
        LDS_WAIT(); asm volatile("" ::: "memory");
#define ATT_PV(VF, dt_) do { f32x16 o; _Pragma("unroll") for (int e = 0; e < 16; ++e) o[e] = 0.f; \
            _Pragma("unroll") for (int kt = 0; kt < 5; ++kt) _Pragma("unroll") for (int k2 = 0; k2 < 2; ++k2) { const bf16x8 pf = *(const LAS bf16x8*)(Pw + li * PLD + (kt * 32 + 16 * k2 + 8 * hh) * 2); o = MFMA32(pf, VF[kt][k2], o); } \
            _Pragma("unroll") for (int e = 0; e < 16; ++e) { const int i = (e & 3) + 8 * (e >> 2) + 4 * hh; const size_t tok = (size_t)seq * SEQ + (size_t)(32 * qb + i) * d + p; \
                OA[((size_t)g * T + tok) * 512 + h * 128 + (dt_) * 32 + li] = (bf16)f2bf(o[e]); } } while (0)
        ATT_VLOAD(vfB, 1); asm volatile("" ::: "memory"); ATT_PV(vfA, 0);
        ATT_VLOAD(vfA, 2); asm volatile("" ::: "memory"); ATT_PV(vfB, 1);
        ATT_VLOAD(vfB, 3); asm volatile("" ::: "memory"); ATT_PV(vfA, 2);
        ATT_PV(vfB, 3);
#undef ATT_PV
#undef ATT_VLOAD
        LDS_WAIT(); asm volatile("" ::: "memory");
    }
}
__device__ __forceinline__ void phase_attn_post(const Frame& F, const Args& a) {
    const bf16* OA = (const bf16*)(F.ws + WS_AR + AR_OA); const float* LSE = (const float*)(F.ws + WS_AR + AR_LSE); bf16* YA = (bf16*)(F.ws + WS_AR + AR_YA);
    const int lane = F.lane, c0 = 8 * lane, h = lane >> 4;
    for (int t = F.gw; t < T; t += F.NGW) {
        const float l0 = LSE[((size_t)0 * T + t) * 4 + h], l1 = LSE[((size_t)1 * T + t) * 4 + h], l2 = LSE[((size_t)2 * T + t) * 4 + h];
        const float m = fmaxf(l0, fmaxf(l1, l2)); float w0 = fexp(l0 - m), w1 = fexp(l1 - m), w2 = fexp(l2 - m); const float inv = 1.0f / (w0 + w1 + w2); w0 *= inv; w1 *= inv; w2 *= inv;
        const v4u o0 = *(const v4u*)(OA + ((size_t)0 * T + t) * 512 + c0), o1 = *(const v4u*)(OA + ((size_t)1 * T + t) * 512 + c0), o2 = *(const v4u*)(OA + ((size_t)2 * T + t) * 512 + c0);
        v4u w;
#pragma unroll
        for (int q = 0; q < 4; ++q) w[q] = pk2(w0 * bf_lo(o0[q]) + w1 * bf_lo(o1[q]) + w2 * bf_lo(o2[q]), w0 * bf_hi(o0[q]) + w1 * bf_hi(o1[q]) + w2 * bf_hi(o2[q]));
        *(v4u*)(YA + (size_t)t * 512 + c0) = w;
    }
}

__device__ __forceinline__ void phase_ret_kv(const Frame& F) {
    const bf16* RKT = (const bf16*)(F.ws + WS_AR + AR_RKT); const bf16* RVT = (const bf16*)(F.ws + WS_AR + AR_RVT); bf16* SB = (bf16*)(F.ws + WS_AR + AR_SB);
    const int lane = F.lane, li = lane & 31, hh = lane >> 5, w = F.wave;
    for (int it = F.bid; it < 1280; it += F.G) {
        const int n = it & 31, h = (it >> 5) & 3, seq = it >> 7; const size_t tok0 = (size_t)seq * SEQ + 128 * n;
        const bf16* vrow = RVT + (size_t)(h * 256 + 32 * w + li) * T + tok0 + 8 * hh;
        bf16x8 vf[8];
#pragma unroll
        for (int ks = 0; ks < 8; ++ks) vf[ks] = *(const bf16x8*)(vrow + 16 * ks);
        bf16* sbase = SB + ((size_t)((seq * 4 + h) * 32 + n) * 256 + 32 * w) * 256;
#pragma unroll 1
        for (int t4 = 0; t4 < 4; ++t4) {
            const int z = t4 >> 1, dk0 = 2 * (t4 & 1);
            const bf16* krow = RKT + (size_t)(z * 512 + h * 128 + 32 * dk0 + li) * T + tok0 + 8 * hh;
            bf16x8 kfa[8], kfb[8];
#pragma unroll
            for (int ks = 0; ks < 8; ++ks) { kfa[ks] = *(const bf16x8*)(krow + 16 * ks); kfb[ks] = *(const bf16x8*)(krow + (size_t)32 * T + 16 * ks); }
            asm volatile("" ::: "memory");
            f32x16 acc0, acc1;
#pragma unroll
            for (int e = 0; e < 16; ++e) { acc0[e] = 0.f; acc1[e] = 0.f; }
#pragma unroll
            for (int ks = 0; ks < 8; ++ks) { acc0 = MFMA32(vf[ks], kfa[ks], acc0); acc1 = MFMA32(vf[ks], kfb[ks], acc1); }
#pragma unroll
            for (int e = 0; e < 16; ++e) { const int dv = (e & 3) + 8 * (e >> 2) + 4 * hh; sbase[(size_t)dv * 256 + z * 128 + 32 * dk0 + li] = (bf16)f2bf(acc0[e]); sbase[(size_t)dv * 256 + z * 128 + 32 * dk0 + 32 + li] = (bf16)f2bf(acc1[e]); }
        }
    }
}
__device__ __forceinline__ void phase_ret_prefix(const Frame& F, const Args& a, int l) {
    bf16* SB = (bf16*)(F.ws + WS_AR + AR_SB); const float* dlog = a.in[F.z + 8] + (size_t)l * 8;
    const int gt = F.bid * NTHR + F.tid, NGT = F.G * NTHR;
    for (int i = gt; i < 40 * 8192; i += NGT) {
        const int p = i >> 13, v = i & 8191, h = p & 3, z = (v >> 4) & 1;
        const float lg = dlog[z * 4 + h]; const float g = __builtin_amdgcn_exp2f(-__builtin_amdgcn_logf(1.0f + fexp(-lg)) * 128.0f);
        bf16* base = SB + (size_t)p * 32 * 65536 + (size_t)v * 8;
        float carry[8];
#pragma unroll
        for (int e = 0; e < 8; ++e) carry[e] = 0.f;
#pragma unroll 4
        for (int st = 0; st < 32; ++st) {
            const int n = z ? (31 - st) : st; v4u* ptr = (v4u*)(base + (size_t)n * 65536);
            const v4u kv = *ptr; v4u o;
#pragma unroll
            for (int q = 0; q < 4; ++q) { o[q] = pk2(carry[2 * q], carry[2 * q + 1]); carry[2 * q] = g * carry[2 * q] + bf_lo(kv[q]); carry[2 * q + 1] = g * carry[2 * q + 1] + bf_hi(kv[q]); }
            *ptr = o;
        }
    }
}
__device__ __forceinline__ void phase_ret_state(const Frame& F, const Args& a, int l) {
    const bf16* RKT = (const bf16*)(F.ws + WS_AR + AR_RKT); const bf16* RVT = (const bf16*)(F.ws + WS_AR + AR_RVT); bf16* SB = (bf16*)(F.ws + WS_AR + AR_SB);
    const float* dlog = a.in[F.z + 8] + (size_t)l * 8;
    const int lane = F.lane, li = lane & 31, hh = lane >> 5;
    if (F.wave >= 5) return;
    for (int q = F.bid * 5 + F.wave; q < 1280; q += F.G * 5) {
        const int kh = q & 1, dt = (q >> 1) & 7, z = (q >> 4) & 1, h = (q >> 5) & 3, seq = q >> 7;
        const float g = __builtin_amdgcn_exp2f(-__builtin_amdgcn_logf(1.0f + fexp(-dlog[z * 4 + h])) * 128.0f);
        const bf16* krow = RKT + (size_t)(z * 512 + h * 128 + 64 * kh + rperm(li)) * T + (size_t)seq * SEQ + 8 * hh;
        const bf16* vrow = RVT + (size_t)(h * 256 + 32 * dt + li) * T + (size_t)seq * SEQ + 8 * hh;
        bf16* srow = SB + ((size_t)((seq * 4 + h) * 32) * 256 + 32 * dt + li) * 256 + z * 128 + 64 * kh + 8 * hh;
        f32x16 acc0, acc1;
#pragma unroll
        for (int e = 0; e < 16; ++e) { acc0[e] = 0.f; acc1[e] = 0.f; }
        bf16x8 vf[8], kfa[8], kfb[8];
        { const int n0 = z ? 31 : 0;
#pragma unroll
          for (int ks = 0; ks < 8; ++ks) { vf[ks] = *(const bf16x8*)(vrow + 128 * n0 + 16 * ks); kfa[ks] = *(const bf16x8*)(krow + 128 * n0 + 16 * ks); kfb[ks] = *(const bf16x8*)(krow + (size_t)32 * T + 128 * n0 + 16 * ks); } }
#pragma unroll 1
        for (int st = 0; st < 32; ++st) {
            const int n = z ? (31 - st) : st; const int st1 = st < 31 ? st + 1 : 31, nn = z ? (31 - st1) : st1;
            bf16* sp = srow + (size_t)n * 65536;
            *(v4u*)sp = pk8(acc0, 0); *(v4u*)(sp + 16) = pk8(acc0, 8); *(v4u*)(sp + 32) = pk8(acc1, 0); *(v4u*)(sp + 48) = pk8(acc1, 8);
#pragma unroll
            for (int e = 0; e < 16; ++e) { acc0[e] *= g; acc1[e] *= g; }
#pragma unroll
            for (int ks = 0; ks < 8; ++ks) acc0 = MFMA32(kfa[ks], vf[ks], acc0);
#pragma unroll
            for (int ks = 0; ks < 8; ++ks) kfa[ks] = *(const bf16x8*)(krow + 128 * nn + 16 * ks);
#pragma unroll
            for (int ks = 0; ks < 8; ++ks) acc1 = MFMA32(kfb[ks], vf[ks], acc1);
#pragma unroll
            for (int ks = 0; ks < 8; ++ks) { kfb[ks] = *(const bf16x8*)(krow + (size_t)32 * T + 128 * nn + 16 * ks); vf[ks] = *(const bf16x8*)(vrow + 128 * nn + 16 * ks); }
        }
    }
}
__device__ __forceinline__ void phase_ret_out(const Frame& F, const Args& a, int l) {
    const bf16* RQ = (const bf16*)(F.ws + WS_AR + AR_RQ); const bf16* RKm = (const bf16*)(F.ws + WS_AR + AR_RK); const bf16* RVT = (const bf16*)(F.ws + WS_AR + AR_RVT);
    const bf16* RG = (const bf16*)(F.ws + WS_AR + AR_RG); const bf16* SB = (const bf16*)(F.ws + WS_AR + AR_SB); bf16* YB = (bf16*)(F.ws + WS_AR + AR_YB);
    const float* dlog = a.in[F.z + 8] + (size_t)l * 8; const float* rn = a.in[F.z + 9] + (size_t)l * 1024;
    constexpr int PLD = 272;
    LAS unsigned char* Pl = F.lds + RING_OFF;
    LAS f32x2* SX = (LAS f32x2*)(F.lds + RING_OFF + 4 * 32 * PLD);
    const int lane = F.lane, li = lane & 31, hh = lane >> 5, w = F.wave, qi = w & 3, dj = w >> 2;
    LAS unsigned char* stg = F.lds + RING_OFF + 40960 + w * (32 * PLD);
    for (int it = F.bid; it < 1280; it += F.G) {
        const int n = it & 31, h = (it >> 5) & 3, seq = it >> 7; const size_t tok0 = (size_t)seq * SEQ + 128 * n;
        const float l2g0 = -__builtin_amdgcn_logf(1.0f + fexp(-dlog[h])), l2g1 = -__builtin_amdgcn_logf(1.0f + fexp(-dlog[4 + h]));
        __syncthreads();
        const bf16* qrow = RQ + (tok0 + 32 * qi + li) * 512 + h * 128 + 8 * hh;
        bf16x8 qf[8];
#pragma unroll
        for (int ks = 0; ks < 8; ++ks) qf[ks] = *(const bf16x8*)(qrow + 16 * ks);
        const int ip = 32 * qi + li;
#pragma unroll 1
        for (int k2 = 0; k2 < 2; ++k2) {
            const int kt = 2 * dj + k2;
            const bf16* krow_ = RKm + (tok0 + 32 * kt + li) * 512 + h * 128 + 8 * hh;
            f32x16 x;
#pragma unroll
            for (int e = 0; e < 16; ++e) x[e] = 0.f;
#pragma unroll
            for (int ks = 0; ks < 8; ++ks) { const bf16x8 kf = *(const bf16x8*)(krow_ + 16 * ks); x = MFMA32(kf, qf[ks], x); }
#pragma unroll
            for (int q4 = 0; q4 < 4; ++q4) {
                float pv[4];
#pragma unroll
                for (int e = 0; e < 4; ++e) { const int jp = 32 * kt + e + 8 * q4 + 4 * hh; const int df = ip - jp;
                    const float f0 = (df >= 0) ? __builtin_amdgcn_exp2f(l2g0 * (float)df) : 0.f, f1 = (df <= 0) ? __builtin_amdgcn_exp2f(l2g1 * (float)(-df)) : 0.f;
                    pv[e] = x[4 * q4 + e] * (f0 + f1); }
                v2u pw; pw.x = cvt_pk_bf16(pv[0], pv[1]); pw.y = cvt_pk_bf16(pv[2], pv[3]);
                *(LAS v2u*)(Pl + (qi * 32 + li) * PLD + (kt * 32 + 8 * q4 + 4 * hh) * 2) = pw;
            }
        }
        LDS_WAIT(); __syncthreads();
        const float e0 = l2g0 * (float)(ip + 1), e1 = l2g1 * (float)(128 - ip);
        const float ratio = __builtin_amdgcn_exp2f(e0 - e1), xi1 = __builtin_amdgcn_exp2f(e1);
        f32x16 o[4]; float s1 = 0.f, s2 = 0.f;
#pragma unroll
        for (int dt = 0; dt < 4; ++dt) {
            const int dvr = 128 * dj + 32 * dt + li;
            const bf16* srow = SB + ((size_t)((seq * 4 + h) * 32 + n) * 256 + dvr) * 256 + 8 * hh;
            const bf16* vrow = RVT + (size_t)(h * 256 + dvr) * T + tok0 + 8 * hh;
            f32x16 acc;
#pragma unroll
            for (int e = 0; e < 16; ++e) acc[e] = 0.f;
            bf16x8 s0f[8], s1f[8], vff[8];
#pragma unroll
            for (int ks = 0; ks < 8; ++ks) { s0f[ks] = *(const bf16x8*)(srow + 16 * ks); s1f[ks] = *(const bf16x8*)(srow + 128 + 16 * ks); vff[ks] = *(const bf16x8*)(vrow + 16 * ks); }
            asm volatile("" ::: "memory");
#pragma unroll
            for (int ks = 0; ks < 8; ++ks) acc = MFMA32(s0f[ks], qf[ks], acc);
#pragma unroll
            for (int e = 0; e < 16; ++e) acc[e] *= ratio;
#pragma unroll
            for (int ks = 0; ks < 8; ++ks) acc = MFMA32(s1f[ks], qf[ks], acc);
#pragma unroll
            for (int e = 0; e < 16; ++e) acc[e] *= xi1;
#pragma unroll
            for (int ks = 0; ks < 8; ++ks) { const bf16x8 pf = *(const LAS bf16x8*)(Pl + (qi * 32 + li) * PLD + (16 * ks + 8 * hh) * 2); acc = MFMA32(vff[ks], pf, acc); }
#pragma unroll
            for (int e = 0; e < 16; ++e) { s1 += acc[e]; s2 += acc[e] * acc[e]; }
            o[dt] = acc;
        }
        s1 += shfl_xor_(s1, 32); s2 += shfl_xor_(s2, 32);
        if (hh == 0) SX[(dj * 4 + qi) * 32 + li] = (f32x2){s1, s2};
        LDS_WAIT(); __syncthreads();
        { const f32x2 ot = SX[((dj ^ 1) * 4 + qi) * 32 + li]; s1 += ot.x; s2 += ot.y; }
        const float mu = s1 * (1.0f / 256.0f); const float var = fmaxf(s2 * (1.0f / 256.0f) - mu * mu, 0.f); const float rstd = 1.0f / sqrtf(var + 1e-5f);
#pragma unroll
        for (int dt = 0; dt < 4; ++dt)
#pragma unroll
            for (int q4 = 0; q4 < 4; ++q4) { v2u pw; pw.x = cvt_pk_bf16((o[dt][4 * q4] - mu) * rstd, (o[dt][4 * q4 + 1] - mu) * rstd); pw.y = cvt_pk_bf16((o[dt][4 * q4 + 2] - mu) * rstd, (o[dt][4 * q4 + 3] - mu) * rstd);
                *(LAS v2u*)(stg + li * PLD + (32 * dt + 8 * q4 + 4 * hh) * 2) = pw; }
        LDS_WAIT(); asm volatile("" ::: "memory");
#pragma unroll
        for (int j = 0; j < 8; ++j) {
            const int idx = lane + 64 * j, q = idx >> 4, cv = idx & 15, col = h * 256 + 128 * dj + 8 * cv;
            const v4u ov = *(const LAS v4u*)(stg + q * PLD + cv * 16);
            const size_t tok = tok0 + 32 * qi + q;
            const v4u gv = *(const v4u*)(RG + tok * 1024 + col);
            const f32x4 r0 = *(const f32x4*)(rn + col), r1 = *(const f32x4*)(rn + col + 4);
            const float rr[8] = {r0.x, r0.y, r0.z, r0.w, r1.x, r1.y, r1.z, r1.w};
            v4u wv;
#pragma unroll
            for (int q2 = 0; q2 < 4; ++q2) { const float ga = bf_lo(gv[q2]), gb = bf_hi(gv[q2]);
                wv[q2] = pk2(ga * fsigmoid(ga) * bf_lo(ov[q2]) * rr[2 * q2], gb * fsigmoid(gb) * bf_hi(ov[q2]) * rr[2 * q2 + 1]); }
            *(v4u*)(YB + tok * 1024 + col) = wv;
        }
    }
    __syncthreads();
}
__device__ __forceinline__ void phase_zero(const Frame& F, void* p, size_t bytes) {
    v4u* q = (v4u*)p; const v4u z = {0u, 0u, 0u, 0u};
    for (size_t i = (size_t)F.bid * NTHR + F.tid; i < bytes / 16; i += (size_t)F.G * NTHR) q[i] = z;
}

__global__ void __launch_bounds__(NTHR, 2) mk_fwd(Args args) {
    extern __shared__ __attribute__((aligned(16))) unsigned char lds[];
    {
        const int t0 = threadIdx.x;
        for (int u = t0; u < (LDS_BYTES - LDSCTL_OFF) / 4; u += NTHR) ((LAS unsigned*)((LAS unsigned char*)lds + LDSCTL_OFF))[u] = 0u;
        __syncthreads();
    }
    XcdBarrier bar; bar.bar = (unsigned*)(args.ws + WS_CTL) + CW_BAR; bar.x = 0; bar.st = nullptr;
#if !MK_PER_PHASE_LAUNCH
    bar = xcd_barrier_post((unsigned*)(args.ws + WS_CTL) + CW_BAR, (volatile LAS unsigned*)((LAS unsigned char*)lds + MISC_OFF) + 8);
#endif
    const int wave_s = __builtin_amdgcn_readfirstlane((int)(threadIdx.x >> 6));
    const int lo = args.ph_lo, hi = args.ph_hi;
    int pc = 0;
#define PH_ON (pc >= lo && pc < hi)
#if MK_PER_PHASE_LAUNCH
#define PH_END do { ++pc; } while (0)
#else
#ifdef MK_NOBAR
#define PH_END do { __syncthreads(); ++pc; } while (0)
#else
#define PH_END do { if (pc >= lo && pc + 1 < hi) xcd_barrier(bar, wave_s == 0 && lane_id() == 0); ++pc; } while (0)
#endif
#endif
#define PH_REP(k) _Pragma("nounroll") for (int rep_ = 0; rep_ < (((MK_REPMASK) >> (k)) & 1) + 1; ++rep_)
#define PH_REPBAR(k) if ((((MK_REPMASK) >> (k)) & 1) && rep_ == 0) xcd_barrier(bar, wave_s == 0 && lane_id() == 0)
#define WTH wt
#define PH_FRAME Frame F; int z_; asm volatile("s_mov_b32 %0, 0" : "=s"(z_)); { int t_ = wave_s * 64 + lane_id(); asm volatile("" : "+v"(t_)); unsigned char* w_ = (unsigned char*)(GAS unsigned char*)ld_karg64(248); F.lds = (LAS unsigned char*)lds; F.ws = w_; F.z = z_; F.tid = t_; F.lane = t_ & 63; \
        F.wave = __builtin_amdgcn_readfirstlane(t_ >> 6); { int g_ = __builtin_amdgcn_readfirstlane((int)gridDim.x), b_ = __builtin_amdgcn_readfirstlane((int)blockIdx.x), g2_, b2_; asm volatile("s_mov_b32 %0, %2\n\ts_mov_b32 %1, %3" : "=&s"(g2_), "=&s"(b2_) : "s"(g_), "s"(b_)); F.G = g2_; F.bid = b2_; } F.gw = F.bid * NWAVES + F.wave; F.NGW = F.G * NWAVES; } \
        unsigned char* const wt = F.ws + WS_WT; unsigned char* const ar = F.ws + WS_AR; bf16* const XN = (bf16*)(F.ws + WS_XN); LAS unsigned char* const ring = F.lds + RING_OFF; \
        bf16* X = (bf16*)((GAS unsigned char*)ld_karg64(240) + XB_OFF); const int c = F.bid; (void)wt; (void)ar; (void)XN; (void)ring; (void)c;

#pragma nounroll
    for (int l = 0; l < DEPTH; ++l) {
        const bool ovl = gridDim.x > 160;
        if (l == 0 || !ovl) {
            if (PH_ON) { PH_FRAME; phase_wconv(F, args, l, wt, wt, ovl ? 1 : 3);
                if (l == 0) phase_norm_in(F, args.in[z_ + 0], args.in[z_ + 1], args.in[z_ + 2], XN, X); }
            PH_END;
        }
#pragma nounroll
        for (int f = 0; f < 2; ++f) {
            if (!(l == 0 && f == 0)) {
                if (PH_ON) { PH_FRAME; phase_norm(F, X, args.in[z_ + (f ? 25 : 2)] + (size_t)l * D, XN); }
                PH_END;
            }
#pragma nounroll
            for (int ck = 0; ck < FFN_NCK; ++ck) {
                const int r0 = ck * FFN_MC, mc = (T - r0 < FFN_MC) ? (T - r0) : FFN_MC;
                PH_REP(0) { if (PH_ON) { PH_FRAME;
                    SchedPlain S{(const char*)(XN + (size_t)r0 * D), (const char*)(f ? WTH + WO_UP2 : wt + WO_UP1), D, D, D, mc / 256, 44, F.G, c, 8};
                    EpiSwiglu E{(bf16*)(ar + AR_H)};
                    pg8::gemm_phase<EpiSwiglu, SchedPlain>(ring, S, E, F.tid);
                } PH_REPBAR(0); }
                PH_END;
                if (PH_ON) { PH_FRAME;
                    SchedPlain S{(const char*)(ar + AR_H), (const char*)(f ? WTH + WO_DN2 : wt + WO_DN1), FF, FF, FF, mc / 256, 8, F.G, c, MK_WGM_DN};
                    { const bool lastf = (l == DEPTH - 1 && f == 1);
                        EpiResid E{(lastf ? (bf16*)(ar + AR_XF) : X) + (size_t)r0 * D, X + (size_t)r0 * D, 0.5f};
                    pg8::gemm_phase<EpiResid, SchedPlain>(ring, S, E, F.tid); }
                }
                PH_END;
            }
            if (f == 0) {
                if (PH_ON) { PH_FRAME; phase_norm(F, X, args.in[z_ + 6] + (size_t)l * D, XN); }
                PH_END;
#if (MK_MIXER & 1)
                PH_REP(1) { if (PH_ON) { PH_FRAME;
                    SchedCF S{SchedPlain{(const char*)XN, (const char*)(WTH + WO_CF), D, D, D, 160, 8, F.G, c, 8}, (char*)(ar + AR_CF)};
                    EpiStore<1> E{nullptr, nullptr, nullptr};
                    pg8::gemm_phase<EpiStore<1>, SchedCF>(ring, S, E, F.tid);
                } PH_REPBAR(1); }
                PH_END;
                if (PH_ON) { PH_FRAME; phase_rwkv_pre(F, args, l); }
                PH_END;
                if (PH_ON) { PH_FRAME;
                    SchedLR S{SchedPlain{(const char*)(ar + AR_LR), (const char*)(WTH + WO_LR), 384, 384, 384, 160, 10, F.G, c, 8}, (char*)(ar + AR_EA), (char*)(ar + AR_GT)};
                    EpiStore<0x70> E{args.in[z_ + 11] + (size_t)l * 1024, args.in[z_ + 13] + (size_t)l * 1024, nullptr};
                    pg8::gemm_phase<EpiStore<0x70>, SchedLR>(ring, S, E, F.tid);
                }
                PH_END;
#if MK_CHUNKED && MK_FUSED_RWKV
                if (PH_ON) { PH_FRAME; phase_rwkv_fused(F, args, l);
                    if (F.bid >= 160) {
                        Frame F2 = F; F2.bid = F.bid - 160; F2.G = F.G - 160; F2.gw = F2.bid * NWAVES + F.wave; F2.NGW = F2.G * NWAVES;
                        phase_wconv(F2, args, l, wt, wt, 2);
                        if (l + 1 < DEPTH) phase_wconv(F2, args, l + 1, wt, wt, 1); } }
                PH_END;
#elif MK_CHUNKED
#pragma nounroll
                for (int seg = 0; seg < RW_NSEG; ++seg) {
                    if (PH_ON) { PH_FRAME; phase_rwkv_prep(F, args, l, seg); }
                    PH_END;
                    if (PH_ON) { PH_FRAME; phase_rwkv_cscan(F, seg); }
                    PH_END;
                }
#else
                if (PH_ON) { PH_FRAME; phase_rwkv_scan(F, args, l); }
                PH_END;
#endif
                if (PH_ON) { PH_FRAME; phase_rwkv_post(F, args, l); }
                PH_END;
#else
                if (PH_ON) { PH_FRAME; phase_zero(F, ar + AR_YC, (size_t)T * 512 * 2); }
                PH_END;
#endif
#if (MK_MIXER & 2)
                PH_REP(2) { if (PH_ON) { PH_FRAME;
                    SchedAtt S{(const char*)XN, (const char*)WTH, (char*)ar, F.G, c};
                    EpiStore<7> E{nullptr, nullptr, args.in[z_ + 8] + (size_t)l * 8};
                    pg8::gemm_phase<EpiStore<7>, SchedAtt>(ring, S, E, F.tid);
                } PH_REPBAR(2); }
                PH_END;
                if (PH_ON) { PH_FRAME; phase_attn(F, args); }
                PH_END;
#if !(MK_MIXER & 4)
                if (PH_ON) { PH_FRAME; phase_attn_post(F, args); }
                PH_END;
#endif
#else
                if (PH_ON) { PH_FRAME; phase_zero(F, ar + AR_YA, (size_t)T * 512 * 2); }
                PH_END;
#endif
#if (MK_MIXER & 4)
                PH_REP(3) { if (PH_ON) { PH_FRAME;
#if (MK_MIXER & 2)
                    if (rep_ == 0) phase_attn_post(F, args);
                    __syncthreads();
#endif
                    SchedRet S{(const char*)XN, (const char*)(WTH + WO_RET), (char*)ar, F.G, c};
                    EpiStore<1> E{nullptr, nullptr, nullptr};
                    pg8::gemm_phase<EpiStore<1>, SchedRet>(ring, S, E, F.tid);
                } PH_REPBAR(3); }
                PH_END;
                if (PH_ON) { PH_FRAME; phase_ret_state(F, args, l); }
                PH_END;
                if (PH_ON) { PH_FRAME; phase_ret_out(F, args, l); }
                PH_END;
#else
                if (PH_ON) { PH_FRAME; phase_zero(F, ar + AR_YB, (size_t)T * 1024 * 2); }
                PH_END;
#endif
                PH_REP(4) { if (PH_ON) { PH_FRAME;
                    SchedMerge S{(const char*)XN, (const char*)ar, (const char*)WTH, F.G, c};
                    v4u* scr = (v4u*)(ar + AR_SCR) + (size_t)F.bid * 2 * 16 * NTHR;
                    EpiMerge E{scr, scr + 16 * NTHR, (bf16*)(ar + AR_MG)};
                    pg8::gemm_phase<EpiMerge, SchedMerge>(ring, S, E, F.tid);
                } PH_REPBAR(4); }
                PH_END;
                if (PH_ON) { PH_FRAME;
                    SchedPlain S{(const char*)(ar + AR_MG), (const char*)(WTH + WO_OUT), D, D, D, 160, 8, F.G, c, 8};
                    { EpiResid E{X, X, 1.0f};
                    pg8::gemm_phase<EpiResid, SchedPlain>(ring, S, E, F.tid); }
                }
                PH_END;
            }
        }
    }
    if (PH_ON) { PH_FRAME; phase_final_norm(F, (const bf16*)(ar + AR_XF), args.in[z_ + 29], (float*)(GAS float*)ld_karg64(240)); }
    ++pc;
#undef PH_ON
#undef PH_END
#undef PH_FRAME
}

extern "C" void kernel_launch(void* const* d_in, const int* in_sizes, int n_in, void* d_out, int out_size, void* d_ws, size_t ws_size, hipStream_t stream) {
    static int grid = 0;
    if (grid == 0) {
        if (n_in != 30 || out_size != T * D || ws_size < WS_END) { fprintf(stderr, "kernel_launch: unexpected shapes (n_in %d, out %d, ws %zu < %zu); nothing launched\n", n_in, out_size, ws_size, (size_t)WS_END); grid = -1; return; }
        int dev = 0, cus = 0, per_cu = 0;
        if (hipGetDevice(&dev) != hipSuccess || hipDeviceGetAttribute(&cus, hipDeviceAttributeMultiprocessorCount, dev) != hipSuccess) { grid = -1; return; }
        if (hipFuncSetAttribute((const void*)mk_fwd, hipFuncAttributeMaxDynamicSharedMemorySize, LDS_BYTES) != hipSuccess) { fprintf(stderr, "kernel_launch: hipFuncSetAttribute failed\n"); grid = -1; return; }
        if (hipOccupancyMaxActiveBlocksPerMultiprocessor(&per_cu, (const void*)mk_fwd, NTHR, LDS_BYTES) != hipSuccess || per_cu < 1) { fprintf(stderr, "kernel_launch: occupancy query reports %d\n", per_cu); }
        (void)hipGetLastError();
        grid = cus;
#ifdef MK_GRID
        grid = MK_GRID;
#endif
    }
    if (grid < 0) return;
    hipMemsetAsync((char*)d_ws + WS_CTL, 0, CTL_ZERO_BYTES, stream);
    Args a{};
    for (int i = 0; i < 30; ++i) a.in[i] = (const float*)d_in[i];
    a.out = (float*)d_out; a.ws = (unsigned char*)d_ws;
#if MK_PER_PHASE_LAUNCH
#ifndef MK_NPH
#define MK_NPH 2
#endif
    for (int p = 0; p < MK_NPH; ++p) {    a.ph_lo = p; a.ph_hi = p + 1; hipLaunchKernelGGL(mk_fwd, dim3(grid), dim3(NTHR), LDS_BYTES, stream, a); }
#else
#ifdef MK_NPH1
    a.ph_lo = 0; a.ph_hi = MK_NPH1;
#else
    a.ph_lo = 0; a.ph_hi = 1 << 30;
#endif
    hipLaunchKernelGGL(mk_fwd, dim3(grid), dim3(NTHR), LDS_BYTES, stream, a);
#endif
}
```

```cpp
#include <hip/hip_runtime.h>
#include <cstdio>
#include <cstdint>

#ifndef MK_PER_PHASE_LAUNCH
#define MK_PER_PHASE_LAUNCH 0
#endif
#ifndef MK_REP_SCAN
#define MK_REP_SCAN 1
#endif
#ifndef MK_REP_ATT
#define MK_REP_ATT 1
#endif
#ifndef MK_REP_RET
#define MK_REP_RET 1
#endif
#ifndef MK_REP_EW
#define MK_REP_EW 1
#endif
#ifndef MK_REP_UP
#define MK_REP_UP 1
#endif
#ifndef MK_PROBE_RESID
#define MK_PROBE_RESID 0
#endif
#ifndef MK_REP_PROJ
#define MK_REP_PROJ 1
#endif
#ifndef MK_REP_MG
#define MK_REP_MG 1
#endif
#ifndef MK_REP_DN
#define MK_REP_DN 1
#endif
#ifndef MK_REP_OUT
#define MK_REP_OUT 1
#endif
#ifndef MK_REPMASK
#define MK_REPMASK 0
#endif
#ifndef MK_FUSED_RWKV
#define MK_FUSED_RWKV 1
#endif
#ifndef MK_WGM_DN
#define MK_WGM_DN 4
#endif
#ifndef MK_CHUNKED
#define MK_CHUNKED 1
#endif
#ifndef MK_MIXER
#define MK_MIXER 7
#endif

constexpr int T = 40960, D = 2048, FF = 5632, SEQ = 4096, NSEQ = 10, DEPTH = 2;
constexpr int NWAVES = 8, NTHR = 512;

#define GAS __attribute__((address_space(1)))
#define LAS __attribute__((address_space(3)))
typedef unsigned short bf16;
typedef unsigned v4u __attribute__((ext_vector_type(4)));
typedef unsigned v2u __attribute__((ext_vector_type(2)));
typedef float f32x4 __attribute__((ext_vector_type(4)));
typedef float f32x2 __attribute__((ext_vector_type(2)));
typedef float f32x16 __attribute__((ext_vector_type(16)));
typedef short bf16x8 __attribute__((ext_vector_type(8)));
typedef _Float16 h2 __attribute__((ext_vector_type(2)));
typedef GAS unsigned gu32;
#define RLX_AGENT __ATOMIC_RELAXED, __HIP_MEMORY_SCOPE_AGENT
#define LDS_WAIT() asm volatile("s_waitcnt lgkmcnt(0)" ::: "memory")
#define VM_WAIT() asm volatile("s_waitcnt vmcnt(0)" ::: "memory")
typedef __bf16 bf16v2_t __attribute__((ext_vector_type(2)));
__device__ __forceinline__ unsigned cvt_pk_bf16(float lo, float hi) { f32x2 v = {lo, hi}; bf16v2_t r = __builtin_convertvector(v, bf16v2_t); return __builtin_bit_cast(unsigned, r); }
__device__ __forceinline__ unsigned f2bf(float f) { return cvt_pk_bf16(f, f) & 0xffffu; }
__device__ __forceinline__ unsigned pk2(float lo, float hi) { return cvt_pk_bf16(lo, hi); }
__device__ __forceinline__ unsigned pkh2(float lo, float hi) { h2 v; v.x = (_Float16)lo; v.y = (_Float16)hi; return __builtin_bit_cast(unsigned, v); }
__device__ __forceinline__ float bf_lo(unsigned w) { return __builtin_bit_cast(float, w << 16); }
__device__ __forceinline__ float bf_hi(unsigned w) { return __builtin_bit_cast(float, w & 0xffff0000u); }
__device__ __forceinline__ float h_lo(unsigned w) { h2 v = __builtin_bit_cast(h2, w); return (float)v.x; }
__device__ __forceinline__ float h_hi(unsigned w) { h2 v = __builtin_bit_cast(h2, w); return (float)v.y; }
__device__ __forceinline__ float h1(unsigned short w) { return (float)__builtin_bit_cast(_Float16, w); }
__device__ __forceinline__ float fexp(float x) { return __builtin_amdgcn_exp2f(x * 1.44269504089f); }
__device__ __forceinline__ float fsigmoid(float x) { return __builtin_amdgcn_rcpf(1.0f + fexp(-x)); }
__device__ __forceinline__ unsigned long long opaque_u64(unsigned long long p) {
    const unsigned lo = __builtin_amdgcn_readfirstlane((unsigned)p), hi = __builtin_amdgcn_readfirstlane((unsigned)(p >> 32)); unsigned lo2, hi2;
    asm volatile("s_mov_b32 %0, %2\n\ts_mov_b32 %1, %3" : "=&s"(lo2), "=&s"(hi2) : "s"(lo), "s"(hi));
    return ((unsigned long long)hi2 << 32) | lo2;
}
__device__ __forceinline__ int lane_id() { int l; asm volatile("v_mbcnt_lo_u32_b32 %0, -1, 0\n\tv_mbcnt_hi_u32_b32 %0, -1, %0" : "=v"(l)); return l; }
__device__ __forceinline__ float shfl_xor_(float v, int m) { return __builtin_bit_cast(float, __builtin_amdgcn_ds_bpermute((lane_id() ^ m) << 2, __builtin_bit_cast(int, v))); }
__device__ __forceinline__ unsigned long long ld_karg64(int off) {
    unsigned long long r;
    asm volatile("s_load_dwordx2 %0, %1, %2\n\ts_waitcnt lgkmcnt(0)" : "=s"(r) : "s"(__builtin_amdgcn_kernarg_segment_ptr()), "n"(off) : "memory");
    return r;
}
__device__ __forceinline__ float wave_sum(float v) {
#pragma unroll
    for (int o = 1; o < 64; o <<= 1) v += shfl_xor_(v, o);
    return v;
}

#define XB_TMO      128
#define XB_XCNT(j)  (256  + 64 * (j))
#define XB_XSUB(j)  (1280 + 64 * (j))
#define XB_XGEN(j)  (2304 + 64 * (j))
#define XB_TOP      3328
#define XB_TOPGEN   3392
#define XCD_BAR_WORDS 3456
#define XB_SPIN_CAP (1u << 22)

__device__ __forceinline__ unsigned xb_ld(unsigned* p)              { return __hip_atomic_load(p, __ATOMIC_RELAXED, __HIP_MEMORY_SCOPE_AGENT); }
__device__ __forceinline__ unsigned xb_add(unsigned* p, unsigned v) { return __hip_atomic_fetch_add(p, v, __ATOMIC_RELAXED, __HIP_MEMORY_SCOPE_AGENT); }
__device__ __forceinline__ unsigned xb_xcc_id() { return (unsigned)__builtin_amdgcn_s_getreg((3 << 11) | 20) & 0xFu; }
#define XB_SPIN(cond, bar) do { unsigned _sp = 0; while (cond) { __builtin_amdgcn_s_sleep(1); \
    if ((++_sp & 255u) == 0u) { if (xb_ld(&(bar)[XB_TMO])) break; if (_sp > XB_SPIN_CAP) { atomicAdd(&(bar)[XB_TMO], 1u); break; } } } } while (0)

struct XcdBarrier { unsigned* bar; unsigned x; volatile LAS unsigned* st; };
__device__ __forceinline__ XcdBarrier xcd_barrier_post(unsigned* bar, volatile LAS unsigned* st) {
    XcdBarrier b; b.bar = bar; b.x = xb_xcc_id(); b.st = st;
    if (threadIdx.x == 0) (void)xb_add(&bar[XB_XCNT(b.x)], 1u);
    return b;
}
__device__ __forceinline__ void xcd_barrier_complete(unsigned* bar, unsigned x, unsigned& nloc, unsigned& nx) {
    const unsigned G = gridDim.x * gridDim.y * gridDim.z;
    unsigned sum, cnt, mine, sp = 0u;
    for (;;) {
        sum = 0u; cnt = 0u; mine = 0u;
#pragma unroll
        for (unsigned j = 0; j < 16; ++j) { const unsigned c = xb_ld(&bar[XB_XCNT(j)]); sum += c; cnt += (c > 0u) ? 1u : 0u; mine = (j == x) ? c : mine; }
        if (sum == G) break;
        __builtin_amdgcn_s_sleep(1);
        if ((++sp & 255u) == 0u) { if (xb_ld(&bar[XB_TMO])) break; if (sp > XB_SPIN_CAP) { atomicAdd(&bar[XB_TMO], 1u); break; } }
    }
    nloc = mine > 0u ? mine : 1u; nx = cnt > 0u ? cnt : 1u;
}
__device__ __forceinline__ void xcd_barrier(const XcdBarrier& b, bool thread0) {
    asm volatile("s_waitcnt vmcnt(0)" ::: "memory");
    __syncthreads();
    if (thread0) {
        unsigned* bar = (unsigned*)opaque_u64((unsigned long long)b.bar); const unsigned bx = xb_xcc_id();
        __builtin_amdgcn_s_waitcnt(0);
        unsigned nloc = b.st[0], nx = b.st[1];
        if (nloc == 0u) { xcd_barrier_complete(bar, bx, nloc, nx); b.st[0] = nloc; b.st[1] = nx; }
        const unsigned old = xb_add(&bar[XB_XSUB(bx)], 1u);
        const unsigned gen = old / nloc;
        if (old + 1u == (gen + 1u) * nloc) {
            __builtin_amdgcn_fence(__ATOMIC_RELEASE, "agent");
            asm volatile("s_waitcnt vmcnt(0)" ::: "memory");
            const unsigned og = xb_add(&bar[XB_TOP], 1u);
            const unsigned tg = og / nx;
            if (og + 1u == (tg + 1u) * nx) xb_add(&bar[XB_TOPGEN], 1u);
            else XB_SPIN(xb_ld(&bar[XB_TOPGEN]) == tg, bar);
            __builtin_amdgcn_fence(__ATOMIC_ACQUIRE, "agent");
            xb_add(&bar[XB_XGEN(bx)], 1u);
            asm volatile("s_waitcnt vmcnt(0)" ::: "memory");
        } else {
            XB_SPIN(xb_ld(&bar[XB_XGEN(bx)]) == gen, bar);
            __builtin_amdgcn_fence(__ATOMIC_ACQUIRE, "agent");
            asm volatile("s_waitcnt vmcnt(0)" ::: "memory");
        }
    }
    __syncthreads();
}

namespace pg8 {
#define PG8_LAS __attribute__((address_space(3)))
constexpr int BM = 256, BK = 64, HALF = 128, HTB = HALF * BK * 2, STAGE_BYTES = 8 * HTB;
__host__ __device__ __forceinline__ int lds_byte(int r, int c) { const int st = (r >> 4) * 2 + (c >> 5), rr = r & 15, cc = c & 31, ob = rr * 64 + cc * 2; return st * 1024 + (ob ^ (((ob >> 9) & 1) << 5)); }
__host__ __device__ __forceinline__ void stage_rc(int b, int& R, int& C) { const int st = b / 1024, sb = b % 1024, swz = sb ^ (((sb >> 9) & 1) << 5); R = (st >> 1) * 16 + swz / 64; C = (st & 1) * 32 + (swz % 64) / 2; }
__host__ __device__ __forceinline__ int perm32(int rho) { const int n = rho >> 4, i = rho & 15; return 8 * (i >> 2) + 4 * n + (i & 3); }

struct UnitG { const char* A; const char* B; int lda, ldb, K; char* O; int ldo, kind, x0, x1; };

__device__ __forceinline__ void tile_map(int L, int nM, int nN, int& pm, int& pn, int wgm = 8) {
    const int nwg = nM * nN; int wgid = L;
    { const int q = nwg / 8, r = nwg % 8, xcd = wgid % 8, off = wgid / 8; wgid = (xcd < r ? xcd * (q + 1) : r * (q + 1) + (xcd - r) * q) + off; }
    const int nig = wgm * nN, gid = wgid / nig, fm = gid * wgm, gsz = (nM - fm) < wgm ? (nM - fm) : wgm;
    pm = fm + ((wgid % nig) % gsz); pn = (wgid % nig) / gsz;
}

template <class Epi, class Sched>
__device__ __forceinline__ void gemm_phase(PG8_LAS unsigned char* lds, const Sched& S, const Epi& E, int tid_in) {
    int tid_ = tid_in; asm volatile("" : "+v"(tid_));
    const int tid = tid_, wid = __builtin_amdgcn_readfirstlane(tid >> 6), lane = tid & 63, wr = wid >> 2, wc = wid & 3, fr = lane & 15, fq = lane >> 4;
    int sR, sC; stage_rc(tid * 16, sR, sC);
    const int sRb = Epi::PERM ? ((sR & ~31) + perm32(sR & 31)) : sR;
    const size_t kstep = (size_t)(BK * 2);
    const unsigned ldsw = (unsigned)wid * 1024u;
    const int aoff = lds_byte(wr * 64 + fr, fq * 8), boff = lds_byte(wc * 32 + fr, fq * 8);
#define PG8_SA(b, h) (((b) * 2 + (h)) * HTB)
#define PG8_SB(b, h) ((4 + (b) * 2 + (h)) * HTB)
#define PG8_STAGE(bufoff, gbase, voff, q64) do { _Pragma("unroll") for (int _i = 0; _i < 2; ++_i) \
        __builtin_amdgcn_global_load_lds((const unsigned*)((const char*)(gbase) + (size_t)_i * (q64) + (voff)), (PG8_LAS unsigned*)(lds + (bufoff) + ldsw + _i * 8192), 16, 0, 0); } while (0)
#define PG8_LDA(dst, b, h) do { _Pragma("unroll") for (int m = 0; m < 4; ++m) _Pragma("unroll") for (int k = 0; k < 2; ++k) dst[m][k] = *(const PG8_LAS bf16x8*)(lds + PG8_SA(b, h) + aoff + m * 2048 + k * 1024); } while (0)
#define PG8_LDB(dst, b, h) do { _Pragma("unroll") for (int n = 0; n < 2; ++n) _Pragma("unroll") for (int k = 0; k < 2; ++k) dst[n][k] = *(const PG8_LAS bf16x8*)(lds + PG8_SB(b, h) + boff + n * 2048 + k * 1024); } while (0)
#define PG8_MMA(ai, bj, At, Bt) do { __builtin_amdgcn_s_setprio(1); _Pragma("unroll") for (int m = 0; m < 4; ++m) _Pragma("unroll") for (int n = 0; n < 2; ++n) _Pragma("unroll") for (int k = 0; k < 2; ++k) \
        acc[ai][bj][m][n] = __builtin_amdgcn_mfma_f32_16x16x32_bf16(Bt[n][k], At[m][k], acc[ai][bj][m][n], 0, 0, 0); __builtin_amdgcn_s_setprio(0); } while (0)
#define PG8_WAIT_V(n) asm volatile("s_waitcnt vmcnt(" #n ")" ::: "memory")
#define PG8_WAIT_L(n) asm volatile("s_waitcnt lgkmcnt(" #n ")" ::: "memory")
#define PG8_WAIT_VP() asm volatile("s_waitcnt vmcnt(%0)" :: "n"(8 + Epi::NST) : "memory")
#define PG8_BAR __builtin_amdgcn_s_barrier()
#define PG8_SCHED __builtin_amdgcn_sched_barrier(0)
    UnitG cur, nxt; int ui = 0;
    if (!S.next(0, cur)) return;
    f32x4 acc[2][2][4][2];
#pragma unroll
    for (int a = 0; a < 2; ++a)
#pragma unroll
        for (int b = 0; b < 2; ++b)
#pragma unroll
            for (int m = 0; m < 4; ++m)
#pragma unroll
                for (int n = 0; n < 2; ++n) acc[a][b][m][n] = (f32x4){0.f, 0.f, 0.f, 0.f};
    bf16x8 At[4][2], B0[2][2], B1[2][2];
    const char* cA = cur.A; const char* cB = cur.B;
    unsigned vA = (unsigned)(sR * cur.lda + sC) * 2u, vB = (unsigned)(sRb * cur.ldb + sC) * 2u;
    unsigned qA = (unsigned)cur.lda * 128u, qB = (unsigned)cur.ldb * 128u;
#define hA (2u * qA)
#define hB (2u * qB)
    PG8_STAGE(PG8_SB(0, 0), cB, vB, qB); PG8_STAGE(PG8_SB(0, 1), cB + hB, vB, qB); PG8_STAGE(PG8_SA(0, 0), cA, vA, qA); PG8_STAGE(PG8_SA(0, 1), cA + hA, vA, qA);
    if (wr == 1) PG8_BAR;
    PG8_WAIT_V(2); PG8_BAR;
    PG8_STAGE(PG8_SB(1, 0), cB + kstep, vB, qB); PG8_STAGE(PG8_SA(1, 0), cA + kstep, vA, qA); PG8_STAGE(PG8_SB(1, 1), cB + hB + kstep, vB, qB);
    PG8_WAIT_V(0); PG8_BAR;
    for (;;) {
        const bool has_next = S.next(ui + 1, nxt);
        const char* nA = has_next ? nxt.A : cA; const char* nB = has_next ? nxt.B : cB;
        const int nlda = has_next ? nxt.lda : cur.lda, nldb = has_next ? nxt.ldb : cur.ldb;
        unsigned nvA, nvB; { int r2, c2; stage_rc((wid * 64 + lane_id()) * 16, r2, c2); const int rb2 = Epi::PERM ? ((r2 & ~31) + perm32(r2 & 31)) : r2;
            nvA = (unsigned)(r2 * nlda + c2) * 2u; nvB = (unsigned)(rb2 * nldb + c2) * 2u; }
        const unsigned nqA = (unsigned)nlda * 128u, nqB = (unsigned)nldb * 128u;
        const int nt = cur.K / BK;
#define PG8_KITER(WV) do { \
            const bool last = (t == nt - 2); \
            const char* a1 = cA + (size_t)(t + 1) * kstep; \
            const char* a2 = last ? nA : cA + (size_t)(t + 2) * kstep; const char* b2 = last ? nB : cB + (size_t)(t + 2) * kstep; \
            const char* a3 = a2 + kstep; const char* b3 = b2 + kstep; \
            const unsigned va2 = last ? nvA : vA, vb2 = last ? nvB : vB; \
            const unsigned qa2 = last ? nqA : qA, qb2 = last ? nqB : qB, ha2 = 2u * qa2, hb2 = 2u * qb2; \
              \
            PG8_LDB(B0, 0, 0); PG8_LDB(B1, 0, 1); PG8_SCHED; PG8_LDA(At, 0, 0); PG8_STAGE(PG8_SA(1, 1), a1 + hA, vA, qA); \
            WV; PG8_WAIT_L(0); PG8_BAR; PG8_MMA(0, 0, At, B0); PG8_MMA(0, 1, At, B1); PG8_BAR; PG8_SCHED; \
              \
            PG8_LDA(At, 0, 1); PG8_STAGE(PG8_SB(0, 0), b2, vb2, qb2); PG8_STAGE(PG8_SB(0, 1), b2 + hb2, vb2, qb2); PG8_STAGE(PG8_SA(0, 0), a2, va2, qa2); \
            WV; PG8_WAIT_L(0); PG8_BAR; PG8_MMA(1, 0, At, B0); PG8_MMA(1, 1, At, B1); PG8_BAR; PG8_SCHED; \
              \
            PG8_LDB(B0, 1, 0); PG8_LDB(B1, 1, 1); PG8_SCHED; PG8_LDA(At, 1, 0); PG8_STAGE(PG8_SA(0, 1), a2 + ha2, va2, qa2); \
            PG8_WAIT_V(8); PG8_WAIT_L(0); PG8_BAR; PG8_MMA(0, 0, At, B0); PG8_MMA(0, 1, At, B1); PG8_BAR; PG8_SCHED; \
              \
            PG8_LDA(At, 1, 1); PG8_STAGE(PG8_SB(1, 0), b3, vb2, qb2); PG8_STAGE(PG8_SB(1, 1), b3 + hb2, vb2, qb2); PG8_STAGE(PG8_SA(1, 0), a3, va2, qa2); \
            PG8_WAIT_V(8); PG8_WAIT_L(0); PG8_BAR; PG8_MMA(1, 0, At, B0); PG8_MMA(1, 1, At, B1); PG8_BAR; PG8_SCHED; } while (0)
        { const int t = 0; PG8_KITER(PG8_WAIT_VP()); }
        for (int t = 2; t < nt; t += 2) PG8_KITER(PG8_WAIT_V(8));
#undef PG8_KITER
        if (wr == 0) PG8_BAR;
        { const int l2 = lane_id(); int fr2 = l2 & 15, fq2 = l2 >> 4; asm volatile("" : "+v"(fr2), "+v"(fq2)); E(acc, cur, wr, wc, fr2, fq2); }
        if (!has_next) break;
#pragma unroll
        for (int a = 0; a < 2; ++a)
#pragma unroll
            for (int b = 0; b < 2; ++b)
#pragma unroll
                for (int m = 0; m < 4; ++m)
#pragma unroll
                    for (int n = 0; n < 2; ++n) acc[a][b][m][n] = (f32x4){0.f, 0.f, 0.f, 0.f};
        cA = nA; cB = nB; vA = nvA; vB = nvB; qA = nqA; qB = nqB; ++ui;
        { int u2 = ui; asm volatile("" : "+s"(u2)); (void)S.next(u2, cur); }
        if (wr == 1) PG8_BAR;
    }
    PG8_WAIT_V(0);
    PG8_BAR;
#undef hA
#undef hB
#undef PG8_SA
#undef PG8_SB
#undef PG8_STAGE
#undef PG8_LDA
#undef PG8_LDB
#undef PG8_MMA
#undef PG8_WAIT_V
#undef PG8_WAIT_VP
#undef PG8_WAIT_L
#undef PG8_BAR
#undef PG8_SCHED
}
}
using pg8::UnitG;

constexpr size_t MiB = 1u << 20;
constexpr size_t WS_CTL = 0, CTL_ZERO_BYTES = 1 * MiB;
constexpr size_t WS_WT = 2 * MiB;
constexpr size_t WO_UP1 = 0, WO_DN1 = 44 * MiB, WO_UP2 = 66 * MiB, WO_DN2 = 110 * MiB, WO_ATT = 132 * MiB, WO_RET = 150 * MiB, WO_CF = 162 * MiB,
                 WO_GATE = 170 * MiB, WO_BA = 194 * MiB, WO_BB = 196 * MiB, WO_BC = 200 * MiB, WO_OUT = 202 * MiB, WO_LR = 210 * MiB, WT_BYTES = 212 * MiB;
constexpr size_t WS_XN = WS_WT + WT_BYTES;
constexpr size_t WS_AR = WS_XN + 160 * MiB;
constexpr size_t AR_YC = 0, AR_YA = 40 * MiB, AR_YB = 80 * MiB;
constexpr int FFN_MC = 40960, FFN_NCK = (T + FFN_MC - 1) / FFN_MC;
constexpr size_t AR_H = 0;
constexpr size_t AR_CF = 160 * MiB, AR_RKVK = 320 * MiB, AR_LR = 480 * MiB, AR_EA = 512 * MiB, AR_GT = 672 * MiB, AR_YS = 160 * MiB, AR_PB = 160 * MiB, AR_YSB = 40 * MiB, AR_STS = 120 * MiB;
static_assert((size_t)160 * 64 * 12800 <= 160 * MiB, "PB");
constexpr size_t AR_QA = 160 * MiB, AR_KA = 280 * MiB, AR_VTA = 400 * MiB, AR_OA = 40 * MiB, AR_LSE = 680 * MiB;
constexpr size_t AR_RQ = 520 * MiB, AR_RK = 560 * MiB, AR_RKT = 600 * MiB, AR_RVT = 160 * MiB, AR_RG = 240 * MiB, AR_SB = 320 * MiB;
constexpr size_t AR_SCR = 160 * MiB, AR_MG = 288 * MiB;
constexpr size_t XB_OFF = 160 * MiB;
constexpr size_t AR_XF = 480 * MiB;
constexpr size_t WS_END = WS_AR + 712 * MiB;
constexpr int CW_BAR = 4096;

constexpr int RING_OFF = 0, RING_BYTES = 131072;
constexpr int LDSCTL_OFF = RING_BYTES, MISC_OFF = LDSCTL_OFF + 320;
constexpr int LDS_BYTES = 147456;

struct Args { const float* in[30]; float* out; unsigned char* ws; int ph_lo, ph_hi; };
static_assert(__builtin_offsetof(Args, out) == 240 && __builtin_offsetof(Args, ws) == 248, "ld_karg64 offsets");

struct Frame { LAS unsigned char* lds; unsigned char* ws; int tid, lane, wave, G, gw, NGW, bid, z; };

__device__ __forceinline__ void transpose_item(const float* W, int ldw, int k0, int n0, bf16* WT, int Kdst, int dst_row0, LAS float* scr, int lane) {
    float tv[32];
#pragma unroll
    for (int i = 0; i < 32; ++i) { const int kk = 2 * i + (lane >> 5); tv[i] = W[(size_t)(k0 + kk) * ldw + n0 + (lane & 31)]; }
#pragma unroll
    for (int i = 0; i < 32; ++i) { const int kk = 2 * i + (lane >> 5); scr[kk * 33 + (lane & 31)] = tv[i]; }
    LDS_WAIT(); asm volatile("" ::: "memory");
    const int c = lane & 7;
#pragma unroll
    for (int j = 0; j < 4; ++j) { const int n = (lane >> 3) + 8 * j; const LAS float* s = scr + (8 * c) * 33 + n;
        v4u o; o.x = pk2(s[0 * 33], s[1 * 33]); o.y = pk2(s[2 * 33], s[3 * 33]); o.z = pk2(s[4 * 33], s[5 * 33]); o.w = pk2(s[6 * 33], s[7 * 33]);
        *(v4u*)(WT + (size_t)(dst_row0 + n) * Kdst + k0 + 8 * c) = o; }
    LDS_WAIT(); asm volatile("" ::: "memory");
}

__device__ __forceinline__ void phase_wconv(const Frame& F, const Args& a, int l, unsigned char* wt, unsigned char* wth, int part) {
    LAS float* scr = (LAS float*)(F.lds + RING_OFF + F.wave * 16384);
    constexpr int I_FF = 5632, I_A = 6 * I_FF, I_IN = 32 * 492, I_BA = 512, I_BB = 1024, I_BC = 512, I_OUT = 2048;
    constexpr int NITEMS = I_A + I_IN + I_BA + I_BB + I_BC + I_OUT;
    for (int it = F.gw; it < NITEMS; it += F.NGW) {
        int r = it;
        if (r < I_A) {
            const int m = r / I_FF, q = r % I_FF, f = m / 3, mm = m % 3;
            if (!((f ? 2 : 1) & part)) continue;
            if (mm < 2) {
                const float* W = a.in[F.z + (f ? 26 : 3) + mm] + (size_t)l * D * FF;
                const int kb = q / 176, nb = q % 176, n0 = 32 * nb;
                bf16* dst = (bf16*)(f ? wth + WO_UP2 : wt + WO_UP1);
                transpose_item(W, FF, 64 * kb, n0, dst, D, (n0 / 128) * 256 + mm * 128 + (n0 % 128), scr, F.lane);
            } else {
                const float* W = a.in[F.z + (f ? 28 : 5)] + (size_t)l * FF * D;
                const int kb = q / 64, nb = q % 64, n0 = 32 * nb;
                bf16* dst = (bf16*)(f ? wth + WO_DN2 : wt + WO_DN1);
                transpose_item(W, D, 64 * kb, n0, dst, FF, n0, scr, F.lane);
            }
            continue;
        }
        r -= I_A;
        if (r < I_IN) {
            const float* W = a.in[F.z + 7] + (size_t)l * D * 15744;
            const int kb = r / 492, nb = r % 492, n0 = 32 * nb;
            if (!(((n0 >= 7680 && n0 < 9600) ? 1 : 2) & part)) continue;
            bf16* dst; int row;
            if (n0 < 4608) { dst = (bf16*)(wth + WO_ATT); row = n0; }
            else if (n0 < 7680) { dst = (bf16*)(wth + WO_RET); row = n0 - 4608; }
            else if (n0 < 9600) { dst = (bf16*)(wth + WO_CF); row = n0 - 7680; }
            else { dst = (bf16*)(wth + WO_GATE); row = n0 - 9600; }
            transpose_item(W, 15744, 64 * kb, n0, dst, D, row, scr, F.lane);
            continue;
        }
        r -= I_IN;
        if (!(part & 2)) break;
        if (r < I_BA) { const int kb = r / 64, nb = r % 64; transpose_item(a.in[F.z + 21] + (size_t)l * 512 * D, D, 64 * kb, 32 * nb, (bf16*)(wth + WO_BA), 512, 32 * nb, scr, F.lane); continue; }
        r -= I_BA;
        if (r < I_BB) { const int kb = r / 64, nb = r % 64; transpose_item(a.in[F.z + 22] + (size_t)l * 1024 * D, D, 64 * kb, 32 * nb, (bf16*)(wth + WO_BB), 1024, 32 * nb, scr, F.lane); continue; }
        r -= I_BB;
        if (r < I_BC) { const int kb = r / 64, nb = r % 64; transpose_item(a.in[F.z + 23] + (size_t)l * 512 * D, D, 64 * kb, 32 * nb, (bf16*)(wth + WO_BC), 512, 32 * nb, scr, F.lane); continue; }
        r -= I_BC;
        { const int kb = r / 64, nb = r % 64; transpose_item(a.in[F.z + 24] + (size_t)l * D * D, D, 64 * kb, 32 * nb, (bf16*)(wth + WO_OUT), D, 32 * nb, scr, F.lane); }
    }
    if (!(part & 1)) return;
    const int gt = F.bid * NTHR + F.tid, NGT = F.G * NTHR;
    bf16* lr = (bf16*)(wth + WO_LR);
    const float* w2 = a.in[F.z + 12] + (size_t)l * 2 * 64 * 512; const float* a2 = a.in[F.z + 14] + (size_t)l * 2 * 64 * 512; const float* g2 = a.in[F.z + 15] + (size_t)l * 128 * 512;
    for (int i = gt; i < 2560 * 384; i += NGT) {
        const int n = i / 384, k = i % 384; float v = 0.f;
        if (n < 1024) { const int z = n >> 9, c = n & 511; if (k >= 64 * z && k < 64 * z + 64) v = w2[((size_t)z * 64 + (k - 64 * z)) * 512 + c]; }
        else if (n < 2048) { const int z = (n - 1024) >> 9, c = n & 511; if (k >= 128 + 64 * z && k < 192 + 64 * z) v = a2[((size_t)z * 64 + (k - 128 - 64 * z)) * 512 + c]; }
        else { const int c = n - 2048; if (k >= 256) v = g2[(size_t)(k - 256) * 512 + c]; }
        lr[i] = (bf16)f2bf(v);
    }
    bf16* cfz = (bf16*)(wth + WO_CF) + (size_t)1920 * D;
    for (int i = gt; i < 128 * D; i += NGT) cfz[i] = 0;
}

__device__ __forceinline__ void phase_norm_in(const Frame& F, const float* xp, const float* xs, const float* gain, bf16* xn, bf16* xb) {
    for (int m = F.gw; m < T; m += F.NGW) {
        const float* src_row = m < 8192 ? xp + (size_t)m * D : xs + (size_t)(m - 8192) * D;
        const f32x4* xr = (const f32x4*)src_row + F.lane; const f32x4* gr = (const f32x4*)gain + F.lane;
        f32x4 v[8]; float s = 0.f;
#pragma unroll
        for (int j = 0; j < 8; ++j) { v[j] = xr[64 * j]; s += (v[j].x * v[j].x + v[j].y * v[j].y) + (v[j].z * v[j].z + v[j].w * v[j].w); }
        const float rstd = 1.0f / sqrtf(wave_sum(s) * (1.0f / D) + 1e-6f);
        v2u* o8 = (v2u*)(xn + (size_t)m * D) + F.lane; v2u* b8 = (v2u*)(xb + (size_t)m * D) + F.lane;
#pragma unroll
        for (int j = 0; j < 8; ++j) { const f32x4 g = gr[64 * j]; v2u w; w.x = pk2(v[j].x * rstd * g.x, v[j].y * rstd * g.y); w.y = pk2(v[j].z * rstd * g.z, v[j].w * rstd * g.w); o8[64 * j] = w;
            v2u b; b.x = pk2(v[j].x, v[j].y); b.y = pk2(v[j].z, v[j].w); b8[64 * j] = b; }
    }
}
__device__ __forceinline__ void phase_norm(const Frame& F, const bf16* x, const float* gain, bf16* xn) {
    for (int m = 2 * F.gw; m < T; m += 2 * F.NGW) {
        v4u v[2][4]; float s[2] = {0.f, 0.f};
#pragma unroll
        for (int r = 0; r < 2; ++r) { const v4u* xr = (const v4u*)(x + (size_t)(m + r) * D) + F.lane;
#pragma unroll
            for (int j = 0; j < 4; ++j) v[r][j] = xr[64 * j]; }
#pragma unroll
        for (int r = 0; r < 2; ++r)
#pragma unroll
            for (int j = 0; j < 4; ++j)
#pragma unroll
                for (int q = 0; q < 4; ++q) { const float a = bf_lo(v[r][j][q]), b = bf_hi(v[r][j][q]); s[r] += a * a + b * b; }
        const f32x4* gr = (const f32x4*)gain + 2 * F.lane;
#pragma unroll
        for (int r = 0; r < 2; ++r) {
            const float rstd = 1.0f / sqrtf(wave_sum(s[r]) * (1.0f / D) + 1e-6f);
            v4u* o = (v4u*)(xn + (size_t)(m + r) * D) + F.lane;
#pragma unroll
            for (int j = 0; j < 4; ++j) { const f32x4 g0 = gr[128 * j], g1 = gr[128 * j + 1]; const v4u w = v[r][j]; v4u ow;
                ow.x = pk2(bf_lo(w.x) * rstd * g0.x, bf_hi(w.x) * rstd * g0.y); ow.y = pk2(bf_lo(w.y) * rstd * g0.z, bf_hi(w.y) * rstd * g0.w);
                ow.z = pk2(bf_lo(w.z) * rstd * g1.x, bf_hi(w.z) * rstd * g1.y); ow.w = pk2(bf_lo(w.w) * rstd * g1.z, bf_hi(w.w) * rstd * g1.w);
                o[64 * j] = ow; }
        }
    }
}
__device__ __forceinline__ void phase_final_norm(const Frame& F, const bf16* x, const float* gain, float* out) {
    for (int m = F.gw; m < T; m += F.NGW) {
        const v4u* xr = (const v4u*)(x + (size_t)m * D) + F.lane;
        v4u v[4]; float s = 0.f;
#pragma unroll
        for (int j = 0; j < 4; ++j) v[j] = xr[64 * j];
#pragma unroll
        for (int j = 0; j < 4; ++j)
#pragma unroll
            for (int q = 0; q < 4; ++q) { const float a = bf_lo(v[j][q]), b = bf_hi(v[j][q]); s += a * a + b * b; }
        const float rstd = 1.0f / sqrtf(wave_sum(s) * (1.0f / D) + 1e-6f);
        const f32x4* gr = (const f32x4*)gain + 2 * F.lane; f32x4* o = (f32x4*)(out + (size_t)m * D) + 2 * F.lane;
#pragma unroll
        for (int j = 0; j < 4; ++j) { const f32x4 g0 = gr[128 * j], g1 = gr[128 * j + 1]; const v4u w = v[j];
            f32x4 o0, o1; o0.x = bf_lo(w.x) * rstd * g0.x; o0.y = bf_hi(w.x) * rstd * g0.y; o0.z = bf_lo(w.y) * rstd * g0.z; o0.w = bf_hi(w.y) * rstd * g0.w;
            o1.x = bf_lo(w.z) * rstd * g1.x; o1.y = bf_hi(w.z) * rstd * g1.y; o1.z = bf_lo(w.w) * rstd * g1.z; o1.w = bf_hi(w.w) * rstd * g1.w;
            o[128 * j] = o0; o[128 * j + 1] = o1; }
    }
}

struct SchedPlain {
    const char* A; const char* B; int lda, ldb, K, nM, nN, G, c, wgm;
    __device__ __forceinline__ bool next(int i, UnitG& u) const {
        const int L = i * G + c; if (L >= nM * nN) return false;
        int pm, pn; pg8::tile_map(L, nM, nN, pm, pn, wgm);
        u.A = A + (size_t)pm * 256 * lda * 2; u.B = B + (size_t)pn * 256 * ldb * 2; u.lda = lda; u.ldb = ldb; u.K = K; u.O = nullptr; u.ldo = 0; u.kind = 0; u.x0 = pm; u.x1 = pn; return true;
    }
};
struct EpiSwiglu {
    static constexpr bool PERM = true; static constexpr int NST = 8;
    bf16* H;
    __device__ __forceinline__ void operator()(const f32x4 (&acc)[2][2][4][2], const UnitG& u, int wr, int wc, int fr, int fq) const {
        const int row0 = u.x0 * 256 + wr * 64 + fr, col0 = u.x1 * 128 + wc * 32 + 8 * fq;
#pragma unroll
        for (int ai = 0; ai < 2; ++ai)
#pragma unroll
            for (int m = 0; m < 4; ++m) {
                float h[8];
#pragma unroll
                for (int n = 0; n < 2; ++n)
#pragma unroll
                    for (int e = 0; e < 4; ++e) { const float g = acc[ai][0][m][n][e], up = acc[ai][1][m][n][e]; h[4 * n + e] = g * fsigmoid(g) * up; }
                v4u w; w.x = cvt_pk_bf16(h[0], h[1]); w.y = cvt_pk_bf16(h[2], h[3]); w.z = cvt_pk_bf16(h[4], h[5]); w.w = cvt_pk_bf16(h[6], h[7]);
                *(v4u*)(H + (size_t)(row0 + ai * 128 + m * 16) * FF + col0) = w;
            }
    }
};
struct EpiResid {
    static constexpr bool PERM = true; static constexpr int NST = 16;
    bf16* X; const bf16* R; float scale;
    __device__ __forceinline__ void operator()(const f32x4 (&acc)[2][2][4][2], const UnitG& u, int wr, int wc, int fr, int fq) const {
        const int row0 = u.x0 * 256 + wr * 64 + fr, col0 = u.x1 * 256 + wc * 32 + 8 * fq;
        v4u xv[2][4][2];
#pragma unroll
        for (int ai = 0; ai < 2; ++ai)
#pragma unroll
            for (int m = 0; m < 4; ++m) { const bf16* rowp = R + (size_t)(row0 + ai * 128 + m * 16) * D + col0;
#pragma unroll
                for (int bj = 0; bj < 2; ++bj) xv[ai][m][bj] = *(const v4u*)(rowp + bj * 128); }
        asm volatile("" ::: "memory");
#pragma unroll
        for (int ai = 0; ai < 2; ++ai)
#pragma unroll
            for (int m = 0; m < 4; ++m) { bf16* rowp = X + (size_t)(row0 + ai * 128 + m * 16) * D + col0;
#pragma unroll
                for (int bj = 0; bj < 2; ++bj) { const f32x4 a0 = acc[ai][bj][m][0], a1 = acc[ai][bj][m][1]; const v4u r = xv[ai][m][bj]; v4u w;
                    w.x = cvt_pk_bf16(bf_lo(r.x) + a0.x * scale, bf_hi(r.x) + a0.y * scale); w.y = cvt_pk_bf16(bf_lo(r.y) + a0.z * scale, bf_hi(r.y) + a0.w * scale);
                    w.z = cvt_pk_bf16(bf_lo(r.z) + a1.x * scale, bf_hi(r.z) + a1.y * scale); w.w = cvt_pk_bf16(bf_lo(r.w) + a1.z * scale, bf_hi(r.w) + a1.w * scale);
                    *(v4u*)(rowp + bj * 128) = w; } }
        asm volatile("" ::: "memory");
    }
};
template <int KM>
struct EpiStore {
    static constexpr bool PERM = true; static constexpr int NST = 16;
    const float* b0; const float* b1; const float* dlog;
    __device__ __forceinline__ void operator()(const f32x4 (&acc)[2][2][4][2], const UnitG& u, int wr, int wc, int fr, int fq) const {
        const int row0 = wr * 64 + fr, col0 = wc * 32 + 8 * fq;
        bf16* O = (bf16*)u.O; const int kind = u.kind;
        float l2g[2] = {0.f, 0.f}, l2h[2] = {0.f, 0.f};
        if ((KM & 4) && kind == 2) {
#pragma unroll
            for (int ai = 0; ai < 2; ++ai) { const float lg = ((const GAS float*)dlog)[u.x0 + ai], lh = ((const GAS float*)dlog)[4 + u.x0 + ai];
                l2g[ai] = -__builtin_amdgcn_logf(1.0f + fexp(-lg)); l2h[ai] = -__builtin_amdgcn_logf(1.0f + fexp(-lh)); }
        }
#pragma unroll
        for (int ai = 0; ai < 2; ++ai)
#pragma unroll
            for (int m = 0; m < 4; ++m) { bf16* rowp = O + (size_t)(row0 + ai * 128 + m * 16) * u.ldo + col0;
#pragma unroll
                for (int bj = 0; bj < 2; ++bj) {
                    float v[8];
#pragma unroll
                    for (int n = 0; n < 2; ++n)
#pragma unroll
                        for (int e = 0; e < 4; ++e) v[4 * n + e] = acc[ai][bj][m][n][e];
                    v4u w;
                    if (!(KM & ~0x41) || kind == 0 || kind == 6) { }
                    else if ((KM & 0x82) && (kind == 1 || kind == 7)) {
#pragma unroll
                        for (int e = 0; e < 8; ++e) v[e] *= 0.08838834764831845f;
                    } else if ((KM & 4) && kind == 2) {
                        float v1[8];
#pragma unroll
                        for (int e = 0; e < 8; ++e) { const int pos = (col0 + e) & 127; const float b = v[e] * 0.08838834764831845f;
                            v1[e] = b * __builtin_amdgcn_exp2f(l2h[ai] * (float)pos); v[e] = b * __builtin_amdgcn_exp2f(l2g[ai] * (float)(127 - pos)); }
                        v4u w1; w1.x = cvt_pk_bf16(v1[0], v1[1]); w1.y = cvt_pk_bf16(v1[2], v1[3]); w1.z = cvt_pk_bf16(v1[4], v1[5]); w1.w = cvt_pk_bf16(v1[6], v1[7]);
                        *(v4u*)(rowp + (size_t)512 * T + bj * 128) = w1;
                    } else if ((KM & 16) && kind == 4) {
                        const int c = u.x1 * 256 + bj * 128 + col0;
#pragma unroll
                        for (int e = 0; e < 8; ++e) { const float xx = -(v[e] + b0[c + e]); const float sp = (xx > 15.f) ? xx : __builtin_amdgcn_logf(1.0f + fexp(xx)) * 0.69314718056f; v[e] = fexp(-sp - 0.5f); }
                    } else if ((KM & 32) && kind == 5) {
                        const int c = u.x1 * 256 + bj * 128 + col0 - 1024;
#pragma unroll
                        for (int e = 0; e < 8; ++e) v[e] = fsigmoid(v[e] + b1[c + e]);
                    }
                    if ((KM & 48) && (kind == 4 || kind == 5)) { w.x = pkh2(v[0], v[1]); w.y = pkh2(v[2], v[3]); w.z = pkh2(v[4], v[5]); w.w = pkh2(v[6], v[7]); }
                    else { w.x = cvt_pk_bf16(v[0], v[1]); w.y = cvt_pk_bf16(v[2], v[3]); w.z = cvt_pk_bf16(v[4], v[5]); w.w = cvt_pk_bf16(v[6], v[7]); }
                    bf16* dst = rowp + bj * 128;
                    if ((KM & 0x180) && (kind == 7 || kind == 8))
                        dst = O + ((size_t)(((u.x0 + 2 * wr + 4 * ai + (m >> 1)) * 4 + u.x1 + bj) * 8 + 2 * wc + (fq >> 1)) * 512 + (((fq & 1) * 32 + (m & 1) * 16 + fr) * 8));
                    else if ((KM & 0x200) && kind == 9)
                        dst = O + ((size_t)((((2 * u.x0 + ai) * 4 + 2 * wr + (m >> 1)) * (T / 32) + u.x1 + 4 * bj + wc) * 2 + (fq >> 1)) * 512 + (((fq & 1) * 32 + (m & 1) * 16 + fr) * 8));
                    *(v4u*)dst = w; } }
    }
};
struct SchedCF {
    SchedPlain P; char* O;
    __device__ __forceinline__ bool next(int i, UnitG& u) const { if (!P.next(i, u)) return false; u.O = O + ((size_t)u.x0 * 256 * 2048 + (size_t)u.x1 * 256) * 2; u.ldo = 2048; u.kind = 0; return true; }
};
struct SchedLR {
    SchedPlain P; char* EA; char* GT;
    __device__ __forceinline__ bool next(int i, UnitG& u) const {
        if (!P.next(i, u)) return false;
        if (u.x1 < 8) { u.O = EA + ((size_t)u.x0 * 256 * 2048 + (size_t)u.x1 * 256) * 2; u.ldo = 2048; u.kind = u.x1 < 4 ? 4 : 5; }
        else { u.O = GT + ((size_t)u.x0 * 256 * 512 + (size_t)(u.x1 - 8) * 256) * 2; u.ldo = 512; u.kind = 6; }
        { const int sl = u.x1 < 4 ? 0 : (u.x1 < 8 ? 1 : 2); u.A += sl * 256; u.B += sl * 256; u.K = 128; }
        return true;
    }
};
__device__ __forceinline__ int panel_tok0(int pn, int d) { const int n0 = pn * 256, seq = n0 >> 12, within = n0 & 4095, Lg = SEQ / d, p = within / Lg, s0 = within % Lg; return seq * SEQ + s0 * d + p; }
struct SchedAtt {
    const char* XN; const char* wt; char* ar; int G, c;
    __device__ __forceinline__ bool next(int i, UnitG& u) const {
        const int L = i * G + c; if (L >= 3840) return false;
        u.K = D; u.x0 = 0; u.x1 = 0;
        if (L < 2880) {
            const char* W = wt + WO_ATT;
            const int g = L / 960, rem = L % 960, d = (g == 0) ? 1 : (g == 1 ? 4 : 16);
            if (rem < 640) {
                int pm, pn; pg8::tile_map(rem, 160, 4, pm, pn);
                const int t0 = panel_tok0(pm, d);
                u.A = XN + (size_t)t0 * D * 2; u.lda = d * D;
                const int isk = pn >> 1, ct = pn & 1;
                u.B = W + (size_t)(isk * 1536 + g * 512 + ct * 256) * D * 2; u.ldb = D;
                u.O = ar + (isk ? AR_KA : AR_QA) + (size_t)g * T * 512 * 2; u.ldo = 512; u.kind = isk ? 8 : 7; u.x0 = 8 * pm; u.x1 = 2 * ct;
            } else {
                int pm, pn; pg8::tile_map(rem - 640, 2, 160, pm, pn);
                const int t0 = panel_tok0(pn, d);
                u.A = W + (size_t)(3072 + g * 512 + pm * 256) * D * 2; u.lda = D;
                u.B = XN + (size_t)t0 * D * 2; u.ldb = d * D;
                u.O = ar + AR_VTA + (size_t)g * 512 * T * 2; u.ldo = T; u.kind = 9; u.x0 = pm; u.x1 = 8 * pn;
            }
        } else if (L < 3520) {
            const char* W = wt + WO_RET;
            int pm, pn; pg8::tile_map(L - 2880, 160, 4, pm, pn);
            u.A = XN + (size_t)pm * 256 * D * 2; u.lda = D; u.ldb = D; u.ldo = 512;
            if (pn < 2) { u.B = W + (size_t)(pn * 256) * D * 2; u.O = ar + AR_RQ + ((size_t)pm * 256 * 512 + pn * 256) * 2; u.kind = 0; }
            else { u.B = W + (size_t)(512 + (pn - 2) * 256) * D * 2; u.O = ar + AR_RK + ((size_t)pm * 256 * 512 + (pn - 2) * 256) * 2; u.kind = 1; }
        } else {
            const char* W = wt + WO_RET;
            int pm, pn; pg8::tile_map(L - 3520, 2, 160, pm, pn);
            u.B = XN + (size_t)pn * 256 * D * 2; u.ldb = D; u.lda = D; u.ldo = T;
            u.A = W + (size_t)(512 + pm * 256) * D * 2; u.O = ar + AR_RKT + ((size_t)(pm * 256) * T + (size_t)pn * 256) * 2; u.kind = 2; u.x0 = 2 * pm;
        }
        return true;
    }
};
struct SchedRet {
    const char* XN; const char* W; char* ar; int G, c;
    __device__ __forceinline__ bool next(int i, UnitG& u) const {
        const int L = i * G + c; if (L >= 1280) return false;
        u.K = D; u.x0 = 0; u.x1 = 0; u.kind = 0; u.lda = D; u.ldb = D;
        if (L < 640) {
            int pm, pn; pg8::tile_map(L, 4, 160, pm, pn);
            u.A = W + (size_t)(1024 + pm * 256) * D * 2; u.B = XN + (size_t)pn * 256 * D * 2;
            u.O = ar + AR_RVT + ((size_t)pm * 256 * T + (size_t)pn * 256) * 2; u.ldo = T;
        } else {
            int pm, pn; pg8::tile_map(L - 640, 160, 4, pm, pn);
            u.A = XN + (size_t)pm * 256 * D * 2; u.B = W + (size_t)(2048 + pn * 256) * D * 2;
            u.O = ar + AR_RG + ((size_t)pm * 256 * 1024 + pn * 256) * 2; u.ldo = 1024;
        }
        return true;
    }
};
struct SchedMerge {
    const char* XN; const char* ar; const char* wt; int G, c;
    __device__ __forceinline__ bool next(int i, UnitG& u) const {
        const int L = (i / 6) * G + c, su = i % 6; if (L >= 1280) return false;
        int pm, pn; pg8::tile_map(L, 160, 8, pm, pn);
        u.x0 = pm; u.x1 = pn; u.kind = su; u.O = nullptr; u.ldo = 0;
        const int b = su >> 1;
        if (su & 1) { u.A = XN + (size_t)pm * 256 * D * 2; u.lda = D; u.K = D; u.B = wt + WO_GATE + (size_t)(b * 2048 + pn * 256) * D * 2; u.ldb = D; }
        else {
            const int kb = 512 << (b == 1 ? 1 : 0);
            const size_t yoff = (size_t)((b + 1) % 3) * (40 * MiB);
            const size_t woff = WO_BA + (size_t)(2 * b + 2 * (b >> 1)) * MiB;
            u.A = ar + yoff + (size_t)pm * 256 * kb * 2; u.lda = kb; u.K = kb;
            u.B = wt + woff + (size_t)pn * 256 * kb * 2; u.ldb = kb;
        }
        return true;
    }
};
static_assert(AR_YA == 40 * MiB && AR_YB == 80 * MiB && AR_YC == 0 && WO_BB == WO_BA + 2 * MiB && WO_BC == WO_BA + 6 * MiB, "SchedMerge offsets");
struct EpiMerge {
    static constexpr bool PERM = true; static constexpr int NST = 16;
    v4u* scrP; v4u* scrM; bf16* MG;
    __device__ __forceinline__ void operator()(const f32x4 (&acc)[2][2][4][2], const UnitG& u, int wr, int wc, int fr, int fq) const {
        const int tid = (wr * 4 + wc) * 64 + fq * 16 + fr; const int su = u.kind;
        if ((su & 1) == 0) {
            GAS v4u* p = (GAS v4u*)scrP + tid;
#pragma unroll
            for (int ai = 0; ai < 2; ++ai)
#pragma unroll
                for (int bj = 0; bj < 2; ++bj)
#pragma unroll
                    for (int m = 0; m < 4; ++m) { const f32x4 a0 = acc[ai][bj][m][0], a1 = acc[ai][bj][m][1];
                        v4u w; w.x = cvt_pk_bf16(a0.x, a0.y); w.y = cvt_pk_bf16(a0.z, a0.w); w.z = cvt_pk_bf16(a1.x, a1.y); w.w = cvt_pk_bf16(a1.z, a1.w);
                        *p = w; p += NTHR; asm volatile("" : "+v"(p)); }
            return;
        }
        const int row0 = u.x0 * 256 + wr * 64 + fr, col0 = u.x1 * 256 + wc * 32 + 8 * fq;
        const GAS v4u* pp = (const GAS v4u*)scrP + tid; GAS v4u* pm_ = (GAS v4u*)scrM + tid;
#pragma unroll
        for (int ai = 0; ai < 2; ++ai)
#pragma unroll
            for (int bj = 0; bj < 2; ++bj)
#pragma unroll
                for (int m = 0; m < 4; ++m) {
                    const v4u pw = *pp; v4u mw = {0u, 0u, 0u, 0u}; if (su > 1) mw = *pm_;
                    const f32x4 g0 = acc[ai][bj][m][0], g1 = acc[ai][bj][m][1];
                    float v[8];
                    v[0] = fsigmoid(g0.x) * bf_lo(pw.x) + bf_lo(mw.x); v[1] = fsigmoid(g0.y) * bf_hi(pw.x) + bf_hi(mw.x);
                    v[2] = fsigmoid(g0.z) * bf_lo(pw.y) + bf_lo(mw.y); v[3] = fsigmoid(g0.w) * bf_hi(pw.y) + bf_hi(mw.y);
                    v[4] = fsigmoid(g1.x) * bf_lo(pw.z) + bf_lo(mw.z); v[5] = fsigmoid(g1.y) * bf_hi(pw.z) + bf_hi(mw.z);
                    v[6] = fsigmoid(g1.z) * bf_lo(pw.w) + bf_lo(mw.w); v[7] = fsigmoid(g1.w) * bf_hi(pw.w) + bf_hi(mw.w);
                    v4u w; w.x = cvt_pk_bf16(v[0], v[1]); w.y = cvt_pk_bf16(v[2], v[3]); w.z = cvt_pk_bf16(v[4], v[5]); w.w = cvt_pk_bf16(v[6], v[7]);
                    if (su < 5) *pm_ = w;
                    else *(v4u*)(MG + (size_t)(row0 + ai * 128 + m * 16) * D + col0 + bj * 128) = w;
                    pp += NTHR; pm_ += NTHR; asm volatile("" : "+v"(pp), "+v"(pm_) :: "memory");
                }
    }
};

#define MFMA32(a, b, c) __builtin_amdgcn_mfma_f32_32x32x16_bf16((a), (b), (c), 0, 0, 0)
__device__ __forceinline__ int rperm(int r) { return (r & 0x13) | ((r & 4) << 1) | ((r & 8) >> 1); }
__device__ __forceinline__ v4u pk8(const f32x16& o, int b) { v4u w; w.x = cvt_pk_bf16(o[b], o[b + 1]); w.y = cvt_pk_bf16(o[b + 2], o[b + 3]); w.z = cvt_pk_bf16(o[b + 4], o[b + 5]); w.w = cvt_pk_bf16(o[b + 6], o[b + 7]); return w; }
__device__ __forceinline__ void phase_rwkv_pre(const Frame& F, const Args& a, int l) {
    const bf16* CF = (const bf16*)(F.ws + WS_AR + AR_CF); unsigned short* RK = (unsigned short*)(F.ws + WS_AR + AR_RKVK); bf16* LR = (bf16*)(F.ws + WS_AR + AR_LR);
    const float* cw = a.in[F.z + 10] + (size_t)l * 3 * 1920; const float* kk_w = a.in[F.z + 16] + (size_t)l * 512;
    const int lane = F.lane;
    for (int t = F.gw; t < T; t += F.NGW) {
        const int s = t & 4095; const bool hp = s > 0, hn = s < 4095;
#pragma unroll
        for (int j = 0; j < 4; ++j) {
            if (j == 3 && lane >= 48) continue;
            const int cb = 512 * j + 8 * lane;
            const v4u zc = {0u, 0u, 0u, 0u};
            const v4u cur = *(const v4u*)(CF + (size_t)t * 2048 + cb);
            const v4u prv = hp ? *(const v4u*)(CF + (size_t)(t - 1) * 2048 + cb) : zc;
            const v4u nxt = hn ? *(const v4u*)(CF + (size_t)(t + 1) * 2048 + cb) : zc;
            float o[8];
#pragma unroll
            for (int q = 0; q < 4; ++q) {
                const unsigned wc_ = cur[q], wp = prv[q], wn = nxt[q];
                const int c = cb + 2 * q;
                o[2 * q] = cw[c] * bf_lo(wp) + cw[1920 + c] * bf_lo(wc_) + cw[3840 + c] * bf_lo(wn);
                o[2 * q + 1] = cw[c + 1] * bf_hi(wp) + cw[1920 + c + 1] * bf_hi(wc_) + cw[3840 + c + 1] * bf_hi(wn);
            }
            if (j < 3) {
                v4u w; w.x = pkh2(o[0], o[1]); w.y = pkh2(o[2], o[3]); w.z = pkh2(o[4], o[5]); w.w = pkh2(o[6], o[7]);
                *(v4u*)(RK + (size_t)t * 2048 + cb) = w;
                if (j == 1) {
                    float kv[8]; float ss = 0.f;
#pragma unroll
                    for (int e = 0; e < 8; ++e) { kv[e] = o[e] * kk_w[8 * lane + e]; ss += kv[e] * kv[e]; }
                    ss += shfl_xor_(ss, 1); ss += shfl_xor_(ss, 2); ss += shfl_xor_(ss, 4);
                    const float rn = 1.0f / sqrtf(ss + 1e-12f);
                    v4u w2; w2.x = pkh2(kv[0] * rn, kv[1] * rn); w2.y = pkh2(kv[2] * rn, kv[3] * rn); w2.z = pkh2(kv[4] * rn, kv[5] * rn); w2.w = pkh2(kv[6] * rn, kv[7] * rn);
                    *(v4u*)(RK + (size_t)t * 2048 + 1536 + 8 * lane) = w2;
                }
            } else {
                if (lane < 16) {
#pragma unroll
                    for (int e = 0; e < 8; ++e) { const float ex = fexp(2.0f * o[e]); o[e] = 1.0f - 2.0f / (ex + 1.0f); }
                } else if (lane >= 32) {
#pragma unroll
                    for (int e = 0; e < 8; ++e) o[e] = fsigmoid(o[e]);
                }
                v4u w; w.x = pk2(o[0], o[1]); w.y = pk2(o[2], o[3]); w.z = pk2(o[4], o[5]); w.w = pk2(o[6], o[7]);
                *(v4u*)(LR + (size_t)t * 384 + 8 * lane) = w;
            }
        }
    }
}

__device__ __forceinline__ float dpp_red16(float x) {
    x += __builtin_bit_cast(float, __builtin_amdgcn_update_dpp(0, __builtin_bit_cast(int, x), 0xB1, 0xF, 0xF, true));
    x += __builtin_bit_cast(float, __builtin_amdgcn_update_dpp(0, __builtin_bit_cast(int, x), 0x4E, 0xF, 0xF, true));
    x += __builtin_bit_cast(float, __builtin_amdgcn_update_dpp(0, __builtin_bit_cast(int, x), 0x141, 0xF, 0xF, true));
    x += __builtin_bit_cast(float, __builtin_amdgcn_update_dpp(0, __builtin_bit_cast(int, x), 0x140, 0xF, 0xF, true));
    return x;
}
__device__ __forceinline__ void phase_rwkv_scan(const Frame& F, const Args& a, int l) {
    const unsigned short* EA = (const unsigned short*)(F.ws + WS_AR + AR_EA); const unsigned short* RK = (const unsigned short*)(F.ws + WS_AR + AR_RKVK);
    float* YS = (float*)(F.ws + WS_AR + AR_YS);
    const float* k_a = a.in[F.z + 17] + (size_t)l * 512;
    constexpr int TB = 32, BUF_F = TB * 384;
    LAS float* buf = (LAS float*)(F.lds + RING_OFF);
    LAS float* yo = buf + 2 * BUF_F;
    const int tid = F.tid, kq = tid & 15, rp = tid >> 4, c = tid & 63, ts = tid >> 6;
    for (int sc = F.bid; sc < 160; sc += F.G) {
        const int seq = sc >> 4, h = (sc >> 1) & 7, z = sc & 1;
        const float ka = k_a[h * 64 + c];
        float st[2][4];
#pragma unroll
        for (int r = 0; r < 2; ++r)
#pragma unroll
            for (int i = 0; i < 4; ++i) st[r][i] = 0.f;
        unsigned short raw[4][6];
#define SCAN_LOAD(nb) do { _Pragma("unroll") for (int i = 0; i < 4; ++i) { const int tau = (nb) * TB + ts + 8 * i; const int pos = z ? (SEQ - 1 - tau) : tau; const size_t tok = (size_t)seq * SEQ + pos; \
            raw[i][0] = EA[tok * 2048 + z * 512 + h * 64 + c]; raw[i][1] = EA[tok * 2048 + 1024 + z * 512 + h * 64 + c]; \
            raw[i][2] = RK[tok * 2048 + h * 64 + c]; raw[i][3] = RK[tok * 2048 + 512 + h * 64 + c]; raw[i][4] = RK[tok * 2048 + 1024 + h * 64 + c]; raw[i][5] = RK[tok * 2048 + 1536 + h * 64 + c]; } } while (0)
#define SCAN_STAGE(bi) do { LAS float* b_ = buf + (bi) * BUF_F; _Pragma("unroll") for (int i = 0; i < 4; ++i) { const int tl = ts + 8 * i; \
            const float e_ = h1(raw[i][0]), a_ = h1(raw[i][1]), r_ = h1(raw[i][2]), k_ = h1(raw[i][3]), v_ = h1(raw[i][4]), kk_ = h1(raw[i][5]); \
            b_[tl * 384 + c] = kk_; b_[tl * 384 + 64 + c] = fexp(-e_); b_[tl * 384 + 128 + c] = kk_ * a_; b_[tl * 384 + 192 + c] = k_ * (1.0f + (a_ - 1.0f) * ka); b_[tl * 384 + 256 + c] = r_; b_[tl * 384 + 320 + c] = v_; } } while (0)
        __syncthreads();
        SCAN_LOAD(0); SCAN_STAGE(0);
        __syncthreads();
        constexpr int NB = SEQ / TB;
        for (int nb = 0; nb < NB; ++nb) {
            if (nb + 1 < NB) SCAN_LOAD(nb + 1);
            const LAS float* b_ = buf + (nb & 1) * BUF_F;
#pragma unroll 4
            for (int stp = 0; stp < TB; ++stp) {
                const LAS float* op = b_ + stp * 384;
                const f32x4 kk4 = *(const LAS f32x4*)(op + 4 * kq), w4 = *(const LAS f32x4*)(op + 64 + 4 * kq), ka4 = *(const LAS f32x4*)(op + 128 + 4 * kq),
                            kd4 = *(const LAS f32x4*)(op + 192 + 4 * kq), r4 = *(const LAS f32x4*)(op + 256 + 4 * kq);
                const f32x2 v2 = *(const LAS f32x2*)(op + 320 + 2 * rp);
#pragma unroll
                for (int r = 0; r < 2; ++r) {
                    float sa = (st[r][0] * kk4.x + st[r][1] * kk4.y) + (st[r][2] * kk4.z + st[r][3] * kk4.w);
                    sa = -dpp_red16(sa);
                    const float vv = r ? v2.y : v2.x;
                    st[r][0] = st[r][0] * w4.x + sa * ka4.x + vv * kd4.x; st[r][1] = st[r][1] * w4.y + sa * ka4.y + vv * kd4.y;
                    st[r][2] = st[r][2] * w4.z + sa * ka4.z + vv * kd4.z; st[r][3] = st[r][3] * w4.w + sa * ka4.w + vv * kd4.w;
                    float y = (st[r][0] * r4.x + st[r][1] * r4.y) + (st[r][2] * r4.z + st[r][3] * r4.w);
                    y = dpp_red16(y);
                    if (kq == 0) yo[stp * 64 + 2 * rp + r] = y;
                }
            }
            if (nb + 1 < NB) SCAN_STAGE((nb + 1) & 1);
            __syncthreads();
#pragma unroll
            for (int i = 0; i < 4; ++i) { const int tl = ts + 8 * i, tau = nb * TB + tl; const int pos = z ? (SEQ - 1 - tau) : tau; const size_t tok = (size_t)seq * SEQ + pos;
                YS[((size_t)z * T + tok) * 512 + h * 64 + c] = yo[tl * 64 + c]; }
            __syncthreads();
        }
#undef SCAN_LOAD
#undef SCAN_STAGE
    }
}

constexpr int RW_CS = 64, RW_NSEG = (SEQ / 16) / RW_CS, RW_PBB = 12800;
__device__ __forceinline__ unsigned lds_u16(const LAS bf16* p) { return (unsigned)*p; }
__device__ __forceinline__ void phase_rwkv_prep(const Frame& F, const Args& a, int l, int seg) {
    const unsigned short* EA = (const unsigned short*)(F.ws + WS_AR + AR_EA); const unsigned short* RK = (const unsigned short*)(F.ws + WS_AR + AR_RKVK);
    unsigned char* PB = F.ws + WS_AR + AR_PB;
    const float* k_a = a.in[F.z + 17] + (size_t)l * 512;
    constexpr int LDA = 72, GLD = 36, M2D = 24;
    LAS unsigned char* pw = F.lds + RING_OFF + F.wave * 15360;
    LAS bf16* AR = (LAS bf16*)pw; LAS bf16* BK = (LAS bf16*)(pw + 4608); LAS float* GL = (LAS float*)(pw + 9216); LAS bf16* VL = (LAS bf16*)(pw + 9216); LAS bf16* M2 = (LAS bf16*)(pw + 13824);
    const int L = F.lane, li = L & 31, hh = L >> 5;
#define PREP_LOAD(dst, it_, hb_) do { const int sc_ = (it_) / RW_CS, c_ = seg * RW_CS + (it_) % RW_CS, seq_ = sc_ >> 4, h_ = (sc_ >> 1) & 7, z_ = sc_ & 1; \
        _Pragma("unroll") for (int t8 = 0; t8 < 8; ++t8) { const int tau = 16 * c_ + 8 * (hb_) + t8, pos = z_ ? (SEQ - 1 - tau) : tau; const size_t tok = (size_t)seq_ * SEQ + pos; \
            dst[t8][0] = EA[tok * 2048 + z_ * 512 + h_ * 64 + L]; dst[t8][1] = EA[tok * 2048 + 1024 + z_ * 512 + h_ * 64 + L]; \
            dst[t8][2] = RK[tok * 2048 + h_ * 64 + L]; dst[t8][3] = RK[tok * 2048 + 512 + h_ * 64 + L]; dst[t8][4] = RK[tok * 2048 + 1024 + h_ * 64 + L]; dst[t8][5] = RK[tok * 2048 + 1536 + h_ * 64 + L]; } } while (0)
#define PREP_HALF(src_, hb_) do { _Pragma("unroll") for (int t8 = 0; t8 < 8; ++t8) { const int t = 8 * (hb_) + t8; \
            const float e_ = h1(src_[t8][0]), a_ = h1(src_[t8][1]), r_ = h1(src_[t8][2]), k_ = h1(src_[t8][3]), v_ = h1(src_[t8][4]), kk_ = h1(src_[t8][5]); \
            cum += e_; gam = fexp(-cum); const float ig = fexp(cum); \
            const float at = -kk_ * gprev, bt = kk_ * a_ * ig, kt = k_ * (1.0f + (a_ - 1.0f) * ka) * ig, rt = r_ * gam; \
            atf[t] = at; \
            AR[t * LDA + L] = (bf16)f2bf(at); AR[(16 + t) * LDA + L] = (bf16)f2bf(rt); BK[t * LDA + L] = (bf16)f2bf(bt); BK[(16 + t) * LDA + L] = (bf16)f2bf(kt); VL[t * LDA + L] = (bf16)f2bf(v_); \
            gprev = gam; } } while (0)
    unsigned short raw0[8][6], raw1[8][6];
    if (F.gw < 160 * RW_CS) PREP_LOAD(raw0, F.gw, 0);
    for (int item = F.gw; item < 160 * RW_CS; item += F.NGW) {
        const int sc = item / RW_CS, cl = item % RW_CS, h = (sc >> 1) & 7;
        unsigned char* rec = PB + (size_t)(sc * RW_CS + cl) * RW_PBB;
        const float ka = k_a[h * 64 + L];
        float atf[16]; float cum = 0.f, gprev = 1.f, gam = 1.f;
        PREP_LOAD(raw1, item, 1);
        asm volatile("" ::: "memory");
        PREP_HALF(raw0, 0);
        { const int nit = (item + F.NGW < 160 * RW_CS) ? item + F.NGW : item; PREP_LOAD(raw0, nit, 0); }
        asm volatile("" ::: "memory");
        PREP_HALF(raw1, 1);
        *(float*)(rec + 12288 + 4 * L) = gam;
        LDS_WAIT(); asm volatile("" ::: "memory");
#pragma unroll
        for (int vt = 0; vt < 2; ++vt) { v4u w;
#pragma unroll
            for (int q = 0; q < 4; ++q) w[q] = lds_u16(VL + (8 * hh + 2 * q) * LDA + 32 * vt + li) | (lds_u16(VL + (8 * hh + 2 * q + 1) * LDA + 32 * vt + li) << 16);
            *(v4u*)(rec + 10240 + vt * 1024 + 16 * L) = w; }
#pragma unroll
        for (int kt = 0; kt < 2; ++kt) { v4u w, w2;
#pragma unroll
            for (int q = 0; q < 4; ++q) { w[q] = lds_u16(BK + (16 + 8 * hh + 2 * q) * LDA + 32 * kt + li) | (lds_u16(BK + (16 + 8 * hh + 2 * q + 1) * LDA + 32 * kt + li) << 16);
                const int j0 = 2 * q, j1 = 2 * q + 1, s0 = 8 * (j0 >> 2) + 4 * hh + (j0 & 3), s1 = 8 * (j1 >> 2) + 4 * hh + (j1 & 3);
                w2[q] = lds_u16(BK + s0 * LDA + 32 * kt + li) | (lds_u16(BK + s1 * LDA + 32 * kt + li) << 16); }
            *(v4u*)(rec + 7168 + kt * 1024 + 16 * L) = w; *(v4u*)(rec + 5120 + kt * 1024 + 16 * L) = w2; }
        f32x16 g;
#pragma unroll
        for (int e = 0; e < 16; ++e) g[e] = 0.f;
#pragma unroll
        for (int ks = 0; ks < 4; ++ks) { const bf16x8 af = *(const LAS bf16x8*)(AR + li * LDA + 16 * ks + 8 * hh); const bf16x8 bf = *(const LAS bf16x8*)(BK + li * LDA + 16 * ks + 8 * hh); g = MFMA32(af, bf, g); }
        LDS_WAIT(); asm volatile("" ::: "memory");
#pragma unroll
        for (int e = 0; e < 16; ++e) GL[((e & 3) + 8 * (e >> 2) + 4 * hh) * GLD + li] = g[e];
        LDS_WAIT(); asm volatile("" ::: "memory");
        float y2[16];
#pragma unroll
        for (int t = 0; t < 16; ++t) y2[t] = (L < 16 && L < t) ? GL[t * GLD + 16 + (L & 15)] : 0.f;
#pragma unroll
        for (int t = 1; t < 16; ++t) {
            float cf[16];
#pragma unroll
            for (int q = 0; q < 4; ++q) { if (4 * q < t) { const f32x4 c4 = *(const LAS f32x4*)(GL + t * GLD + 4 * q); cf[4 * q] = c4.x; cf[4 * q + 1] = c4.y; cf[4 * q + 2] = c4.z; cf[4 * q + 3] = c4.w; } }
#pragma unroll
            for (int s = 0; s < 16; ++s) if (s < t) { atf[t] += cf[s] * atf[s]; y2[t] += cf[s] * y2[s]; }
        }
#pragma unroll
        for (int t = 0; t < 16; ++t) { AR[t * LDA + L] = (bf16)f2bf(atf[t]); if (L < 16) M2[t * M2D + L] = (bf16)f2bf(y2[t]); }
        { const int t = L >> 2, s0 = 4 * (L & 3); const f32x4 c4 = *(const LAS f32x4*)(GL + (16 + t) * GLD + 16 + s0);
          v2u w; w.x = pk2(s0 <= t ? c4.x : 0.f, s0 + 1 <= t ? c4.y : 0.f); w.y = pk2(s0 + 2 <= t ? c4.z : 0.f, s0 + 3 <= t ? c4.w : 0.f);
          *(LAS v2u*)(M2 + (16 + t) * M2D + s0) = w; }
        LDS_WAIT(); asm volatile("" ::: "memory");
#pragma unroll
        for (int ks = 0; ks < 4; ++ks) { const v2u p0 = *(const LAS v2u*)(AR + li * LDA + 16 * ks + 4 * hh), p1 = *(const LAS v2u*)(AR + li * LDA + 16 * ks + 8 + 4 * hh);
            v4u w; w.x = p0.x; w.y = p0.y; w.z = p1.x; w.w = p1.y; *(v4u*)(rec + ks * 1024 + 16 * L) = w; }
        *(v4u*)(rec + 4096 + 16 * L) = *(const LAS v4u*)(M2 + li * M2D + 8 * hh);
        { v4u w = {0u, 0u, 0u, 0u};
          if (li >= 16) { const int t = li - 16; const f32x4 c0 = *(const LAS f32x4*)(GL + (16 + t) * GLD + 4 * hh), c1 = *(const LAS f32x4*)(GL + (16 + t) * GLD + 8 + 4 * hh); const int s0 = 4 * hh, s1 = 8 + 4 * hh;
              w.x = pk2(s0 <= t ? c0.x : 0.f, s0 + 1 <= t ? c0.y : 0.f); w.y = pk2(s0 + 2 <= t ? c0.z : 0.f, s0 + 3 <= t ? c0.w : 0.f);
              w.z = pk2(s1 <= t ? c1.x : 0.f, s1 + 1 <= t ? c1.y : 0.f); w.w = pk2(s1 + 2 <= t ? c1.z : 0.f, s1 + 3 <= t ? c1.w : 0.f); }
          *(v4u*)(rec + 9216 + 16 * L) = w; }
        LDS_WAIT(); asm volatile("" ::: "memory");
    }
#undef PREP_LOAD
#undef PREP_HALF
}
__device__ __forceinline__ void phase_rwkv_fused(const Frame& F, const Args& a, int l) {
    if (F.bid >= 160) return;
    const int sc = F.bid, seq = sc >> 4, h = (sc >> 1) & 7, z = sc & 1;
    constexpr int NCH = SEQ / 16, FR_RING = 6 * 15360, FR_FLAGS = FR_RING + 3 * RW_PBB;
    LAS unsigned char* ring = F.lds + RING_OFF + FR_RING;
    volatile LAS unsigned* ready = (volatile LAS unsigned*)(F.lds + RING_OFF + FR_FLAGS);
    volatile LAS unsigned* done = ready + 4;
    bf16* YS = (bf16*)(F.ws + WS_AR + AR_YSB);
    __syncthreads();
    if (F.tid < 16) ready[F.tid] = 0u;
    __syncthreads();
    if (F.wave >= 2) {
    const unsigned short* EA = (const unsigned short*)(F.ws + WS_AR + AR_EA); const unsigned short* RK = (const unsigned short*)(F.ws + WS_AR + AR_RKVK);
    const float* k_a = a.in[F.z + 17] + (size_t)l * 512;
    constexpr int LDA = 72, GLD = 36, M2D = 24;
    LAS unsigned char* pw = F.lds + RING_OFF + (F.wave - 2) * 15360;
    LAS bf16* AR = (LAS bf16*)pw; LAS bf16* BK = (LAS bf16*)(pw + 4608); LAS float* GL = (LAS float*)(pw + 9216); LAS bf16* VL = (LAS bf16*)(pw + 9216); LAS bf16* M2 = (LAS bf16*)(pw + 13824);
    const int L = F.lane, li = L & 31, hh = L >> 5;
#define PREP_LOAD(dst, it_, hb_) do { const int c_ = (it_), seq_ = seq, h_ = h, z_ = z; \
        _Pragma("unroll") for (int t8 = 0; t8 < 8; ++t8) { const int tau = 16 * c_ + 8 * (hb_) + t8, pos = z_ ? (SEQ - 1 - tau) : tau; const size_t tok = (size_t)seq_ * SEQ + pos; \
            dst[t8][0] = EA[tok * 2048 + z_ * 512 + h_ * 64 + L]; dst[t8][1] = EA[tok * 2048 + 1024 + z_ * 512 + h_ * 64 + L]; \
            dst[t8][2] = RK[tok * 2048 + h_ * 64 + L]; dst[t8][3] = RK[tok * 2048 + 512 + h_ * 64 + L]; dst[t8][4] = RK[tok * 2048 + 1024 + h_ * 64 + L]; dst[t8][5] = RK[tok * 2048 + 1536 + h_ * 64 + L]; } } while (0)
#define PREP_HALF(src_, hb_) do { _Pragma("unroll") for (int t8 = 0; t8 < 8; ++t8) { const int t = 8 * (hb_) + t8; \
            const float e_ = h1(src_[t8][0]), a_ = h1(src_[t8][1]), r_ = h1(src_[t8][2]), k_ = h1(src_[t8][3]), v_ = h1(src_[t8][4]), kk_ = h1(src_[t8][5]); \
            cum += e_; gam = fexp(-cum); const float ig = fexp(cum); \
            const float at = -kk_ * gprev, bt = kk_ * a_ * ig, kt = k_ * (1.0f + (a_ - 1.0f) * ka) * ig, rt = r_ * gam; \
            atf[t] = at; \
            AR[t * LDA + L] = (bf16)f2bf(at); AR[(16 + t) * LDA + L] = (bf16)f2bf(rt); BK[t * LDA + L] = (bf16)f2bf(bt); BK[(16 + t) * LDA + L] = (bf16)f2bf(kt); VL[t * LDA + L] = (bf16)f2bf(v_); \
            gprev = gam; } } while (0)
    unsigned short raw0[8][6], raw1[8][6];
    const float ka_ = k_a[h * 64 + L];
    PREP_LOAD(raw0, F.wave - 2, 0); PREP_LOAD(raw1, F.wave - 2, 1);
    for (int item = F.wave - 2; item < NCH; item += 6) {
        v4u frv[2]; float gamC;
        const float ka = ka_;
        float atf[16]; float cum = 0.f, gprev = 1.f, gam = 1.f;
        asm volatile("" ::: "memory");
        PREP_HALF(raw0, 0);
        PREP_HALF(raw1, 1);
        gamC = gam;
        LDS_WAIT(); asm volatile("" ::: "memory");
#pragma unroll
        for (int vt = 0; vt < 2; ++vt) { v4u w;
#pragma unroll
            for (int q = 0; q < 4; ++q) w[q] = lds_u16(VL + (8 * hh + 2 * q) * LDA + 32 * vt + li) | (lds_u16(VL + (8 * hh + 2 * q + 1) * LDA + 32 * vt + li) << 16);
            frv[vt] = w; }
        f32x16 g;
#pragma unroll
        for (int e = 0; e < 16; ++e) g[e] = 0.f;
#pragma unroll
        for (int ks = 0; ks < 4; ++ks) { const bf16x8 af = *(const LAS bf16x8*)(AR + li * LDA + 16 * ks + 8 * hh); const bf16x8 bf = *(const LAS bf16x8*)(BK + li * LDA + 16 * ks + 8 * hh); g = MFMA32(af, bf, g); }
        LDS_WAIT(); asm volatile("" ::: "memory");
#pragma unroll
        for (int e = 0; e < 16; ++e) GL[((e & 3) + 8 * (e >> 2) + 4 * hh) * GLD + li] = g[e];
        LDS_WAIT(); asm volatile("" ::: "memory");
        float y2[16];
#pragma unroll
        for (int t = 0; t < 16; ++t) y2[t] = (L < 16 && L < t) ? GL[t * GLD + 16 + (L & 15)] : 0.f;
#pragma unroll
        for (int t = 1; t < 16; ++t) {
            float cf[16];
#pragma unroll
            for (int q = 0; q < 4; ++q) { if (4 * q < t) { const f32x4 c4 = *(const LAS f32x4*)(GL + t * GLD + 4 * q); cf[4 * q] = c4.x; cf[4 * q + 1] = c4.y; cf[4 * q + 2] = c4.z; cf[4 * q + 3] = c4.w; } }
#pragma unroll
            for (int s = 0; s < 16; ++s) if (s < t) { atf[t] += cf[s] * atf[s]; y2[t] += cf[s] * y2[s]; }
        }
#pragma unroll
        for (int t = 0; t < 16; ++t) { AR[t * LDA + L] = (bf16)f2bf(atf[t]); if (L < 16) M2[t * M2D + L] = (bf16)f2bf(y2[t]); }
        { const int t = L >> 2, s0 = 4 * (L & 3); const f32x4 c4 = *(const LAS f32x4*)(GL + (16 + t) * GLD + 16 + s0);
          v2u w; w.x = pk2(s0 <= t ? c4.x : 0.f, s0 + 1 <= t ? c4.y : 0.f); w.y = pk2(s0 + 2 <= t ? c4.z : 0.f, s0 + 3 <= t ? c4.w : 0.f);
          *(LAS v2u*)(M2 + (16 + t) * M2D + s0) = w; }
        LDS_WAIT(); asm volatile("" ::: "memory");
        { const int nit = (item + 6 < NCH) ? item + 6 : item; PREP_LOAD(raw0, nit, 0); PREP_LOAD(raw1, nit, 1); }
        asm volatile("" ::: "memory");
        const int slot = item % 3;
        if (item >= 3) { unsigned sp = 0; while ((done[slot * 2] < (unsigned)(item - 2) || done[slot * 2 + 1] < (unsigned)(item - 2)) && ++sp < (1u << 22)) __builtin_amdgcn_s_sleep(1); }
        asm volatile("" ::: "memory");
        LAS unsigned char* rp = ring + slot * RW_PBB;
#pragma unroll
        for (int ks = 0; ks < 4; ++ks) { const v2u p0 = *(const LAS v2u*)(AR + li * LDA + 16 * ks + 4 * hh), p1 = *(const LAS v2u*)(AR + li * LDA + 16 * ks + 8 + 4 * hh);
            v4u w; w.x = p0.x; w.y = p0.y; w.z = p1.x; w.w = p1.y; *(LAS v4u*)(rp + ks * 1024 + 16 * L) = w; }
        { const v4u w4 = *(const LAS v4u*)(M2 + li * M2D + 8 * hh); *(LAS v4u*)(rp + 4096 + 16 * L) = w4; }
        { v4u w = {0u, 0u, 0u, 0u};
          if (li >= 16) { const int t = li - 16; const f32x4 c0 = *(const LAS f32x4*)(GL + (16 + t) * GLD + 4 * hh), c1 = *(const LAS f32x4*)(GL + (16 + t) * GLD + 8 + 4 * hh); const int s0 = 4 * hh, s1 = 8 + 4 * hh;
              w.x = pk2(s0 <= t ? c0.x : 0.f, s0 + 1 <= t ? c0.y : 0.f); w.y = pk2(s0 + 2 <= t ? c0.z : 0.f, s0 + 3 <= t ? c0.w : 0.f);
              w.z = pk2(s1 <= t ? c1.x : 0.f, s1 + 1 <= t ? c1.y : 0.f); w.w = pk2(s1 + 2 <= t ? c1.z : 0.f, s1 + 3 <= t ? c1.w : 0.f); }
          *(LAS v4u*)(rp + 9216 + 16 * L) = w; }
#pragma unroll
        for (int kt = 0; kt < 2; ++kt) { v4u w, w2;
#pragma unroll
            for (int q = 0; q < 4; ++q) { w[q] = lds_u16(BK + (16 + 8 * hh + 2 * q) * LDA + 32 * kt + li) | (lds_u16(BK + (16 + 8 * hh + 2 * q + 1) * LDA + 32 * kt + li) << 16);
                const int j0 = 2 * q, j1 = 2 * q + 1, s0 = 8 * (j0 >> 2) + 4 * hh + (j0 & 3), s1 = 8 * (j1 >> 2) + 4 * hh + (j1 & 3);
                w2[q] = lds_u16(BK + s0 * LDA + 32 * kt + li) | (lds_u16(BK + s1 * LDA + 32 * kt + li) << 16); }
            *(LAS v4u*)(rp + 7168 + kt * 1024 + 16 * L) = w; *(LAS v4u*)(rp + 5120 + kt * 1024 + 16 * L) = w2; }
        LDS_WAIT(); asm volatile("" ::: "memory");
        *(LAS v4u*)(rp + 10240 + 16 * L) = frv[0]; *(LAS v4u*)(rp + 11264 + 16 * L) = frv[1];
        *(LAS float*)(rp + 12288 + 4 * L) = gamC;
        LDS_WAIT(); asm volatile("" ::: "memory");
        if (L == 0) ready[slot] = (unsigned)(item + 1);
    }
#undef PREP_LOAD
#undef PREP_HALF
        return;
    }
    const int L = F.lane, li = L & 31, hh = L >> 5, vt = F.wave;
    f32x16 st[2];
#pragma unroll
    for (int kt = 0; kt < 2; ++kt)
#pragma unroll
        for (int e = 0; e < 16; ++e) st[kt][e] = 0.f;
    for (int cl = 0; cl < NCH; ++cl) {
        const int slot = cl % 3;
        { unsigned sp = 0; while (ready[slot] != (unsigned)(cl + 1) && ++sp < (1u << 22)) __builtin_amdgcn_s_sleep(1); }
        asm volatile("" ::: "memory");
        const LAS unsigned char* rec = ring + slot * RW_PBB;
        bf16x8 a1[4], btf[2], ktf[2]; f32x4 gm[2][4];
#pragma unroll
        for (int ks = 0; ks < 4; ++ks) a1[ks] = *(const LAS bf16x8*)(rec + ks * 1024 + 16 * L);
        const bf16x8 a2 = *(const LAS bf16x8*)(rec + 4096 + 16 * L), mbr = *(const LAS bf16x8*)(rec + 9216 + 16 * L), vc = *(const LAS bf16x8*)(rec + 10240 + vt * 1024 + 16 * L);
#pragma unroll
        for (int kt = 0; kt < 2; ++kt) { btf[kt] = *(const LAS bf16x8*)(rec + 5120 + kt * 1024 + 16 * L); ktf[kt] = *(const LAS bf16x8*)(rec + 7168 + kt * 1024 + 16 * L);
#pragma unroll
            for (int q4 = 0; q4 < 4; ++q4) gm[kt][q4] = *(const LAS f32x4*)(rec + 12288 + 4 * (32 * kt + 8 * q4 + 4 * hh)); }
        LDS_WAIT(); asm volatile("" ::: "memory");
        if (L == 0) done[slot * 2 + vt] = (unsigned)(cl + 1);
        f32x16 acc;
#pragma unroll
        for (int e = 0; e < 16; ++e) acc[e] = 0.f;
        acc = MFMA32(a2, vc, acc);
#pragma unroll
        for (int ks = 0; ks < 4; ++ks) { const int kt = ks >> 1, b8 = 8 * (ks & 1);
            v4u w; w.x = cvt_pk_bf16(st[kt][b8], st[kt][b8 + 1]); w.y = cvt_pk_bf16(st[kt][b8 + 2], st[kt][b8 + 3]); w.z = cvt_pk_bf16(st[kt][b8 + 4], st[kt][b8 + 5]); w.w = cvt_pk_bf16(st[kt][b8 + 6], st[kt][b8 + 7]);
            acc = MFMA32(a1[ks], __builtin_bit_cast(bf16x8, w), acc); }
        v4u uw; uw.x = cvt_pk_bf16(acc[0], acc[1]); uw.y = cvt_pk_bf16(acc[2], acc[3]); uw.z = cvt_pk_bf16(acc[4], acc[5]); uw.w = cvt_pk_bf16(acc[6], acc[7]);
        const bf16x8 uf = __builtin_bit_cast(bf16x8, uw);
        acc = MFMA32(mbr, uf, acc);
#pragma unroll
        for (int kt = 0; kt < 2; ++kt) { st[kt] = MFMA32(btf[kt], uf, st[kt]); st[kt] = MFMA32(ktf[kt], vc, st[kt]);
#pragma unroll
            for (int q4 = 0; q4 < 4; ++q4) { st[kt][4 * q4] *= gm[kt][q4].x; st[kt][4 * q4 + 1] *= gm[kt][q4].y; st[kt][4 * q4 + 2] *= gm[kt][q4].z; st[kt][4 * q4 + 3] *= gm[kt][q4].w; } }
#pragma unroll
        for (int e = 8; e < 16; ++e) { const int t = (e & 3) + 8 * ((e >> 2) - 2) + 4 * hh, tau = 16 * cl + t, pos = z ? (SEQ - 1 - tau) : tau; const size_t tok = (size_t)seq * SEQ + pos;
            YS[((size_t)z * T + tok) * 512 + h * 64 + 32 * vt + li] = (bf16)f2bf(acc[e]); }
    }
}

__device__ __forceinline__ void phase_rwkv_cscan(const Frame& F, int seg) {
    if (F.bid >= 160) return;
    const unsigned char* PB = F.ws + WS_AR + AR_PB; bf16* YS = (bf16*)(F.ws + WS_AR + AR_YSB); float* STS = (float*)(F.ws + WS_AR + AR_STS);
    LAS unsigned char* ring = F.lds + RING_OFF;
    volatile LAS unsigned* ready = (volatile LAS unsigned*)(F.lds + RING_OFF + 8 * RW_PBB);
    volatile LAS unsigned* done = ready + 8;
    const int L = F.lane, li = L & 31, hh = L >> 5, sc = F.bid, seq = sc >> 4, h = (sc >> 1) & 7, z = sc & 1;
    __syncthreads();
    if (F.tid < 24) ready[F.tid] = 0u;
    __syncthreads();
    if (F.wave >= 2) {
        for (int cl = F.wave - 2; cl < RW_CS; cl += 6) {
            const int slot = cl & 7;
            if (cl >= 8) { unsigned sp = 0; while ((done[slot * 2] < (unsigned)(cl - 7) || done[slot * 2 + 1] < (unsigned)(cl - 7)) && ++sp < (1u << 22)) __builtin_amdgcn_s_sleep(1); }
            asm volatile("" ::: "memory");
            const unsigned char* rec = PB + (size_t)(sc * RW_CS + cl) * RW_PBB;
            v4u r[13];
#pragma unroll
            for (int i = 0; i < 13; ++i) { const int o = (i * 64 + L) * 16; r[i] = (o < RW_PBB) ? *(const v4u*)(rec + o) : (v4u){0u, 0u, 0u, 0u}; }
#pragma unroll
            for (int i = 0; i < 13; ++i) { const int o = (i * 64 + L) * 16; if (o < RW_PBB) *(LAS v4u*)(ring + slot * RW_PBB + o) = r[i]; }
            LDS_WAIT(); asm volatile("" ::: "memory");
            if (L == 0) ready[slot] = (unsigned)(cl + 1);
        }
        return;
    }
    const int vt = F.wave;
    f32x16 st[2];
    float* sts = STS + ((size_t)(sc * 2 + vt) * 2) * 1024 + L;
#pragma unroll
    for (int kt = 0; kt < 2; ++kt)
#pragma unroll
        for (int e = 0; e < 16; ++e) st[kt][e] = (seg == 0) ? 0.f : sts[(kt * 16 + e) * 64];
    for (int cl = 0; cl < RW_CS; ++cl) {
        const int slot = cl & 7;
        { unsigned sp = 0; while (ready[slot] != (unsigned)(cl + 1) && ++sp < (1u << 22)) __builtin_amdgcn_s_sleep(1); }
        asm volatile("" ::: "memory");
        const LAS unsigned char* rec = ring + slot * RW_PBB;
        bf16x8 a1[4], btf[2], ktf[2]; f32x4 gm[2][4];
#pragma unroll
        for (int ks = 0; ks < 4; ++ks) a1[ks] = *(const LAS bf16x8*)(rec + ks * 1024 + 16 * L);
        const bf16x8 a2 = *(const LAS bf16x8*)(rec + 4096 + 16 * L), mbr = *(const LAS bf16x8*)(rec + 9216 + 16 * L), vc = *(const LAS bf16x8*)(rec + 10240 + vt * 1024 + 16 * L);
#pragma unroll
        for (int kt = 0; kt < 2; ++kt) { btf[kt] = *(const LAS bf16x8*)(rec + 5120 + kt * 1024 + 16 * L); ktf[kt] = *(const LAS bf16x8*)(rec + 7168 + kt * 1024 + 16 * L);
#pragma unroll
            for (int q4 = 0; q4 < 4; ++q4) gm[kt][q4] = *(const LAS f32x4*)(rec + 12288 + 4 * (32 * kt + 8 * q4 + 4 * hh)); }
        LDS_WAIT(); asm volatile("" ::: "memory");
        if (L == 0) done[slot * 2 + vt] = (unsigned)(cl + 1);
        f32x16 acc;
#pragma unroll
        for (int e = 0; e < 16; ++e) acc[e] = 0.f;
        acc = MFMA32(a2, vc, acc);
#pragma unroll
        for (int ks = 0; ks < 4; ++ks) { const int kt = ks >> 1, b8 = 8 * (ks & 1);
            v4u w; w.x = cvt_pk_bf16(st[kt][b8], st[kt][b8 + 1]); w.y = cvt_pk_bf16(st[kt][b8 + 2], st[kt][b8 + 3]); w.z = cvt_pk_bf16(st[kt][b8 + 4], st[kt][b8 + 5]); w.w = cvt_pk_bf16(st[kt][b8 + 6], st[kt][b8 + 7]);
            acc = MFMA32(a1[ks], __builtin_bit_cast(bf16x8, w), acc); }
        v4u uw; uw.x = cvt_pk_bf16(acc[0], acc[1]); uw.y = cvt_pk_bf16(acc[2], acc[3]); uw.z = cvt_pk_bf16(acc[4], acc[5]); uw.w = cvt_pk_bf16(acc[6], acc[7]);
        const bf16x8 uf = __builtin_bit_cast(bf16x8, uw);
        acc = MFMA32(mbr, uf, acc);
#pragma unroll
        for (int kt = 0; kt < 2; ++kt) { st[kt] = MFMA32(btf[kt], uf, st[kt]); st[kt] = MFMA32(ktf[kt], vc, st[kt]);
#pragma unroll
            for (int q4 = 0; q4 < 4; ++q4) { st[kt][4 * q4] *= gm[kt][q4].x; st[kt][4 * q4 + 1] *= gm[kt][q4].y; st[kt][4 * q4 + 2] *= gm[kt][q4].z; st[kt][4 * q4 + 3] *= gm[kt][q4].w; } }
        const int c = seg * RW_CS + cl;
#pragma unroll
        for (int e = 8; e < 16; ++e) { const int t = (e & 3) + 8 * ((e >> 2) - 2) + 4 * hh, tau = 16 * c + t, pos = z ? (SEQ - 1 - tau) : tau; const size_t tok = (size_t)seq * SEQ + pos;
            YS[((size_t)z * T + tok) * 512 + h * 64 + 32 * vt + li] = (bf16)f2bf(acc[e]); }
    }
#pragma unroll
    for (int kt = 0; kt < 2; ++kt)
#pragma unroll
        for (int e = 0; e < 16; ++e) sts[(kt * 16 + e) * 64] = st[kt][e];
}

__device__ __forceinline__ void phase_rwkv_post(const Frame& F, const Args& a, int l) {
    const unsigned short* EA = (const unsigned short*)(F.ws + WS_AR + AR_EA); const unsigned short* RK = (const unsigned short*)(F.ws + WS_AR + AR_RKVK);
    const bf16* GT = (const bf16*)(F.ws + WS_AR + AR_GT); const float* YS = (const float*)(F.ws + WS_AR + AR_YS); const bf16* YSB = (const bf16*)(F.ws + WS_AR + AR_YSB); bf16* YC = (bf16*)(F.ws + WS_AR + AR_YC); (void)YS; (void)YSB;
    const float* k_a = a.in[F.z + 17] + (size_t)l * 512; const float* r_k = a.in[F.z + 18] + (size_t)l * 512; const float* ln_w = a.in[F.z + 19] + (size_t)l * 512; const float* ln_b = a.in[F.z + 20] + (size_t)l * 512;
    const int lane = F.lane, c0 = 8 * lane;
    for (int t = F.gw; t < T; t += F.NGW) {
        float y[8];
#if MK_CHUNKED
        { const v4u p = *(const v4u*)(YSB + (size_t)t * 512 + c0), q = *(const v4u*)(YSB + ((size_t)T + t) * 512 + c0);
#pragma unroll
          for (int i = 0; i < 4; ++i) { y[2 * i] = bf_lo(p[i]) + bf_lo(q[i]); y[2 * i + 1] = bf_hi(p[i]) + bf_hi(q[i]); } }
#else
        { const f32x4 p0 = *(const f32x4*)(YS + (size_t)t * 512 + c0), p1 = *(const f32x4*)(YS + (size_t)t * 512 + c0 + 4);
          const f32x4 q0 = *(const f32x4*)(YS + ((size_t)T + t) * 512 + c0), q1 = *(const f32x4*)(YS + ((size_t)T + t) * 512 + c0 + 4);
          y[0] = p0.x + q0.x; y[1] = p0.y + q0.y; y[2] = p0.z + q0.z; y[3] = p0.w + q0.w; y[4] = p1.x + q1.x; y[5] = p1.y + q1.y; y[6] = p1.z + q1.z; y[7] = p1.w + q1.w; }
#endif
        const v4u rr = *(const v4u*)(RK + (size_t)t * 2048 + c0), kk = *(const v4u*)(RK + (size_t)t * 2048 + 512 + c0), vv = *(const v4u*)(RK + (size_t)t * 2048 + 1024 + c0);
        const v4u a0 = *(const v4u*)(EA + (size_t)t * 2048 + 1024 + c0), a1 = *(const v4u*)(EA + (size_t)t * 2048 + 1536 + c0);
        const v4u gg = *(const v4u*)(GT + (size_t)t * 512 + c0);
        float r[8], k[8], v[8], aa0[8], aa1[8], g[8];
#pragma unroll
        for (int q = 0; q < 4; ++q) { r[2 * q] = h_lo(rr[q]); r[2 * q + 1] = h_hi(rr[q]); k[2 * q] = h_lo(kk[q]); k[2 * q + 1] = h_hi(kk[q]); v[2 * q] = h_lo(vv[q]); v[2 * q + 1] = h_hi(vv[q]);
            aa0[2 * q] = h_lo(a0[q]); aa0[2 * q + 1] = h_hi(a0[q]); aa1[2 * q] = h_lo(a1[q]); aa1[2 * q + 1] = h_hi(a1[q]); g[2 * q] = bf_lo(gg[q]); g[2 * q + 1] = bf_hi(gg[q]); }
        float s = 0.f, bon = 0.f;
#pragma unroll
        for (int e = 0; e < 8; ++e) { s += y[e]; const float kaa = k_a[c0 + e]; bon += r[e] * k[e] * r_k[c0 + e] * ((1.0f + (aa0[e] - 1.0f) * kaa) + (1.0f + (aa1[e] - 1.0f) * kaa)); }
        s += shfl_xor_(s, 1); s += shfl_xor_(s, 2); s += shfl_xor_(s, 4);
        bon += shfl_xor_(bon, 1); bon += shfl_xor_(bon, 2); bon += shfl_xor_(bon, 4);
        const float mu = s * (1.0f / 64.0f); float q2 = 0.f;
#pragma unroll
        for (int e = 0; e < 8; ++e) { const float d_ = y[e] - mu; q2 += d_ * d_; }
        q2 += shfl_xor_(q2, 1); q2 += shfl_xor_(q2, 2); q2 += shfl_xor_(q2, 4);
        const float rstd = 1.0f / sqrtf(q2 * (1.0f / 64.0f) + 64e-5f);
        float o[8];
#pragma unroll
        for (int e = 0; e < 8; ++e) o[e] = (((y[e] - mu) * rstd) * ln_w[c0 + e] + ln_b[c0 + e] + bon * v[e]) * g[e];
        v4u w; w.x = pk2(o[0], o[1]); w.y = pk2(o[2], o[3]); w.z = pk2(o[4], o[5]); w.w = pk2(o[6], o[7]);
        *(v4u*)(YC + (size_t)t * 512 + c0) = w;
    }
}

__device__ __forceinline__ void phase_attn(const Frame& F, const Args& a) {
    const bf16* QA = (const bf16*)(F.ws + WS_AR + AR_QA); const bf16* KA = (const bf16*)(F.ws + WS_AR + AR_KA); const bf16* VTA = (const bf16*)(F.ws + WS_AR + AR_VTA);
    bf16* OA = (bf16*)(F.ws + WS_AR + AR_OA); float* LSE = (float*)(F.ws + WS_AR + AR_LSE);
    constexpr int PLD = 336;
    LAS unsigned char* Pw = F.lds + RING_OFF + F.wave * (32 * PLD);
    const int lane = F.lane, li = lane & 31, hh = lane >> 5;
    for (int w = F.gw; w < 15360; w += F.NGW) {
        const int h = w & 3, pq = (w >> 2) & 127, rest = w >> 9, seq = rest % 10, g = rest / 10;
        const int d = (g == 0) ? 1 : (g == 1 ? 4 : 16), Lg = SEQ / d, nqb = Lg / 32, p = pq / nqb, qb = pq % nqb;
        const size_t base = (size_t)seq * SEQ + (size_t)p * Lg;
        const float slope = __builtin_amdgcn_exp2f(-8.0f * (float)(g * 4 + h + 1) / 12.0f) * (float)d;
        const bf16* Qg = QA + (size_t)g * T * 512; const bf16* Kg = KA + (size_t)g * T * 512; const bf16* Vg = VTA + (size_t)g * 512 * T;
        f32x16 x[5]; bool tv[5]; int sc_[5];
#pragma unroll
        for (int kt = 0; kt < 5; ++kt) { const int s_t = 32 * qb - 64 + 32 * kt; tv[kt] = (s_t >= 0) && (s_t < Lg); sc_[kt] = tv[kt] ? s_t : 32 * qb;
#pragma unroll
            for (int e = 0; e < 16; ++e) x[kt][e] = 0.f; }
        { bf16x8 ka[8], kb[8];
          { bf16x8 qf[8];
#pragma unroll
            for (int ks = 0; ks < 8; ++ks) qf[ks] = *(const bf16x8*)(Qg + ((((base + 32 * qb) >> 5) * 4 + h) * 8 + ks) * 512 + lane * 8);
#pragma unroll
            for (int ks = 0; ks < 8; ++ks) *(LAS bf16x8*)(Pw + li * PLD + (16 * ks + 8 * hh) * 2) = qf[ks]; }
#pragma unroll
          for (int ks = 0; ks < 8; ++ks) { ka[ks] = *(const bf16x8*)(Kg + ((((base + sc_[0]) >> 5) * 4 + h) * 8 + ks) * 512 + lane * 8); kb[ks] = *(const bf16x8*)(Kg + ((((base + sc_[1]) >> 5) * 4 + h) * 8 + ks) * 512 + lane * 8); }
          asm volatile("" ::: "memory");
          LDS_WAIT(); asm volatile("" ::: "memory");
#pragma unroll
          for (int ks = 0; ks < 8; ++ks) { const bf16x8 q = *(const LAS bf16x8*)(Pw + li * PLD + (16 * ks + 8 * hh) * 2); x[0] = MFMA32(ka[ks], q, x[0]); x[1] = MFMA32(kb[ks], q, x[1]); }
#pragma unroll
          for (int ks = 0; ks < 8; ++ks) { ka[ks] = *(const bf16x8*)(Kg + ((((base + sc_[2]) >> 5) * 4 + h) * 8 + ks) * 512 + lane * 8); kb[ks] = *(const bf16x8*)(Kg + ((((base + sc_[3]) >> 5) * 4 + h) * 8 + ks) * 512 + lane * 8); }
          asm volatile("" ::: "memory");
#pragma unroll
          for (int ks = 0; ks < 8; ++ks) { const bf16x8 q = *(const LAS bf16x8*)(Pw + li * PLD + (16 * ks + 8 * hh) * 2); x[2] = MFMA32(ka[ks], q, x[2]); x[3] = MFMA32(kb[ks], q, x[3]); }
#pragma unroll
          for (int ks = 0; ks < 8; ++ks) ka[ks] = *(const bf16x8*)(Kg + ((((base + sc_[4]) >> 5) * 4 + h) * 8 + ks) * 512 + lane * 8);
          asm volatile("" ::: "memory");
#pragma unroll
          for (int ks = 0; ks < 8; ++ks) { const bf16x8 q = *(const LAS bf16x8*)(Pw + li * PLD + (16 * ks + 8 * hh) * 2); x[4] = MFMA32(ka[ks], q, x[4]); }
          LDS_WAIT(); asm volatile("" ::: "memory");
        }
        float mx = -1e30f;
#pragma unroll
        for (int kt = 0; kt < 5; ++kt)
#pragma unroll
            for (int e = 0; e < 16; ++e) { const int j = (e & 3) + 8 * (e >> 2) + 4 * hh; const int rel = 32 * kt - 64 + j - li; const int ar = rel < 0 ? -rel : rel;
                const bool ok = tv[kt] && ar <= 64; const float sv = ok ? (x[kt][e] - slope * (float)ar) : -1e30f; x[kt][e] = sv; mx = fmaxf(mx, sv); }
        mx = fmaxf(mx, shfl_xor_(mx, 32));
        float sum = 0.f;
#pragma unroll
        for (int kt = 0; kt < 5; ++kt)
#pragma unroll
            for (int e = 0; e < 16; ++e) { const float pv = (x[kt][e] > -1e29f) ? fexp(x[kt][e] - mx) : 0.f; x[kt][e] = pv; sum += pv; }
        sum += shfl_xor_(sum, 32);
        const float inv = 1.0f / sum;
        if (hh == 0) { const size_t tok = (size_t)seq * SEQ + (size_t)(32 * qb + li) * d + p; LSE[((size_t)g * T + tok) * 4 + h] = mx + __builtin_amdgcn_logf(sum) * 0.69314718056f; }
#pragma unroll
        for (int kt = 0; kt < 5; ++kt)
#pragma unroll
            for (int q4 = 0; q4 < 4; ++q4) { v2u pw; pw.x = cvt_pk_bf16(x[kt][4 * q4] * inv, x[kt][4 * q4 + 1] * inv); pw.y = cvt_pk_bf16(x[kt][4 * q4 + 2] * inv, x[kt][4 * q4 + 3] * inv);
                *(LAS v2u*)(Pw + li * PLD + (kt * 32 + 8 * q4 + 4 * hh) * 2) = pw; }
        LDS_WAIT(); asm volatile("" ::: "memory");
#pragma unroll
        for (int dt = 0; dt < 4; ++dt) {
            bf16x8 vf[5][2];
#pragma unroll
            for (int kt = 0; kt < 5; ++kt)
#pragma unroll
                for (int k2 = 0; k2 < 2; ++k2) vf[kt][k2] = *(const bf16x8*)(Vg + ((((size_t)(h * 4 + dt) * (T / 32) + ((base + sc_[kt]) >> 5)) * 2 + k2) * 512 + lane * 8));
            asm volatile("" ::: "memory");
            f32x16 o;
#pragma unroll
            for (int e = 0; e < 16; ++e) o[e] = 0.f;
#pragma unroll
            for (int kt = 0; kt < 5; ++kt)
#pragma unroll
                for (int k2 = 0; k2 < 2; ++k2) { const bf16x8 pf = *(const LAS bf16x8*)(Pw + li * PLD + (kt * 32 + 16 * k2 + 8 * hh) * 2); o = MFMA32(pf, vf[kt][k2], o); }
#pragma unroll
            for (int e = 0; e < 16; ++e) { const int i = (e & 3) + 8 * (e >> 2) + 4 * hh; const size_t tok = (size_t)seq * SEQ + (size_t)(32 * qb + i) * d + p;
                OA[((size_t)g * T + tok) * 512 + h * 128 + dt * 32 + li] = (bf16)f2bf(o[e]); }
        }
        LDS_WAIT(); asm volatile("" ::: "memory");
    }
}
__device__ __forceinline__ void phase_attn_post(const Frame& F, const Args& a) {
    const bf16* OA = (const bf16*)(F.ws + WS_AR + AR_OA); const float* LSE = (const float*)(F.ws + WS_AR + AR_LSE); bf16* YA = (bf16*)(F.ws + WS_AR + AR_YA);
    const int lane = F.lane, c0 = 8 * lane, h = lane >> 4;
    for (int t = F.gw; t < T; t += F.NGW) {
        const float l0 = LSE[((size_t)0 * T + t) * 4 + h], l1 = LSE[((size_t)1 * T + t) * 4 + h], l2 = LSE[((size_t)2 * T + t) * 4 + h];
        const float m = fmaxf(l0, fmaxf(l1, l2)); float w0 = fexp(l0 - m), w1 = fexp(l1 - m), w2 = fexp(l2 - m); const float inv = 1.0f / (w0 + w1 + w2); w0 *= inv; w1 *= inv; w2 *= inv;
        const v4u o0 = *(const v4u*)(OA + ((size_t)0 * T + t) * 512 + c0), o1 = *(const v4u*)(OA + ((size_t)1 * T + t) * 512 + c0), o2 = *(const v4u*)(OA + ((size_t)2 * T + t) * 512 + c0);
        v4u w;
#pragma unroll
        for (int q = 0; q < 4; ++q) w[q] = pk2(w0 * bf_lo(o0[q]) + w1 * bf_lo(o1[q]) + w2 * bf_lo(o2[q]), w0 * bf_hi(o0[q]) + w1 * bf_hi(o1[q]) + w2 * bf_hi(o2[q]));
        *(v4u*)(YA + (size_t)t * 512 + c0) = w;
    }
}

__device__ __forceinline__ void phase_ret_kv(const Frame& F) {
    const bf16* RKT = (const bf16*)(F.ws + WS_AR + AR_RKT); const bf16* RVT = (const bf16*)(F.ws + WS_AR + AR_RVT); bf16* SB = (bf16*)(F.ws + WS_AR + AR_SB);
    const int lane = F.lane, li = lane & 31, hh = lane >> 5, w = F.wave;
    for (int it = F.bid; it < 1280; it += F.G) {
        const int n = it & 31, h = (it >> 5) & 3, seq = it >> 7; const size_t tok0 = (size_t)seq * SEQ + 128 * n;
        const bf16* vrow = RVT + (size_t)(h * 256 + 32 * w + li) * T + tok0 + 8 * hh;
        bf16x8 vf[8];
#pragma unroll
        for (int ks = 0; ks < 8; ++ks) vf[ks] = *(const bf16x8*)(vrow + 16 * ks);
        bf16* sbase = SB + ((size_t)((seq * 4 + h) * 32 + n) * 256 + 32 * w) * 256;
#pragma unroll 1
        for (int t4 = 0; t4 < 4; ++t4) {
            const int z = t4 >> 1, dk0 = 2 * (t4 & 1);
            const bf16* krow = RKT + (size_t)(z * 512 + h * 128 + 32 * dk0 + li) * T + tok0 + 8 * hh;
            bf16x8 kfa[8], kfb[8];
#pragma unroll
            for (int ks = 0; ks < 8; ++ks) { kfa[ks] = *(const bf16x8*)(krow + 16 * ks); kfb[ks] = *(const bf16x8*)(krow + (size_t)32 * T + 16 * ks); }
            asm volatile("" ::: "memory");
            f32x16 acc0, acc1;
#pragma unroll
            for (int e = 0; e < 16; ++e) { acc0[e] = 0.f; acc1[e] = 0.f; }
#pragma unroll
            for (int ks = 0; ks < 8; ++ks) { acc0 = MFMA32(vf[ks], kfa[ks], acc0); acc1 = MFMA32(vf[ks], kfb[ks], acc1); }
#pragma unroll
            for (int e = 0; e < 16; ++e) { const int dv = (e & 3) + 8 * (e >> 2) + 4 * hh; sbase[(size_t)dv * 256 + z * 128 + 32 * dk0 + li] = (bf16)f2bf(acc0[e]); sbase[(size_t)dv * 256 + z * 128 + 32 * dk0 + 32 + li] = (bf16)f2bf(acc1[e]); }
        }
    }
}
__device__ __forceinline__ void phase_ret_prefix(const Frame& F, const Args& a, int l) {
    bf16* SB = (bf16*)(F.ws + WS_AR + AR_SB); const float* dlog = a.in[F.z + 8] + (size_t)l * 8;
    const int gt = F.bid * NTHR + F.tid, NGT = F.G * NTHR;
    for (int i = gt; i < 40 * 8192; i += NGT) {
        const int p = i >> 13, v = i & 8191, h = p & 3, z = (v >> 4) & 1;
        const float lg = dlog[z * 4 + h]; const float g = __builtin_amdgcn_exp2f(-__builtin_amdgcn_logf(1.0f + fexp(-lg)) * 128.0f);
        bf16* base = SB + (size_t)p * 32 * 65536 + (size_t)v * 8;
        float carry[8];
#pragma unroll
        for (int e = 0; e < 8; ++e) carry[e] = 0.f;
#pragma unroll 4
        for (int st = 0; st < 32; ++st) {
            const int n = z ? (31 - st) : st; v4u* ptr = (v4u*)(base + (size_t)n * 65536);
            const v4u kv = *ptr; v4u o;
#pragma unroll
            for (int q = 0; q < 4; ++q) { o[q] = pk2(carry[2 * q], carry[2 * q + 1]); carry[2 * q] = g * carry[2 * q] + bf_lo(kv[q]); carry[2 * q + 1] = g * carry[2 * q + 1] + bf_hi(kv[q]); }
            *ptr = o;
        }
    }
}
__device__ __forceinline__ void phase_ret_state(const Frame& F, const Args& a, int l) {
    const bf16* RKT = (const bf16*)(F.ws + WS_AR + AR_RKT); const bf16* RVT = (const bf16*)(F.ws + WS_AR + AR_RVT); bf16* SB = (bf16*)(F.ws + WS_AR + AR_SB);
    const float* dlog = a.in[F.z + 8] + (size_t)l * 8;
    const int lane = F.lane, li = lane & 31, hh = lane >> 5;
    if (F.wave >= 5) return;
    for (int q = F.bid * 5 + F.wave; q < 1280; q += F.G * 5) {
        const int kh = q & 1, dt = (q >> 1) & 7, z = (q >> 4) & 1, h = (q >> 5) & 3, seq = q >> 7;
        const float g = __builtin_amdgcn_exp2f(-__builtin_amdgcn_logf(1.0f + fexp(-dlog[z * 4 + h])) * 128.0f);
        const bf16* krow = RKT + (size_t)(z * 512 + h * 128 + 64 * kh + rperm(li)) * T + (size_t)seq * SEQ + 8 * hh;
        const bf16* vrow = RVT + (size_t)(h * 256 + 32 * dt + li) * T + (size_t)seq * SEQ + 8 * hh;
        bf16* srow = SB + ((size_t)((seq * 4 + h) * 32) * 256 + 32 * dt + li) * 256 + z * 128 + 64 * kh + 8 * hh;
        f32x16 acc0, acc1;
#pragma unroll
        for (int e = 0; e < 16; ++e) { acc0[e] = 0.f; acc1[e] = 0.f; }
        bf16x8 vf[8], kfa[8], kfb[8];
        { const int n0 = z ? 31 : 0;
#pragma unroll
          for (int ks = 0; ks < 8; ++ks) { vf[ks] = *(const bf16x8*)(vrow + 128 * n0 + 16 * ks); kfa[ks] = *(const bf16x8*)(krow + 128 * n0 + 16 * ks); kfb[ks] = *(const bf16x8*)(krow + (size_t)32 * T + 128 * n0 + 16 * ks); } }
#pragma unroll 1
        for (int st = 0; st < 32; ++st) {
            const int n = z ? (31 - st) : st; const int st1 = st < 31 ? st + 1 : 31, nn = z ? (31 - st1) : st1;
            bf16* sp = srow + (size_t)n * 65536;
            *(v4u*)sp = pk8(acc0, 0); *(v4u*)(sp + 16) = pk8(acc0, 8); *(v4u*)(sp + 32) = pk8(acc1, 0); *(v4u*)(sp + 48) = pk8(acc1, 8);
#pragma unroll
            for (int e = 0; e < 16; ++e) { acc0[e] *= g; acc1[e] *= g; }
#pragma unroll
            for (int ks = 0; ks < 8; ++ks) acc0 = MFMA32(kfa[ks], vf[ks], acc0);
#pragma unroll
            for (int ks = 0; ks < 8; ++ks) kfa[ks] = *(const bf16x8*)(krow + 128 * nn + 16 * ks);
#pragma unroll
            for (int ks = 0; ks < 8; ++ks) acc1 = MFMA32(kfb[ks], vf[ks], acc1);
#pragma unroll
            for (int ks = 0; ks < 8; ++ks) { kfb[ks] = *(const bf16x8*)(krow + (size_t)32 * T + 128 * nn + 16 * ks); vf[ks] = *(const bf16x8*)(vrow + 128 * nn + 16 * ks); }
        }
    }
}
__device__ __forceinline__ void phase_ret_out(const Frame& F, const Args& a, int l) {
    const bf16* RQ = (const bf16*)(F.ws + WS_AR + AR_RQ); const bf16* RKm = (const bf16*)(F.ws + WS_AR + AR_RK); const bf16* RVT = (const bf16*)(F.ws + WS_AR + AR_RVT);
    const bf16* RG = (const bf16*)(F.ws + WS_AR + AR_RG); const bf16* SB = (const bf16*)(F.ws + WS_AR + AR_SB); bf16* YB = (bf16*)(F.ws + WS_AR + AR_YB);
    const float* dlog = a.in[F.z + 8] + (size_t)l * 8; const float* rn = a.in[F.z + 9] + (size_t)l * 1024;
    constexpr int PLD = 272;
    LAS unsigned char* Pl = F.lds + RING_OFF;
    LAS f32x2* SX = (LAS f32x2*)(F.lds + RING_OFF + 4 * 32 * PLD);
    const int lane = F.lane, li = lane & 31, hh = lane >> 5, w = F.wave, qi = w & 3, dj = w >> 2;
    LAS unsigned char* stg = F.lds + RING_OFF + 40960 + w * (32 * PLD);
    for (int it = F.bid; it < 1280; it += F.G) {
        const int n = it & 31, h = (it >> 5) & 3, seq = it >> 7; const size_t tok0 = (size_t)seq * SEQ + 128 * n;
        const float l2g0 = -__builtin_amdgcn_logf(1.0f + fexp(-dlog[h])), l2g1 = -__builtin_amdgcn_logf(1.0f + fexp(-dlog[4 + h]));
        __syncthreads();
        const bf16* qrow = RQ + (tok0 + 32 * qi + li) * 512 + h * 128 + 8 * hh;
        bf16x8 qf[8];
#pragma unroll
        for (int ks = 0; ks < 8; ++ks) qf[ks] = *(const bf16x8*)(qrow + 16 * ks);
        const int ip = 32 * qi + li;
#pragma unroll 1
        for (int k2 = 0; k2 < 2; ++k2) {
            const int kt = 2 * dj + k2;
            const bf16* krow_ = RKm + (tok0 + 32 * kt + li) * 512 + h * 128 + 8 * hh;
            f32x16 x;
#pragma unroll
            for (int e = 0; e < 16; ++e) x[e] = 0.f;
#pragma unroll
            for (int ks = 0; ks < 8; ++ks) { const bf16x8 kf = *(const bf16x8*)(krow_ + 16 * ks); x = MFMA32(kf, qf[ks], x); }
#pragma unroll
            for (int q4 = 0; q4 < 4; ++q4) {
                float pv[4];
#pragma unroll
                for (int e = 0; e < 4; ++e) { const int jp = 32 * kt + e + 8 * q4 + 4 * hh; const int df = ip - jp;
                    const float f0 = (df >= 0) ? __builtin_amdgcn_exp2f(l2g0 * (float)df) : 0.f, f1 = (df <= 0) ? __builtin_amdgcn_exp2f(l2g1 * (float)(-df)) : 0.f;
                    pv[e] = x[4 * q4 + e] * (f0 + f1); }
                v2u pw; pw.x = cvt_pk_bf16(pv[0], pv[1]); pw.y = cvt_pk_bf16(pv[2], pv[3]);
                *(LAS v2u*)(Pl + (qi * 32 + li) * PLD + (kt * 32 + 8 * q4 + 4 * hh) * 2) = pw;
            }
        }
        LDS_WAIT(); __syncthreads();
        const float e0 = l2g0 * (float)(ip + 1), e1 = l2g1 * (float)(128 - ip);
        const float ratio = __builtin_amdgcn_exp2f(e0 - e1), xi1 = __builtin_amdgcn_exp2f(e1);
        f32x16 o[4]; float s1 = 0.f, s2 = 0.f;
#pragma unroll
        for (int dt = 0; dt < 4; ++dt) {
            const int dvr = 128 * dj + 32 * dt + li;
            const bf16* srow = SB + ((size_t)((seq * 4 + h) * 32 + n) * 256 + dvr) * 256 + 8 * hh;
            const bf16* vrow = RVT + (size_t)(h * 256 + dvr) * T + tok0 + 8 * hh;
            f32x16 acc;
#pragma unroll
            for (int e = 0; e < 16; ++e) acc[e] = 0.f;
            bf16x8 s0f[8], s1f[8], vff[8];
#pragma unroll
            for (int ks = 0; ks < 8; ++ks) { s0f[ks] = *(const bf16x8*)(srow + 16 * ks); s1f[ks] = *(const bf16x8*)(srow + 128 + 16 * ks); vff[ks] = *(const bf16x8*)(vrow + 16 * ks); }
            asm volatile("" ::: "memory");
#pragma unroll
            for (int ks = 0; ks < 8; ++ks) acc = MFMA32(s0f[ks], qf[ks], acc);
#pragma unroll
            for (int e = 0; e < 16; ++e) acc[e] *= ratio;
#pragma unroll
            for (int ks = 0; ks < 8; ++ks) acc = MFMA32(s1f[ks], qf[ks], acc);
#pragma unroll
            for (int e = 0; e < 16; ++e) acc[e] *= xi1;
#pragma unroll
            for (int ks = 0; ks < 8; ++ks) { const bf16x8 pf = *(const LAS bf16x8*)(Pl + (qi * 32 + li) * PLD + (16 * ks + 8 * hh) * 2); acc = MFMA32(vff[ks], pf, acc); }
#pragma unroll
            for (int e = 0; e < 16; ++e) { s1 += acc[e]; s2 += acc[e] * acc[e]; }
            o[dt] = acc;
        }
        s1 += shfl_xor_(s1, 32); s2 += shfl_xor_(s2, 32);
        if (hh == 0) SX[(dj * 4 + qi) * 32 + li] = (f32x2){s1, s2};
        LDS_WAIT(); __syncthreads();
        { const f32x2 ot = SX[((dj ^ 1) * 4 + qi) * 32 + li]; s1 += ot.x; s2 += ot.y; }
        const float mu = s1 * (1.0f / 256.0f); const float var = fmaxf(s2 * (1.0f / 256.0f) - mu * mu, 0.f); const float rstd = 1.0f / sqrtf(var + 1e-5f);
#pragma unroll
        for (int dt = 0; dt < 4; ++dt)
#pragma unroll
            for (int q4 = 0; q4 < 4; ++q4) { v2u pw; pw.x = cvt_pk_bf16((o[dt][4 * q4] - mu) * rstd, (o[dt][4 * q4 + 1] - mu) * rstd); pw.y = cvt_pk_bf16((o[dt][4 * q4 + 2] - mu) * rstd, (o[dt][4 * q4 + 3] - mu) * rstd);
                *(LAS v2u*)(stg + li * PLD + (32 * dt + 8 * q4 + 4 * hh) * 2) = pw; }
        LDS_WAIT(); asm volatile("" ::: "memory");
#pragma unroll
        for (int j = 0; j < 8; ++j) {
            const int idx = lane + 64 * j, q = idx >> 4, cv = idx & 15, col = h * 256 + 128 * dj + 8 * cv;
            const v4u ov = *(const LAS v4u*)(stg + q * PLD + cv * 16);
            const size_t tok = tok0 + 32 * qi + q;
            const v4u gv = *(const v4u*)(RG + tok * 1024 + col);
            const f32x4 r0 = *(const f32x4*)(rn + col), r1 = *(const f32x4*)(rn + col + 4);
            const float rr[8] = {r0.x, r0.y, r0.z, r0.w, r1.x, r1.y, r1.z, r1.w};
            v4u wv;
#pragma unroll
            for (int q2 = 0; q2 < 4; ++q2) { const float ga = bf_lo(gv[q2]), gb = bf_hi(gv[q2]);
                wv[q2] = pk2(ga * fsigmoid(ga) * bf_lo(ov[q2]) * rr[2 * q2], gb * fsigmoid(gb) * bf_hi(ov[q2]) * rr[2 * q2 + 1]); }
            *(v4u*)(YB + tok * 1024 + col) = wv;
        }
    }
    __syncthreads();
}
__device__ __forceinline__ void phase_zero(const Frame& F, void* p, size_t bytes) {
    v4u* q = (v4u*)p; const v4u z = {0u, 0u, 0u, 0u};
    for (size_t i = (size_t)F.bid * NTHR + F.tid; i < bytes / 16; i += (size_t)F.G * NTHR) q[i] = z;
}

__global__ void __launch_bounds__(NTHR, 2) mk_fwd(Args args) {
    extern __shared__ __attribute__((aligned(16))) unsigned char lds[];
    {
        const int t0 = threadIdx.x;
        for (int u = t0; u < (LDS_BYTES - LDSCTL_OFF) / 4; u += NTHR) ((LAS unsigned*)((LAS unsigned char*)lds + LDSCTL_OFF))[u] = 0u;
        __syncthreads();
    }
    XcdBarrier bar; bar.bar = (unsigned*)(args.ws + WS_CTL) + CW_BAR; bar.x = 0; bar.st = nullptr;
#if !MK_PER_PHASE_LAUNCH
    bar = xcd_barrier_post((unsigned*)(args.ws + WS_CTL) + CW_BAR, (volatile LAS unsigned*)((LAS unsigned char*)lds + MISC_OFF) + 8);
#endif
    const int wave_s = __builtin_amdgcn_readfirstlane((int)(threadIdx.x >> 6));
    const int lo = args.ph_lo, hi = args.ph_hi;
    int pc = 0;
#define PH_ON (pc >= lo && pc < hi)
#if MK_PER_PHASE_LAUNCH
#define PH_END do { ++pc; } while (0)
#else
#ifdef MK_NOBAR
#define PH_END do { __syncthreads(); ++pc; } while (0)
#else
#define PH_END do { if (pc >= lo && pc + 1 < hi) xcd_barrier(bar, wave_s == 0 && lane_id() == 0); ++pc; } while (0)
#endif
#endif
#define PH_REP(k) _Pragma("nounroll") for (int rep_ = 0; rep_ < (((MK_REPMASK) >> (k)) & 1) + 1; ++rep_)
#define PH_REPBAR(k) if ((((MK_REPMASK) >> (k)) & 1) && rep_ == 0) xcd_barrier(bar, wave_s == 0 && lane_id() == 0)
#define WTH wt
#define PH_FRAME Frame F; int z_; asm volatile("s_mov_b32 %0, 0" : "=s"(z_)); { int t_ = wave_s * 64 + lane_id(); asm volatile("" : "+v"(t_)); unsigned char* w_ = (unsigned char*)(GAS unsigned char*)ld_karg64(248); F.lds = (LAS unsigned char*)lds; F.ws = w_; F.z = z_; F.tid = t_; F.lane = t_ & 63; \
        F.wave = __builtin_amdgcn_readfirstlane(t_ >> 6); { int g_ = __builtin_amdgcn_readfirstlane((int)gridDim.x), b_ = __builtin_amdgcn_readfirstlane((int)blockIdx.x), g2_, b2_; asm volatile("s_mov_b32 %0, %2\n\ts_mov_b32 %1, %3" : "=&s"(g2_), "=&s"(b2_) : "s"(g_), "s"(b_)); F.G = g2_; F.bid = b2_; } F.gw = F.bid * NWAVES + F.wave; F.NGW = F.G * NWAVES; } \
        unsigned char* const wt = F.ws + WS_WT; unsigned char* const ar = F.ws + WS_AR; bf16* const XN = (bf16*)(F.ws + WS_XN); LAS unsigned char* const ring = F.lds + RING_OFF; \
        bf16* X = (bf16*)((GAS unsigned char*)ld_karg64(240) + XB_OFF); const int c = F.bid; (void)wt; (void)ar; (void)XN; (void)ring; (void)c;

#pragma nounroll
    for (int l = 0; l < DEPTH; ++l) {
        const bool ovl = gridDim.x > 160;
        if (l == 0 || !ovl) {
            if (PH_ON) { PH_FRAME; phase_wconv(F, args, l, wt, wt, ovl ? 1 : 3);
                if (l == 0) phase_norm_in(F, args.in[z_ + 0], args.in[z_ + 1], args.in[z_ + 2], XN, X); }
            PH_END;
        }
#pragma nounroll
        for (int f = 0; f < 2; ++f) {
            if (!(l == 0 && f == 0)) {
                if (PH_ON) { PH_FRAME; phase_norm(F, X, args.in[z_ + (f ? 25 : 2)] + (size_t)l * D, XN); }
                PH_END;
            }
#pragma nounroll
            for (int ck = 0; ck < FFN_NCK; ++ck) {
                const int r0 = ck * FFN_MC, mc = (T - r0 < FFN_MC) ? (T - r0) : FFN_MC;
                PH_REP(0) { if (PH_ON) { PH_FRAME;
                    SchedPlain S{(const char*)(XN + (size_t)r0 * D), (const char*)(f ? WTH + WO_UP2 : wt + WO_UP1), D, D, D, mc / 256, 44, F.G, c, 8};
                    EpiSwiglu E{(bf16*)(ar + AR_H)};
                    pg8::gemm_phase<EpiSwiglu, SchedPlain>(ring, S, E, F.tid);
                } PH_REPBAR(0); }
                PH_END;
                if (PH_ON) { PH_FRAME;
                    SchedPlain S{(const char*)(ar + AR_H), (const char*)(f ? WTH + WO_DN2 : wt + WO_DN1), FF, FF, FF, mc / 256, 8, F.G, c, MK_WGM_DN};
                    { const bool lastf = (l == DEPTH - 1 && f == 1);
                        EpiResid E{(lastf ? (bf16*)(ar + AR_XF) : X) + (size_t)r0 * D, X + (size_t)r0 * D, 0.5f};
                    pg8::gemm_phase<EpiResid, SchedPlain>(ring, S, E, F.tid); }
                }
                PH_END;
            }
            if (f == 0) {
                if (PH_ON) { PH_FRAME; phase_norm(F, X, args.in[z_ + 6] + (size_t)l * D, XN); }
                PH_END;
#if (MK_MIXER & 1)
                PH_REP(1) { if (PH_ON) { PH_FRAME;
                    SchedCF S{SchedPlain{(const char*)XN, (const char*)(WTH + WO_CF), D, D, D, 160, 8, F.G, c, 8}, (char*)(ar + AR_CF)};
                    EpiStore<1> E{nullptr, nullptr, nullptr};
                    pg8::gemm_phase<EpiStore<1>, SchedCF>(ring, S, E, F.tid);
                } PH_REPBAR(1); }
                PH_END;
                if (PH_ON) { PH_FRAME; phase_rwkv_pre(F, args, l); }
                PH_END;
                if (PH_ON) { PH_FRAME;
                    SchedLR S{SchedPlain{(const char*)(ar + AR_LR), (const char*)(WTH + WO_LR), 384, 384, 384, 160, 10, F.G, c, 8}, (char*)(ar + AR_EA), (char*)(ar + AR_GT)};
                    EpiStore<0x70> E{args.in[z_ + 11] + (size_t)l * 1024, args.in[z_ + 13] + (size_t)l * 1024, nullptr};
                    pg8::gemm_phase<EpiStore<0x70>, SchedLR>(ring, S, E, F.tid);
                }
                PH_END;
#if MK_CHUNKED && MK_FUSED_RWKV
                if (PH_ON) { PH_FRAME; phase_rwkv_fused(F, args, l);
                    if (F.bid >= 160) {
                        Frame F2 = F; F2.bid = F.bid - 160; F2.G = F.G - 160; F2.gw = F2.bid * NWAVES + F.wave; F2.NGW = F2.G * NWAVES;
                        phase_wconv(F2, args, l, wt, wt, 2);
                        if (l + 1 < DEPTH) phase_wconv(F2, args, l + 1, wt, wt, 1); } }
                PH_END;
#elif MK_CHUNKED
#pragma nounroll
                for (int seg = 0; seg < RW_NSEG; ++seg) {
                    if (PH_ON) { PH_FRAME; phase_rwkv_prep(F, args, l, seg); }
                    PH_END;
                    if (PH_ON) { PH_FRAME; phase_rwkv_cscan(F, seg); }
                    PH_END;
                }
#else
                if (PH_ON) { PH_FRAME; phase_rwkv_scan(F, args, l); }
                PH_END;
#endif
                if (PH_ON) { PH_FRAME; phase_rwkv_post(F, args, l); }
                PH_END;
#else
                if (PH_ON) { PH_FRAME; phase_zero(F, ar + AR_YC, (size_t)T * 512 * 2); }
                PH_END;
#endif
#if (MK_MIXER & 2)
                PH_REP(2) { if (PH_ON) { PH_FRAME;
                    SchedAtt S{(const char*)XN, (const char*)WTH, (char*)ar, F.G, c};
                    EpiStore<0x387> E{nullptr, nullptr, args.in[z_ + 8] + (size_t)l * 8};
                    pg8::gemm_phase<EpiStore<0x387>, SchedAtt>(ring, S, E, F.tid);
                } PH_REPBAR(2); }
                PH_END;
                if (PH_ON) { PH_FRAME; phase_attn(F, args); }
                PH_END;
#if !(MK_MIXER & 4)
                if (PH_ON) { PH_FRAME; phase_attn_post(F, args); }
                PH_END;
#endif
#else
                if (PH_ON) { PH_FRAME; phase_zero(F, ar + AR_YA, (size_t)T * 512 * 2); }
                PH_END;
#endif
#if (MK_MIXER & 4)
                PH_REP(3) { if (PH_ON) { PH_FRAME;
#if (MK_MIXER & 2)
                    if (rep_ == 0) phase_attn_post(F, args);
                    __syncthreads();
#endif
                    SchedRet S{(const char*)XN, (const char*)(WTH + WO_RET), (char*)ar, F.G, c};
                    EpiStore<1> E{nullptr, nullptr, nullptr};
                    pg8::gemm_phase<EpiStore<1>, SchedRet>(ring, S, E, F.tid);
                } PH_REPBAR(3); }
                PH_END;
                if (PH_ON) { PH_FRAME; phase_ret_state(F, args, l); }
                PH_END;
                if (PH_ON) { PH_FRAME; phase_ret_out(F, args, l); }
                PH_END;
#else
                if (PH_ON) { PH_FRAME; phase_zero(F, ar + AR_YB, (size_t)T * 1024 * 2); }
                PH_END;
#endif
                PH_REP(4) { if (PH_ON) { PH_FRAME;
                    SchedMerge S{(const char*)XN, (const char*)ar, (const char*)WTH, F.G, c};
                    v4u* scr = (v4u*)(ar + AR_SCR) + (size_t)F.bid * 2 * 16 * NTHR;
                    EpiMerge E{scr, scr + 16 * NTHR, (bf16*)(ar + AR_MG)};
                    pg8::gemm_phase<EpiMerge, SchedMerge>(ring, S, E, F.tid);
                } PH_REPBAR(4); }
                PH_END;
                if (PH_ON) { PH_FRAME;
                    SchedPlain S{(const char*)(ar + AR_MG), (const char*)(WTH + WO_OUT), D, D, D, 160, 8, F.G, c, 8};
                    { EpiResid E{X, X, 1.0f};
                    pg8::gemm_phase<EpiResid, SchedPlain>(ring, S, E, F.tid); }
                }
                PH_END;
            }
        }
    }
    if (PH_ON) { PH_FRAME; phase_final_norm(F, (const bf16*)(ar + AR_XF), args.in[z_ + 29], (float*)(GAS float*)ld_karg64(240)); }
    ++pc;
#undef PH_ON
#undef PH_END
#undef PH_FRAME
}

extern "C" void kernel_launch(void* const* d_in, const int* in_sizes, int n_in, void* d_out, int out_size, void* d_ws, size_t ws_size, hipStream_t stream) {
    static int grid = 0;
    if (grid == 0) {
        if (n_in != 30 || out_size != T * D || ws_size < WS_END) { fprintf(stderr, "kernel_launch: unexpected shapes (n_in %d, out %d, ws %zu < %zu); nothing launched\n", n_in, out_size, ws_size, (size_t)WS_END); grid = -1; return; }
        int dev = 0, cus = 0, per_cu = 0;
        if (hipGetDevice(&dev) != hipSuccess || hipDeviceGetAttribute(&cus, hipDeviceAttributeMultiprocessorCount, dev) != hipSuccess) { grid = -1; return; }
        if (hipFuncSetAttribute((const void*)mk_fwd, hipFuncAttributeMaxDynamicSharedMemorySize, LDS_BYTES) != hipSuccess) { fprintf(stderr, "kernel_launch: hipFuncSetAttribute failed\n"); grid = -1; return; }
        if (hipOccupancyMaxActiveBlocksPerMultiprocessor(&per_cu, (const void*)mk_fwd, NTHR, LDS_BYTES) != hipSuccess || per_cu < 1) { fprintf(stderr, "kernel_launch: occupancy query reports %d\n", per_cu); }
        (void)hipGetLastError();
        grid = cus;
#ifdef MK_GRID
        grid = MK_GRID;
#endif
    }
    if (grid < 0) return;
    hipMemsetAsync((char*)d_ws + WS_CTL, 0, CTL_ZERO_BYTES, stream);
    Args a{};
    for (int i = 0; i < 30; ++i) a.in[i] = (const float*)d_in[i];
    a.out = (float*)d_out; a.ws = (unsigned char*)d_ws;
#if MK_PER_PHASE_LAUNCH
#ifndef MK_NPH
#define MK_NPH 2
#endif
    for (int p = 0; p < MK_NPH; ++p) {    a.ph_lo = p; a.ph_hi = p + 1; hipLaunchKernelGGL(mk_fwd, dim3(grid), dim3(NTHR), LDS_BYTES, stream, a); }
#else
#ifdef MK_NPH1
    a.ph_lo = 0; a.ph_hi = MK_NPH1;
#else
    a.ph_lo = 0; a.ph_hi = 1 << 30;
#endif
    hipLaunchKernelGGL(mk_fwd, dim3(grid), dim3(NTHR), LDS_BYTES, stream, a);
#endif
}
```

```cpp
#include <hip/hip_runtime.h>
#include <cstdio>
#include <cstdint>

#ifndef MK_PER_PHASE_LAUNCH
#define MK_PER_PHASE_LAUNCH 0
#endif
#ifndef MK_REP_SCAN
#define MK_REP_SCAN 1
#endif
#ifndef MK_REP_ATT
#define MK_REP_ATT 1
#endif
#ifndef MK_REP_RET
#define MK_REP_RET 1
#endif
#ifndef MK_REP_EW
#define MK_REP_EW 1
#endif
#ifndef MK_REP_UP
#define MK_REP_UP 1
#endif
#ifndef MK_PROBE_RESID
#define MK_PROBE_RESID 0
#endif
#ifndef MK_REP_PROJ
#define MK_REP_PROJ 1
#endif
#ifndef MK_REP_MG
#define MK_REP_MG 1
#endif
#ifndef MK_REP_DN
#define MK_REP_DN 1
#endif
#ifndef MK_REP_OUT
#define MK_REP_OUT 1
#endif
#ifndef MK_REPMASK
#define MK_REPMASK 0
#endif
#ifndef MK_FUSED_RWKV
#define MK_FUSED_RWKV 1
#endif
#ifndef MK_WGM_DN
#define MK_WGM_DN 4
#endif
#ifndef MK_CHUNKED
#define MK_CHUNKED 1
#endif
#ifndef MK_MIXER
#define MK_MIXER 7
#endif

constexpr int T = 40960, D = 2048, FF = 5632, SEQ = 4096, NSEQ = 10, DEPTH = 2;
constexpr int NWAVES = 8, NTHR = 512;

#define GAS __attribute__((address_space(1)))
#define LAS __attribute__((address_space(3)))
typedef unsigned short bf16;
typedef unsigned v4u __attribute__((ext_vector_type(4)));
typedef unsigned v2u __attribute__((ext_vector_type(2)));
typedef float f32x4 __attribute__((ext_vector_type(4)));
typedef float f32x2 __attribute__((ext_vector_type(2)));
typedef float f32x16 __attribute__((ext_vector_type(16)));
typedef short bf16x8 __attribute__((ext_vector_type(8)));
typedef _Float16 h2 __attribute__((ext_vector_type(2)));
typedef GAS unsigned gu32;
#define RLX_AGENT __ATOMIC_RELAXED, __HIP_MEMORY_SCOPE_AGENT
#define LDS_WAIT() asm volatile("s_waitcnt lgkmcnt(0)" ::: "memory")
#define VM_WAIT() asm volatile("s_waitcnt vmcnt(0)" ::: "memory")
typedef __bf16 bf16v2_t __attribute__((ext_vector_type(2)));
__device__ __forceinline__ unsigned cvt_pk_bf16(float lo, float hi) { f32x2 v = {lo, hi}; bf16v2_t r = __builtin_convertvector(v, bf16v2_t); return __builtin_bit_cast(unsigned, r); }
__device__ __forceinline__ unsigned f2bf(float f) { return cvt_pk_bf16(f, f) & 0xffffu; }
__device__ __forceinline__ unsigned pk2(float lo, float hi) { return cvt_pk_bf16(lo, hi); }
__device__ __forceinline__ unsigned pkh2(float lo, float hi) { h2 v; v.x = (_Float16)lo; v.y = (_Float16)hi; return __builtin_bit_cast(unsigned, v); }
__device__ __forceinline__ float bf_lo(unsigned w) { return __builtin_bit_cast(float, w << 16); }
__device__ __forceinline__ float bf_hi(unsigned w) { return __builtin_bit_cast(float, w & 0xffff0000u); }
__device__ __forceinline__ float h_lo(unsigned w) { h2 v = __builtin_bit_cast(h2, w); return (float)v.x; }
__device__ __forceinline__ float h_hi(unsigned w) { h2 v = __builtin_bit_cast(h2, w); return (float)v.y; }
__device__ __forceinline__ float h1(unsigned short w) { return (float)__builtin_bit_cast(_Float16, w); }
__device__ __forceinline__ float fexp(float x) { return __builtin_amdgcn_exp2f(x * 1.44269504089f); }
__device__ __forceinline__ float fsigmoid(float x) { return __builtin_amdgcn_rcpf(1.0f + fexp(-x)); }
__device__ __forceinline__ unsigned long long opaque_u64(unsigned long long p) {
    const unsigned lo = __builtin_amdgcn_readfirstlane((unsigned)p), hi = __builtin_amdgcn_readfirstlane((unsigned)(p >> 32)); unsigned lo2, hi2;
    asm volatile("s_mov_b32 %0, %2\n\ts_mov_b32 %1, %3" : "=&s"(lo2), "=&s"(hi2) : "s"(lo), "s"(hi));
    return ((unsigned long long)hi2 << 32) | lo2;
}
__device__ __forceinline__ int lane_id() { int l; asm volatile("v_mbcnt_lo_u32_b32 %0, -1, 0\n\tv_mbcnt_hi_u32_b32 %0, -1, %0" : "=v"(l)); return l; }
__device__ __forceinline__ float shfl_xor_(float v, int m) { return __builtin_bit_cast(float, __builtin_amdgcn_ds_bpermute((lane_id() ^ m) << 2, __builtin_bit_cast(int, v))); }
__device__ __forceinline__ unsigned long long ld_karg64(int off) {
    unsigned long long r;
    asm volatile("s_load_dwordx2 %0, %1, %2\n\ts_waitcnt lgkmcnt(0)" : "=s"(r) : "s"(__builtin_amdgcn_kernarg_segment_ptr()), "n"(off) : "memory");
    return r;
}
__device__ __forceinline__ float wave_sum(float v) {
#pragma unroll
    for (int o = 1; o < 64; o <<= 1) v += shfl_xor_(v, o);
    return v;
}

#define XB_TMO      128
#define XB_XCNT(j)  (256  + 64 * (j))
#define XB_XSUB(j)  (1280 + 64 * (j))
#define XB_XGEN(j)  (2304 + 64 * (j))
#define XB_TOP      3328
#define XB_TOPGEN   3392
#define XCD_BAR_WORDS 3456
#define XB_SPIN_CAP (1u << 22)

__device__ __forceinline__ unsigned xb_ld(unsigned* p)              { return __hip_atomic_load(p, __ATOMIC_RELAXED, __HIP_MEMORY_SCOPE_AGENT); }
__device__ __forceinline__ unsigned xb_add(unsigned* p, unsigned v) { return __hip_atomic_fetch_add(p, v, __ATOMIC_RELAXED, __HIP_MEMORY_SCOPE_AGENT); }
__device__ __forceinline__ unsigned xb_xcc_id() { return (unsigned)__builtin_amdgcn_s_getreg((3 << 11) | 20) & 0xFu; }
#define XB_SPIN(cond, bar) do { unsigned _sp = 0; while (cond) { __builtin_amdgcn_s_sleep(1); \
    if ((++_sp & 255u) == 0u) { if (xb_ld(&(bar)[XB_TMO])) break; if (_sp > XB_SPIN_CAP) { atomicAdd(&(bar)[XB_TMO], 1u); break; } } } } while (0)

struct XcdBarrier { unsigned* bar; unsigned x; volatile LAS unsigned* st; };
__device__ __forceinline__ XcdBarrier xcd_barrier_post(unsigned* bar, volatile LAS unsigned* st) {
    XcdBarrier b; b.bar = bar; b.x = xb_xcc_id(); b.st = st;
    if (threadIdx.x == 0) (void)xb_add(&bar[XB_XCNT(b.x)], 1u);
    return b;
}
__device__ __forceinline__ void xcd_barrier_complete(unsigned* bar, unsigned x, unsigned& nloc, unsigned& nx) {
    const unsigned G = gridDim.x * gridDim.y * gridDim.z;
    unsigned sum, cnt, mine, sp = 0u;
    for (;;) {
        sum = 0u; cnt = 0u; mine = 0u;
#pragma unroll
        for (unsigned j = 0; j < 16; ++j) { const unsigned c = xb_ld(&bar[XB_XCNT(j)]); sum += c; cnt += (c > 0u) ? 1u : 0u; mine = (j == x) ? c : mine; }
        if (sum == G) break;
        __builtin_amdgcn_s_sleep(1);
        if ((++sp & 255u) == 0u) { if (xb_ld(&bar[XB_TMO])) break; if (sp > XB_SPIN_CAP) { atomicAdd(&bar[XB_TMO], 1u); break; } }
    }
    nloc = mine > 0u ? mine : 1u; nx = cnt > 0u ? cnt : 1u;
}
__device__ __forceinline__ void xcd_barrier(const XcdBarrier& b, bool thread0) {
    asm volatile("s_waitcnt vmcnt(0)" ::: "memory");
    __syncthreads();
    if (thread0) {
        unsigned* bar = (unsigned*)opaque_u64((unsigned long long)b.bar); const unsigned bx = xb_xcc_id();
        __builtin_amdgcn_s_waitcnt(0);
        unsigned nloc = b.st[0], nx = b.st[1];
        if (nloc == 0u) { xcd_barrier_complete(bar, bx, nloc, nx); b.st[0] = nloc; b.st[1] = nx; }
        const unsigned old = xb_add(&bar[XB_XSUB(bx)], 1u);
        const unsigned gen = old / nloc;
        if (old + 1u == (gen + 1u) * nloc) {
            __builtin_amdgcn_fence(__ATOMIC_RELEASE, "agent");
            asm volatile("s_waitcnt vmcnt(0)" ::: "memory");
            const unsigned og = xb_add(&bar[XB_TOP], 1u);
            const unsigned tg = og / nx;
            if (og + 1u == (tg + 1u) * nx) xb_add(&bar[XB_TOPGEN], 1u);
            else XB_SPIN(xb_ld(&bar[XB_TOPGEN]) == tg, bar);
            __builtin_amdgcn_fence(__ATOMIC_ACQUIRE, "agent");
            xb_add(&bar[XB_XGEN(bx)], 1u);
            asm volatile("s_waitcnt vmcnt(0)" ::: "memory");
        } else {
            XB_SPIN(xb_ld(&bar[XB_XGEN(bx)]) == gen, bar);
            __builtin_amdgcn_fence(__ATOMIC_ACQUIRE, "agent");
            asm volatile("s_waitcnt vmcnt(0)" ::: "memory");
        }
    }
    __syncthreads();
}

namespace pg8 {
#define PG8_LAS __attribute__((address_space(3)))
constexpr int BM = 256, BK = 64, HALF = 128, HTB = HALF * BK * 2, STAGE_BYTES = 8 * HTB;
__host__ __device__ __forceinline__ int lds_byte(int r, int c) { const int st = (r >> 4) * 2 + (c >> 5), rr = r & 15, cc = c & 31, ob = rr * 64 + cc * 2; return st * 1024 + (ob ^ (((ob >> 9) & 1) << 5)); }
__host__ __device__ __forceinline__ void stage_rc(int b, int& R, int& C) { const int st = b / 1024, sb = b % 1024, swz = sb ^ (((sb >> 9) & 1) << 5); R = (st >> 1) * 16 + swz / 64; C = (st & 1) * 32 + (swz % 64) / 2; }
__host__ __device__ __forceinline__ int perm32(int rho) { const int n = rho >> 4, i = rho & 15; return 8 * (i >> 2) + 4 * n + (i & 3); }

struct UnitG { const char* A; const char* B; int lda, ldb, K; char* O; int ldo, kind, x0, x1; };

__device__ __forceinline__ void tile_map(int L, int nM, int nN, int& pm, int& pn, int wgm = 8) {
    const int nwg = nM * nN; int wgid = L;
    { const int q = nwg / 8, r = nwg % 8, xcd = wgid % 8, off = wgid / 8; wgid = (xcd < r ? xcd * (q + 1) : r * (q + 1) + (xcd - r) * q) + off; }
    const int nig = wgm * nN, gid = wgid / nig, fm = gid * wgm, gsz = (nM - fm) < wgm ? (nM - fm) : wgm;
    pm = fm + ((wgid % nig) % gsz); pn = (wgid % nig) / gsz;
}

template <class Epi, class Sched>
__device__ __forceinline__ void gemm_phase(PG8_LAS unsigned char* lds, const Sched& S, const Epi& E, int tid_in) {
    int tid_ = tid_in; asm volatile("" : "+v"(tid_));
    const int tid = tid_, wid = __builtin_amdgcn_readfirstlane(tid >> 6), lane = tid & 63, wr = wid >> 2, wc = wid & 3, fr = lane & 15, fq = lane >> 4;
    int sR, sC; stage_rc(tid * 16, sR, sC);
    const int sRb = Epi::PERM ? ((sR & ~31) + perm32(sR & 31)) : sR;
    const size_t kstep = (size_t)(BK * 2);
    const unsigned ldsw = (unsigned)wid * 1024u;
    const int aoff = lds_byte(wr * 64 + fr, fq * 8), boff = lds_byte(wc * 32 + fr, fq * 8);
#define PG8_SA(b, h) (((b) * 2 + (h)) * HTB)
#define PG8_SB(b, h) ((4 + (b) * 2 + (h)) * HTB)
#define PG8_STAGE(bufoff, gbase, voff, q64) do { _Pragma("unroll") for (int _i = 0; _i < 2; ++_i) \
        __builtin_amdgcn_global_load_lds((const unsigned*)((const char*)(gbase) + (size_t)_i * (q64) + (voff)), (PG8_LAS unsigned*)(lds + (bufoff) + ldsw + _i * 8192), 16, 0, 0); } while (0)
#define PG8_LDA(dst, b, h) do { _Pragma("unroll") for (int m = 0; m < 4; ++m) _Pragma("unroll") for (int k = 0; k < 2; ++k) dst[m][k] = *(const PG8_LAS bf16x8*)(lds + PG8_SA(b, h) + aoff + m * 2048 + k * 1024); } while (0)
#define PG8_LDB(dst, b, h) do { _Pragma("unroll") for (int n = 0; n < 2; ++n) _Pragma("unroll") for (int k = 0; k < 2; ++k) dst[n][k] = *(const PG8_LAS bf16x8*)(lds + PG8_SB(b, h) + boff + n * 2048 + k * 1024); } while (0)
#define PG8_MMA(ai, bj, At, Bt) do { __builtin_amdgcn_s_setprio(1); _Pragma("unroll") for (int m = 0; m < 4; ++m) _Pragma("unroll") for (int n = 0; n < 2; ++n) _Pragma("unroll") for (int k = 0; k < 2; ++k) \
        acc[ai][bj][m][n] = __builtin_amdgcn_mfma_f32_16x16x32_bf16(Bt[n][k], At[m][k], acc[ai][bj][m][n], 0, 0, 0); __builtin_amdgcn_s_setprio(0); } while (0)
#define PG8_WAIT_V(n) asm volatile("s_waitcnt vmcnt(" #n ")" ::: "memory")
#define PG8_WAIT_L(n) asm volatile("s_waitcnt lgkmcnt(" #n ")" ::: "memory")
#define PG8_WAIT_VP() asm volatile("s_waitcnt vmcnt(%0)" :: "n"(8 + Epi::NST) : "memory")
#define PG8_BAR __builtin_amdgcn_s_barrier()
#define PG8_SCHED __builtin_amdgcn_sched_barrier(0)
    UnitG cur, nxt; int ui = 0;
    if (!S.next(0, cur)) return;
    f32x4 acc[2][2][4][2];
#pragma unroll
    for (int a = 0; a < 2; ++a)
#pragma unroll
        for (int b = 0; b < 2; ++b)
#pragma unroll
            for (int m = 0; m < 4; ++m)
#pragma unroll
                for (int n = 0; n < 2; ++n) acc[a][b][m][n] = (f32x4){0.f, 0.f, 0.f, 0.f};
    bf16x8 At[4][2], B0[2][2], B1[2][2];
    const char* cA = cur.A; const char* cB = cur.B;
    unsigned vA = (unsigned)(sR * cur.lda + sC) * 2u, vB = (unsigned)(sRb * cur.ldb + sC) * 2u;
    unsigned qA = (unsigned)cur.lda * 128u, qB = (unsigned)cur.ldb * 128u;
#define hA (2u * qA)
#define hB (2u * qB)
    PG8_STAGE(PG8_SB(0, 0), cB, vB, qB); PG8_STAGE(PG8_SB(0, 1), cB + hB, vB, qB); PG8_STAGE(PG8_SA(0, 0), cA, vA, qA); PG8_STAGE(PG8_SA(0, 1), cA + hA, vA, qA);
    if (wr == 1) PG8_BAR;
    PG8_WAIT_V(2); PG8_BAR;
    PG8_STAGE(PG8_SB(1, 0), cB + kstep, vB, qB); PG8_STAGE(PG8_SA(1, 0), cA + kstep, vA, qA); PG8_STAGE(PG8_SB(1, 1), cB + hB + kstep, vB, qB);
    PG8_WAIT_V(0); PG8_BAR;
    for (;;) {
        const bool has_next = S.next(ui + 1, nxt);
        const char* nA = has_next ? nxt.A : cA; const char* nB = has_next ? nxt.B : cB;
        const int nlda = has_next ? nxt.lda : cur.lda, nldb = has_next ? nxt.ldb : cur.ldb;
        unsigned nvA, nvB; { int r2, c2; stage_rc((wid * 64 + lane_id()) * 16, r2, c2); const int rb2 = Epi::PERM ? ((r2 & ~31) + perm32(r2 & 31)) : r2;
            nvA = (unsigned)(r2 * nlda + c2) * 2u; nvB = (unsigned)(rb2 * nldb + c2) * 2u; }
        const unsigned nqA = (unsigned)nlda * 128u, nqB = (unsigned)nldb * 128u;
        const int nt = cur.K / BK;
#define PG8_KITER(WV) do { \
            const bool last = (t == nt - 2); \
            const char* a1 = cA + (size_t)(t + 1) * kstep; \
            const char* a2 = last ? nA : cA + (size_t)(t + 2) * kstep; const char* b2 = last ? nB : cB + (size_t)(t + 2) * kstep; \
            const char* a3 = a2 + kstep; const char* b3 = b2 + kstep; \
            const unsigned va2 = last ? nvA : vA, vb2 = last ? nvB : vB; \
            const unsigned qa2 = last ? nqA : qA, qb2 = last ? nqB : qB, ha2 = 2u * qa2, hb2 = 2u * qb2; \
              \
            PG8_LDB(B0, 0, 0); PG8_LDB(B1, 0, 1); PG8_SCHED; PG8_LDA(At, 0, 0); PG8_STAGE(PG8_SA(1, 1), a1 + hA, vA, qA); \
            WV; PG8_WAIT_L(0); PG8_BAR; PG8_MMA(0, 0, At, B0); PG8_MMA(0, 1, At, B1); PG8_BAR; PG8_SCHED; \
              \
            PG8_LDA(At, 0, 1); PG8_STAGE(PG8_SB(0, 0), b2, vb2, qb2); PG8_STAGE(PG8_SB(0, 1), b2 + hb2, vb2, qb2); PG8_STAGE(PG8_SA(0, 0), a2, va2, qa2); \
            WV; PG8_WAIT_L(0); PG8_BAR; PG8_MMA(1, 0, At, B0); PG8_MMA(1, 1, At, B1); PG8_BAR; PG8_SCHED; \
              \
            PG8_LDB(B0, 1, 0); PG8_LDB(B1, 1, 1); PG8_SCHED; PG8_LDA(At, 1, 0); PG8_STAGE(PG8_SA(0, 1), a2 + ha2, va2, qa2); \
            PG8_WAIT_V(8); PG8_WAIT_L(0); PG8_BAR; PG8_MMA(0, 0, At, B0); PG8_MMA(0, 1, At, B1); PG8_BAR; PG8_SCHED; \
              \
            PG8_LDA(At, 1, 1); PG8_STAGE(PG8_SB(1, 0), b3, vb2, qb2); PG8_STAGE(PG8_SB(1, 1), b3 + hb2, vb2, qb2); PG8_STAGE(PG8_SA(1, 0), a3, va2, qa2); \
            PG8_WAIT_V(8); PG8_WAIT_L(0); PG8_BAR; PG8_MMA(1, 0, At, B0); PG8_MMA(1, 1, At, B1); PG8_BAR; PG8_SCHED; } while (0)
        { const int t = 0; PG8_KITER(PG8_WAIT_VP()); }
        for (int t = 2; t < nt; t += 2) PG8_KITER(PG8_WAIT_V(8));
#undef PG8_KITER
        if (wr == 0) PG8_BAR;
        { const int l2 = lane_id(); int fr2 = l2 & 15, fq2 = l2 >> 4; asm volatile("" : "+v"(fr2), "+v"(fq2)); E(acc, cur, wr, wc, fr2, fq2); }
        if (!has_next) break;
#pragma unroll
        for (int a = 0; a < 2; ++a)
#pragma unroll
            for (int b = 0; b < 2; ++b)
#pragma unroll
                for (int m = 0; m < 4; ++m)
#pragma unroll
                    for (int n = 0; n < 2; ++n) acc[a][b][m][n] = (f32x4){0.f, 0.f, 0.f, 0.f};
        cA = nA; cB = nB; vA = nvA; vB = nvB; qA = nqA; qB = nqB; ++ui;
        { int u2 = __builtin_amdgcn_readfirstlane(ui); asm volatile("" : "+s"(u2)); (void)S.next(u2, cur); }
        if (wr == 1) PG8_BAR;
    }
    PG8_WAIT_V(0);
    PG8_BAR;
#undef hA
#undef hB
#undef PG8_SA
#undef PG8_SB
#undef PG8_STAGE
#undef PG8_LDA
#undef PG8_LDB
#undef PG8_MMA
#undef PG8_WAIT_V
#undef PG8_WAIT_VP
#undef PG8_WAIT_L
#undef PG8_BAR
#undef PG8_SCHED
}
}
using pg8::UnitG;

constexpr size_t MiB = 1u << 20;
constexpr size_t WS_CTL = 0, CTL_ZERO_BYTES = 1 * MiB;
constexpr size_t WS_WT = 2 * MiB;
constexpr size_t WO_UP1 = 0, WO_DN1 = 44 * MiB, WO_UP2 = 66 * MiB, WO_DN2 = 110 * MiB, WO_ATT = 132 * MiB, WO_RET = 150 * MiB, WO_CF = 162 * MiB,
                 WO_GATE = 170 * MiB, WO_BA = 194 * MiB, WO_BB = 196 * MiB, WO_BC = 200 * MiB, WO_OUT = 202 * MiB, WO_LR = 210 * MiB, WT_BYTES = 212 * MiB;
constexpr size_t WS_XN = WS_WT + WT_BYTES;
constexpr size_t WS_AR = WS_XN + 160 * MiB;
constexpr size_t AR_YC = 0, AR_YA = 40 * MiB, AR_YB = 80 * MiB;
constexpr int FFN_MC = 40960, FFN_NCK = (T + FFN_MC - 1) / FFN_MC;
constexpr size_t AR_H = 0;
constexpr size_t AR_CF = 160 * MiB, AR_RKVK = 320 * MiB, AR_LR = 480 * MiB, AR_EA = 512 * MiB, AR_GT = 672 * MiB, AR_YS = 160 * MiB, AR_PB = 160 * MiB, AR_YSB = 40 * MiB, AR_STS = 120 * MiB;
static_assert((size_t)160 * 64 * 12800 <= 160 * MiB, "PB");
constexpr size_t AR_QA = 160 * MiB, AR_KA = 280 * MiB, AR_VTA = 400 * MiB, AR_OA = 40 * MiB, AR_LSE = 680 * MiB;
constexpr size_t AR_RQ = 520 * MiB, AR_RK = 560 * MiB, AR_RKT = 600 * MiB, AR_RVT = 160 * MiB, AR_RG = 240 * MiB, AR_SB = 320 * MiB;
constexpr size_t AR_SCR = 160 * MiB, AR_MG = 288 * MiB;
constexpr size_t XB_OFF = 160 * MiB;
constexpr size_t AR_XF = 480 * MiB;
constexpr size_t WS_END = WS_AR + 712 * MiB;
constexpr int CW_BAR = 4096;

constexpr int RING_OFF = 0, RING_BYTES = 131072;
constexpr int LDSCTL_OFF = RING_BYTES, MISC_OFF = LDSCTL_OFF + 320;
constexpr int LDS_BYTES = 147456;

struct Args { const float* in[30]; float* out; unsigned char* ws; int ph_lo, ph_hi; };
static_assert(__builtin_offsetof(Args, out) == 240 && __builtin_offsetof(Args, ws) == 248, "ld_karg64 offsets");

struct Frame { LAS unsigned char* lds; unsigned char* ws; int tid, lane, wave, G, gw, NGW, bid, z; };

__device__ __forceinline__ void transpose_item(const float* W, int ldw, int k0, int n0, bf16* WT, int Kdst, int dst_row0, LAS float* scr, int lane) {
    float tv[32];
#pragma unroll
    for (int i = 0; i < 32; ++i) { const int kk = 2 * i + (lane >> 5); tv[i] = W[(size_t)(k0 + kk) * ldw + n0 + (lane & 31)]; }
#pragma unroll
    for (int i = 0; i < 32; ++i) { const int kk = 2 * i + (lane >> 5); scr[kk * 33 + (lane & 31)] = tv[i]; }
    LDS_WAIT(); asm volatile("" ::: "memory");
    const int c = lane & 7;
#pragma unroll
    for (int j = 0; j < 4; ++j) { const int n = (lane >> 3) + 8 * j; const LAS float* s = scr + (8 * c) * 33 + n;
        v4u o; o.x = pk2(s[0 * 33], s[1 * 33]); o.y = pk2(s[2 * 33], s[3 * 33]); o.z = pk2(s[4 * 33], s[5 * 33]); o.w = pk2(s[6 * 33], s[7 * 33]);
        *(v4u*)(WT + (size_t)(dst_row0 + n) * Kdst + k0 + 8 * c) = o; }
    LDS_WAIT(); asm volatile("" ::: "memory");
}

__device__ __forceinline__ void phase_wconv(const Frame& F, const Args& a, int l, unsigned char* wt, unsigned char* wth, int part) {
    LAS float* scr = (LAS float*)(F.lds + RING_OFF + F.wave * 16384);
    constexpr int I_FF = 5632, I_A = 6 * I_FF, I_IN = 32 * 492, I_BA = 512, I_BB = 1024, I_BC = 512, I_OUT = 2048;
    constexpr int NITEMS = I_A + I_IN + I_BA + I_BB + I_BC + I_OUT;
    for (int it = F.gw; it < NITEMS; it += F.NGW) {
        int r = it;
        if (r < I_A) {
            const int m = r / I_FF, q = r % I_FF, f = m / 3, mm = m % 3;
            if (!((f ? 2 : 1) & part)) continue;
            if (mm < 2) {
                const float* W = a.in[F.z + (f ? 26 : 3) + mm] + (size_t)l * D * FF;
                const int kb = q / 176, nb = q % 176, n0 = 32 * nb;
                bf16* dst = (bf16*)(f ? wth + WO_UP2 : wt + WO_UP1);
                transpose_item(W, FF, 64 * kb, n0, dst, D, (n0 / 128) * 256 + mm * 128 + (n0 % 128), scr, F.lane);
            } else {
                const float* W = a.in[F.z + (f ? 28 : 5)] + (size_t)l * FF * D;
                const int kb = q / 64, nb = q % 64, n0 = 32 * nb;
                bf16* dst = (bf16*)(f ? wth + WO_DN2 : wt + WO_DN1);
                transpose_item(W, D, 64 * kb, n0, dst, FF, n0, scr, F.lane);
            }
            continue;
        }
        r -= I_A;
        if (r < I_IN) {
            const float* W = a.in[F.z + 7] + (size_t)l * D * 15744;
            const int kb = r / 492, nb = r % 492, n0 = 32 * nb;
            if (!(((n0 >= 7680 && n0 < 9600) ? 1 : 2) & part)) continue;
            bf16* dst; int row;
            if (n0 < 4608) { dst = (bf16*)(wth + WO_ATT); row = n0; }
            else if (n0 < 7680) { dst = (bf16*)(wth + WO_RET); row = n0 - 4608; }
            else if (n0 < 9600) { dst = (bf16*)(wth + WO_CF); row = n0 - 7680; }
            else { dst = (bf16*)(wth + WO_GATE); row = n0 - 9600; }
            transpose_item(W, 15744, 64 * kb, n0, dst, D, row, scr, F.lane);
            continue;
        }
        r -= I_IN;
        if (!(part & 2)) break;
        if (r < I_BA) { const int kb = r / 64, nb = r % 64; transpose_item(a.in[F.z + 21] + (size_t)l * 512 * D, D, 64 * kb, 32 * nb, (bf16*)(wth + WO_BA), 512, 32 * nb, scr, F.lane); continue; }
        r -= I_BA;
        if (r < I_BB) { const int kb = r / 64, nb = r % 64; transpose_item(a.in[F.z + 22] + (size_t)l * 1024 * D, D, 64 * kb, 32 * nb, (bf16*)(wth + WO_BB), 1024, 32 * nb, scr, F.lane); continue; }
        r -= I_BB;
        if (r < I_BC) { const int kb = r / 64, nb = r % 64; transpose_item(a.in[F.z + 23] + (size_t)l * 512 * D, D, 64 * kb, 32 * nb, (bf16*)(wth + WO_BC), 512, 32 * nb, scr, F.lane); continue; }
        r -= I_BC;
        { const int kb = r / 64, nb = r % 64; transpose_item(a.in[F.z + 24] + (size_t)l * D * D, D, 64 * kb, 32 * nb, (bf16*)(wth + WO_OUT), D, 32 * nb, scr, F.lane); }
    }
    if (!(part & 1)) return;
    const int gt = F.bid * NTHR + F.tid, NGT = F.G * NTHR;
    bf16* lr = (bf16*)(wth + WO_LR);
    const float* w2 = a.in[F.z + 12] + (size_t)l * 2 * 64 * 512; const float* a2 = a.in[F.z + 14] + (size_t)l * 2 * 64 * 512; const float* g2 = a.in[F.z + 15] + (size_t)l * 128 * 512;
    for (int i = gt; i < 2560 * 384; i += NGT) {
        const int n = i / 384, k = i % 384; float v = 0.f;
        if (n < 1024) { const int z = n >> 9, c = n & 511; if (k >= 64 * z && k < 64 * z + 64) v = w2[((size_t)z * 64 + (k - 64 * z)) * 512 + c]; }
        else if (n < 2048) { const int z = (n - 1024) >> 9, c = n & 511; if (k >= 128 + 64 * z && k < 192 + 64 * z) v = a2[((size_t)z * 64 + (k - 128 - 64 * z)) * 512 + c]; }
        else { const int c = n - 2048; if (k >= 256) v = g2[(size_t)(k - 256) * 512 + c]; }
        lr[i] = (bf16)f2bf(v);
    }
    bf16* cfz = (bf16*)(wth + WO_CF) + (size_t)1920 * D;
    for (int i = gt; i < 128 * D; i += NGT) cfz[i] = 0;
}

__device__ __forceinline__ void phase_norm_in(const Frame& F, const float* xp, const float* xs, const float* gain, bf16* xn, bf16* xb) {
    for (int m = F.gw; m < T; m += F.NGW) {
        const float* src_row = m < 8192 ? xp + (size_t)m * D : xs + (size_t)(m - 8192) * D;
        const f32x4* xr = (const f32x4*)src_row + F.lane; const f32x4* gr = (const f32x4*)gain + F.lane;
        f32x4 v[8]; float s = 0.f;
#pragma unroll
        for (int j = 0; j < 8; ++j) { v[j] = xr[64 * j]; s += (v[j].x * v[j].x + v[j].y * v[j].y) + (v[j].z * v[j].z + v[j].w * v[j].w); }
        const float rstd = 1.0f / sqrtf(wave_sum(s) * (1.0f / D) + 1e-6f);
        v2u* o8 = (v2u*)(xn + (size_t)m * D) + F.lane; v2u* b8 = (v2u*)(xb + (size_t)m * D) + F.lane;
#pragma unroll
        for (int j = 0; j < 8; ++j) { const f32x4 g = gr[64 * j]; v2u w; w.x = pk2(v[j].x * rstd * g.x, v[j].y * rstd * g.y); w.y = pk2(v[j].z * rstd * g.z, v[j].w * rstd * g.w); o8[64 * j] = w;
            v2u b; b.x = pk2(v[j].x, v[j].y); b.y = pk2(v[j].z, v[j].w); b8[64 * j] = b; }
    }
}
__device__ __forceinline__ void phase_norm(const Frame& F, const bf16* x, const float* gain, bf16* xn) {
    for (int m = 2 * F.gw; m < T; m += 2 * F.NGW) {
        v4u v[2][4]; float s[2] = {0.f, 0.f};
#pragma unroll
        for (int r = 0; r < 2; ++r) { const v4u* xr = (const v4u*)(x + (size_t)(m + r) * D) + F.lane;
#pragma unroll
            for (int j = 0; j < 4; ++j) v[r][j] = xr[64 * j]; }
#pragma unroll
        for (int r = 0; r < 2; ++r)
#pragma unroll
            for (int j = 0; j < 4; ++j)
#pragma unroll
                for (int q = 0; q < 4; ++q) { const float a = bf_lo(v[r][j][q]), b = bf_hi(v[r][j][q]); s[r] += a * a + b * b; }
        const f32x4* gr = (const f32x4*)gain + 2 * F.lane;
#pragma unroll
        for (int r = 0; r < 2; ++r) {
            const float rstd = 1.0f / sqrtf(wave_sum(s[r]) * (1.0f / D) + 1e-6f);
            v4u* o = (v4u*)(xn + (size_t)(m + r) * D) + F.lane;
#pragma unroll
            for (int j = 0; j < 4; ++j) { const f32x4 g0 = gr[128 * j], g1 = gr[128 * j + 1]; const v4u w = v[r][j]; v4u ow;
                ow.x = pk2(bf_lo(w.x) * rstd * g0.x, bf_hi(w.x) * rstd * g0.y); ow.y = pk2(bf_lo(w.y) * rstd * g0.z, bf_hi(w.y) * rstd * g0.w);
                ow.z = pk2(bf_lo(w.z) * rstd * g1.x, bf_hi(w.z) * rstd * g1.y); ow.w = pk2(bf_lo(w.w) * rstd * g1.z, bf_hi(w.w) * rstd * g1.w);
                o[64 * j] = ow; }
        }
    }
}
__device__ __forceinline__ void phase_final_norm(const Frame& F, const bf16* x, const float* gain, float* out) {
    for (int m = F.gw; m < T; m += F.NGW) {
        const v4u* xr = (const v4u*)(x + (size_t)m * D) + F.lane;
        v4u v[4]; float s = 0.f;
#pragma unroll
        for (int j = 0; j < 4; ++j) v[j] = xr[64 * j];
#pragma unroll
        for (int j = 0; j < 4; ++j)
#pragma unroll
            for (int q = 0; q < 4; ++q) { const float a = bf_lo(v[j][q]), b = bf_hi(v[j][q]); s += a * a + b * b; }
        const float rstd = 1.0f / sqrtf(wave_sum(s) * (1.0f / D) + 1e-6f);
        const f32x4* gr = (const f32x4*)gain + 2 * F.lane; f32x4* o = (f32x4*)(out + (size_t)m * D) + 2 * F.lane;
#pragma unroll
        for (int j = 0; j < 4; ++j) { const f32x4 g0 = gr[128 * j], g1 = gr[128 * j + 1]; const v4u w = v[j];
            f32x4 o0, o1; o0.x = bf_lo(w.x) * rstd * g0.x; o0.y = bf_hi(w.x) * rstd * g0.y; o0.z = bf_lo(w.y) * rstd * g0.z; o0.w = bf_hi(w.y) * rstd * g0.w;
            o1.x = bf_lo(w.z) * rstd * g1.x; o1.y = bf_hi(w.z) * rstd * g1.y; o1.z = bf_lo(w.w) * rstd * g1.z; o1.w = bf_hi(w.w) * rstd * g1.w;
            o[128 * j] = o0; o[128 * j + 1] = o1; }
    }
}

__device__ __forceinline__ int rperm(int r) { return (r & 0x13) | ((r & 4) << 1) | ((r & 8) >> 1); }
struct SchedPlain {
    const char* A; const char* B; int lda, ldb, K, nM, nN, G, c, wgm;
    __device__ __forceinline__ bool next(int i, UnitG& u) const {
        const int L = i * G + c; if (L >= nM * nN) return false;
        int pm, pn; pg8::tile_map(L, nM, nN, pm, pn, wgm);
        u.A = A + (size_t)pm * 256 * lda * 2; u.B = B + (size_t)pn * 256 * ldb * 2; u.lda = lda; u.ldb = ldb; u.K = K; u.O = nullptr; u.ldo = 0; u.kind = 0; u.x0 = pm; u.x1 = pn; return true;
    }
};
struct EpiSwiglu {
    static constexpr bool PERM = true; static constexpr int NST = 8;
    bf16* H;
    __device__ __forceinline__ void operator()(const f32x4 (&acc)[2][2][4][2], const UnitG& u, int wr, int wc, int fr, int fq) const {
        const int row0 = u.x0 * 256 + wr * 64 + fr, col0 = u.x1 * 128 + wc * 32 + 8 * fq;
#pragma unroll
        for (int ai = 0; ai < 2; ++ai)
#pragma unroll
            for (int m = 0; m < 4; ++m) {
                float h[8];
#pragma unroll
                for (int n = 0; n < 2; ++n)
#pragma unroll
                    for (int e = 0; e < 4; ++e) { const float g = acc[ai][0][m][n][e], up = acc[ai][1][m][n][e]; h[4 * n + e] = g * fsigmoid(g) * up; }
                v4u w; w.x = cvt_pk_bf16(h[0], h[1]); w.y = cvt_pk_bf16(h[2], h[3]); w.z = cvt_pk_bf16(h[4], h[5]); w.w = cvt_pk_bf16(h[6], h[7]);
                *(v4u*)(H + (size_t)(row0 + ai * 128 + m * 16) * FF + col0) = w;
            }
    }
};
struct EpiResid {
    static constexpr bool PERM = true; static constexpr int NST = 16;
    bf16* X; const bf16* R; float scale;
    __device__ __forceinline__ void operator()(const f32x4 (&acc)[2][2][4][2], const UnitG& u, int wr, int wc, int fr, int fq) const {
        const int row0 = u.x0 * 256 + wr * 64 + fr, col0 = u.x1 * 256 + wc * 32 + 8 * fq;
        v4u xv[2][4][2];
#pragma unroll
        for (int ai = 0; ai < 2; ++ai)
#pragma unroll
            for (int m = 0; m < 4; ++m) { const bf16* rowp = R + (size_t)(row0 + ai * 128 + m * 16) * D + col0;
#pragma unroll
                for (int bj = 0; bj < 2; ++bj) xv[ai][m][bj] = *(const v4u*)(rowp + bj * 128); }
        asm volatile("" ::: "memory");
#pragma unroll
        for (int ai = 0; ai < 2; ++ai)
#pragma unroll
            for (int m = 0; m < 4; ++m) { bf16* rowp = X + (size_t)(row0 + ai * 128 + m * 16) * D + col0;
#pragma unroll
                for (int bj = 0; bj < 2; ++bj) { const f32x4 a0 = acc[ai][bj][m][0], a1 = acc[ai][bj][m][1]; const v4u r = xv[ai][m][bj]; v4u w;
                    w.x = cvt_pk_bf16(bf_lo(r.x) + a0.x * scale, bf_hi(r.x) + a0.y * scale); w.y = cvt_pk_bf16(bf_lo(r.y) + a0.z * scale, bf_hi(r.y) + a0.w * scale);
                    w.z = cvt_pk_bf16(bf_lo(r.z) + a1.x * scale, bf_hi(r.z) + a1.y * scale); w.w = cvt_pk_bf16(bf_lo(r.w) + a1.z * scale, bf_hi(r.w) + a1.w * scale);
                    *(v4u*)(rowp + bj * 128) = w; } }
        asm volatile("" ::: "memory");
    }
};
template <int KM>
struct EpiStore {
    static constexpr bool PERM = true; static constexpr int NST = 16;
    const float* b0; const float* b1; const float* dlog;
    template <int KIND>
    __device__ __forceinline__ void run(const f32x4 (&acc)[2][2][4][2], const UnitG& u, int wr, int wc, int fr, int fq) const {
        const int row0 = wr * 64 + fr, col0 = wc * 32 + 8 * fq;
        bf16* O = (bf16*)u.O;
        const unsigned lof = (unsigned)((fq >> 1) * 512 + ((fq & 1) * 32 + (KIND == 2 ? rperm(fr) : fr)) * 8);
        float l2g[2] = {0.f, 0.f}, l2h[2] = {0.f, 0.f};
        if (KIND == 2) {
#pragma unroll
            for (int ai = 0; ai < 2; ++ai) { const float lg = ((const GAS float*)dlog)[u.x0 + ai], lh = ((const GAS float*)dlog)[4 + u.x0 + ai];
                l2g[ai] = -__builtin_amdgcn_logf(1.0f + fexp(-lg)); l2h[ai] = -__builtin_amdgcn_logf(1.0f + fexp(-lh)); }
        }
#pragma unroll
        for (int ai = 0; ai < 2; ++ai)
#pragma unroll
            for (int m = 0; m < 4; ++m)
#pragma unroll
                for (int bj = 0; bj < 2; ++bj) {
                    float v[8];
#pragma unroll
                    for (int n = 0; n < 2; ++n)
#pragma unroll
                        for (int e = 0; e < 4; ++e) v[4 * n + e] = acc[ai][bj][m][n][e];
                    bf16* dst;
                    if (KIND == 7 || KIND == 8)
                        dst = O + ((size_t)(((u.x0 + 2 * wr + 4 * ai + (m >> 1)) * 4 + u.x1 + bj) * 8 + 2 * wc) * 512 + (m & 1) * 128) + lof;
                    else if (KIND == 9)
                        dst = O + ((size_t)((((2 * u.x0 + ai) * 4 + 2 * wr + (m >> 1)) * (T / 32) + u.x1 + 4 * bj + wc) * 2) * 512 + (m & 1) * 128) + lof;
                    else if (KIND == 2)
                        dst = O + ((size_t)(((u.x0 + ai) * 4 + 2 * wr + (m >> 1)) * (T / 16) + u.x1 + 8 * bj + 2 * wc) * 512 + (m & 1) * 128) + lof;
                    else if (KIND == 10)
                        dst = O + ((size_t)((u.x0 * 8 + 2 * wr + 4 * ai + (m >> 1)) * (T / 16) + u.x1 + 8 * bj + 2 * wc) * 512 + (m & 1) * 128) + lof;
                    else dst = O + (size_t)(row0 + ai * 128 + m * 16) * u.ldo + col0 + bj * 128;
                    v4u w;
                    if (KIND == 1 || KIND == 7) {
#pragma unroll
                        for (int e = 0; e < 8; ++e) v[e] *= 0.08838834764831845f;
                    } else if (KIND == 2) {
                        float v1[8];
#pragma unroll
                        for (int e = 0; e < 8; ++e) { const int pos = (col0 + e) & 127; const float b = v[e] * 0.08838834764831845f;
                            v1[e] = b * __builtin_amdgcn_exp2f(l2h[ai] * (float)pos); v[e] = b * __builtin_amdgcn_exp2f(l2g[ai] * (float)(127 - pos)); }
                        v4u w1; w1.x = cvt_pk_bf16(v1[0], v1[1]); w1.y = cvt_pk_bf16(v1[2], v1[3]); w1.z = cvt_pk_bf16(v1[4], v1[5]); w1.w = cvt_pk_bf16(v1[6], v1[7]);
                        *(v4u*)(dst + (size_t)16 * (T / 16) * 512) = w1;
                    } else if (KIND == 4) {
                        const int c = u.x1 * 256 + bj * 128 + col0;
#pragma unroll
                        for (int e = 0; e < 8; ++e) { const float xx = -(v[e] + b0[c + e]); const float sp = (xx > 15.f) ? xx : __builtin_amdgcn_logf(1.0f + fexp(xx)) * 0.69314718056f; v[e] = fexp(-sp - 0.5f); }
                    } else if (KIND == 5) {
                        const int c = u.x1 * 256 + bj * 128 + col0 - 1024;
#pragma unroll
                        for (int e = 0; e < 8; ++e) v[e] = fsigmoid(v[e] + b1[c + e]);
                    }
                    if (KIND == 4 || KIND == 5) { w.x = pkh2(v[0], v[1]); w.y = pkh2(v[2], v[3]); w.z = pkh2(v[4], v[5]); w.w = pkh2(v[6], v[7]); }
                    else { w.x = cvt_pk_bf16(v[0], v[1]); w.y = cvt_pk_bf16(v[2], v[3]); w.z = cvt_pk_bf16(v[4], v[5]); w.w = cvt_pk_bf16(v[6], v[7]); }
                    *(v4u*)dst = w; }
    }
    __device__ __forceinline__ void operator()(const f32x4 (&acc)[2][2][4][2], const UnitG& u, int wr, int wc, int fr, int fq) const {
        const int kind = u.kind;
#define ES_CASE(K) if (((KM >> (K)) & 1) && (kind == (K) || (KM & ~(1 << (K))) == 0)) { run<K>(acc, u, wr, wc, fr, fq); return; }
        ES_CASE(0) ES_CASE(1) ES_CASE(2) ES_CASE(4) ES_CASE(5) ES_CASE(7) ES_CASE(8) ES_CASE(9) ES_CASE(10)
        if ((KM >> 6) & 1) run<0>(acc, u, wr, wc, fr, fq);
#undef ES_CASE
    }
};
struct SchedCF {
    SchedPlain P; char* O;
    __device__ __forceinline__ bool next(int i, UnitG& u) const { if (!P.next(i, u)) return false; u.O = O + ((size_t)u.x0 * 256 * 2048 + (size_t)u.x1 * 256) * 2; u.ldo = 2048; u.kind = 0; return true; }
};
struct SchedLR {
    SchedPlain P; char* EA; char* GT;
    __device__ __forceinline__ bool next(int i, UnitG& u) const {
        if (!P.next(i, u)) return false;
        if (u.x1 < 8) { u.O = EA + ((size_t)u.x0 * 256 * 2048 + (size_t)u.x1 * 256) * 2; u.ldo = 2048; u.kind = u.x1 < 4 ? 4 : 5; }
        else { u.O = GT + ((size_t)u.x0 * 256 * 512 + (size_t)(u.x1 - 8) * 256) * 2; u.ldo = 512; u.kind = 6; }
        { const int sl = u.x1 < 4 ? 0 : (u.x1 < 8 ? 1 : 2); u.A += sl * 256; u.B += sl * 256; u.K = 128; }
        return true;
    }
};
__device__ __forceinline__ int panel_tok0(int pn, int d) { const int n0 = pn * 256, seq = n0 >> 12, within = n0 & 4095, Lg = SEQ / d, p = within / Lg, s0 = within % Lg; return seq * SEQ + s0 * d + p; }
struct SchedAtt {
    const char* XN; const char* wt; char* ar; int G, c;
    __device__ __forceinline__ bool next(int i, UnitG& u) const {
        const int L = i * G + c; if (L >= 3840) return false;
        u.K = D; u.x0 = 0; u.x1 = 0;
        if (L < 2880) {
            const char* W = wt + WO_ATT;
            const int g = L / 960, rem = L % 960, d = (g == 0) ? 1 : (g == 1 ? 4 : 16);
            if (rem < 640) {
                int pm, pn; pg8::tile_map(rem, 160, 4, pm, pn);
                const int t0 = panel_tok0(pm, d);
                u.A = XN + (size_t)t0 * D * 2; u.lda = d * D;
                const int isk = pn >> 1, ct = pn & 1;
                u.B = W + (size_t)(isk * 1536 + g * 512 + ct * 256) * D * 2; u.ldb = D;
                u.O = ar + (isk ? AR_KA : AR_QA) + (size_t)g * T * 512 * 2; u.ldo = 512; u.kind = isk ? 8 : 7; u.x0 = 8 * pm; u.x1 = 2 * ct;
            } else {
                int pm, pn; pg8::tile_map(rem - 640, 2, 160, pm, pn);
                const int t0 = panel_tok0(pn, d);
                u.A = W + (size_t)(3072 + g * 512 + pm * 256) * D * 2; u.lda = D;
                u.B = XN + (size_t)t0 * D * 2; u.ldb = d * D;
                u.O = ar + AR_VTA + (size_t)g * 512 * T * 2; u.ldo = T; u.kind = 9; u.x0 = pm; u.x1 = 8 * pn;
            }
        } else if (L < 3520) {
            const char* W = wt + WO_RET;
            int pm, pn; pg8::tile_map(L - 2880, 160, 4, pm, pn);
            u.A = XN + (size_t)pm * 256 * D * 2; u.lda = D; u.ldb = D; u.ldo = 512;
            u.x0 = 8 * pm;
            if (pn < 2) { u.B = W + (size_t)(pn * 256) * D * 2; u.O = ar + AR_RQ; u.kind = 8; u.x1 = 2 * pn; }
            else { u.B = W + (size_t)(512 + (pn - 2) * 256) * D * 2; u.O = ar + AR_RK; u.kind = 7; u.x1 = 2 * (pn - 2); }
        } else {
            const char* W = wt + WO_RET;
            int pm, pn; pg8::tile_map(L - 3520, 2, 160, pm, pn);
            u.B = XN + (size_t)pn * 256 * D * 2; u.ldb = D; u.lda = D; u.ldo = T;
            u.A = W + (size_t)(512 + pm * 256) * D * 2; u.O = ar + AR_RKT; u.kind = 2; u.x0 = 2 * pm; u.x1 = 16 * pn;
        }
        return true;
    }
};
struct SchedRet {
    const char* XN; const char* W; char* ar; int G, c;
    __device__ __forceinline__ bool next(int i, UnitG& u) const {
        const int L = i * G + c; if (L >= 1280) return false;
        u.K = D; u.x0 = 0; u.x1 = 0; u.kind = 0; u.lda = D; u.ldb = D;
        if (L < 640) {
            int pm, pn; pg8::tile_map(L, 4, 160, pm, pn);
            u.A = W + (size_t)(1024 + pm * 256) * D * 2; u.B = XN + (size_t)pn * 256 * D * 2;
            u.O = ar + AR_RVT; u.ldo = T; u.kind = 10; u.x0 = pm; u.x1 = 16 * pn;
        } else {
            int pm, pn; pg8::tile_map(L - 640, 160, 4, pm, pn);
            u.A = XN + (size_t)pm * 256 * D * 2; u.B = W + (size_t)(2048 + pn * 256) * D * 2;
            u.O = ar + AR_RG + ((size_t)pm * 256 * 1024 + pn * 256) * 2; u.ldo = 1024;
        }
        return true;
    }
};
struct SchedMerge {
    const char* XN; const char* ar; const char* wt; int G, c;
    __device__ __forceinline__ bool next(int i, UnitG& u) const {
        const int L = (i / 6) * G + c, su = i % 6; if (L >= 1280) return false;
        int pm, pn; pg8::tile_map(L, 160, 8, pm, pn);
        u.x0 = pm; u.x1 = pn; u.kind = su; u.O = nullptr; u.ldo = 0;
        const int b = su >> 1;
        if (su & 1) { u.A = XN + (size_t)pm * 256 * D * 2; u.lda = D; u.K = D; u.B = wt + WO_GATE + (size_t)(b * 2048 + pn * 256) * D * 2; u.ldb = D; }
        else {
            const int kb = 512 << (b == 1 ? 1 : 0);
            const size_t yoff = (size_t)((b + 1) % 3) * (40 * MiB);
            const size_t woff = WO_BA + (size_t)(2 * b + 2 * (b >> 1)) * MiB;
            u.A = ar + yoff + (size_t)pm * 256 * kb * 2; u.lda = kb; u.K = kb;
            u.B = wt + woff + (size_t)pn * 256 * kb * 2; u.ldb = kb;
        }
        return true;
    }
};
static_assert(AR_YA == 40 * MiB && AR_YB == 80 * MiB && AR_YC == 0 && WO_BB == WO_BA + 2 * MiB && WO_BC == WO_BA + 6 * MiB, "SchedMerge offsets");
struct EpiMerge {
    static constexpr bool PERM = true; static constexpr int NST = 16;
    v4u* scrP; v4u* scrM; bf16* MG;
    __device__ __forceinline__ void operator()(const f32x4 (&acc)[2][2][4][2], const UnitG& u, int wr, int wc, int fr, int fq) const {
        const int tid = (wr * 4 + wc) * 64 + fq * 16 + fr; const int su = u.kind;
        if ((su & 1) == 0) {
            GAS v4u* p = (GAS v4u*)scrP + tid;
#pragma unroll
            for (int ai = 0; ai < 2; ++ai)
#pragma unroll
                for (int bj = 0; bj < 2; ++bj)
#pragma unroll
                    for (int m = 0; m < 4; ++m) { const f32x4 a0 = acc[ai][bj][m][0], a1 = acc[ai][bj][m][1];
                        v4u w; w.x = cvt_pk_bf16(a0.x, a0.y); w.y = cvt_pk_bf16(a0.z, a0.w); w.z = cvt_pk_bf16(a1.x, a1.y); w.w = cvt_pk_bf16(a1.z, a1.w);
                        *p = w; p += NTHR; asm volatile("" : "+v"(p)); }
            return;
        }
        const int row0 = u.x0 * 256 + wr * 64 + fr, col0 = u.x1 * 256 + wc * 32 + 8 * fq;
        const GAS v4u* pp = (const GAS v4u*)scrP + tid; GAS v4u* pm_ = (GAS v4u*)scrM + tid;
#pragma unroll
        for (int ai = 0; ai < 2; ++ai)
#pragma unroll
            for (int bj = 0; bj < 2; ++bj)
#pragma unroll
                for (int m = 0; m < 4; ++m) {
                    const v4u pw = *pp; v4u mw = {0u, 0u, 0u, 0u}; if (su > 1) mw = *pm_;
                    const f32x4 g0 = acc[ai][bj][m][0], g1 = acc[ai][bj][m][1];
                    float v[8];
                    v[0] = fsigmoid(g0.x) * bf_lo(pw.x) + bf_lo(mw.x); v[1] = fsigmoid(g0.y) * bf_hi(pw.x) + bf_hi(mw.x);
                    v[2] = fsigmoid(g0.z) * bf_lo(pw.y) + bf_lo(mw.y); v[3] = fsigmoid(g0.w) * bf_hi(pw.y) + bf_hi(mw.y);
                    v[4] = fsigmoid(g1.x) * bf_lo(pw.z) + bf_lo(mw.z); v[5] = fsigmoid(g1.y) * bf_hi(pw.z) + bf_hi(mw.z);
                    v[6] = fsigmoid(g1.z) * bf_lo(pw.w) + bf_lo(mw.w); v[7] = fsigmoid(g1.w) * bf_hi(pw.w) + bf_hi(mw.w);
                    v4u w; w.x = cvt_pk_bf16(v[0], v[1]); w.y = cvt_pk_bf16(v[2], v[3]); w.z = cvt_pk_bf16(v[4], v[5]); w.w = cvt_pk_bf16(v[6], v[7]);
                    if (su < 5) *pm_ = w;
                    else *(v4u*)(MG + (size_t)(row0 + ai * 128 + m * 16) * D + col0 + bj * 128) = w;
                    pp += NTHR; pm_ += NTHR; asm volatile("" : "+v"(pp), "+v"(pm_) :: "memory");
                }
    }
};

#define MFMA32(a, b, c) __builtin_amdgcn_mfma_f32_32x32x16_bf16((a), (b), (c), 0, 0, 0)
__device__ __forceinline__ v4u pk8(const f32x16& o, int b) { v4u w; w.x = cvt_pk_bf16(o[b], o[b + 1]); w.y = cvt_pk_bf16(o[b + 2], o[b + 3]); w.z = cvt_pk_bf16(o[b + 4], o[b + 5]); w.w = cvt_pk_bf16(o[b + 6], o[b + 7]); return w; }
__device__ __forceinline__ void phase_rwkv_pre(const Frame& F, const Args& a, int l) {
    const bf16* CF = (const bf16*)(F.ws + WS_AR + AR_CF); unsigned short* RK = (unsigned short*)(F.ws + WS_AR + AR_RKVK); bf16* LR = (bf16*)(F.ws + WS_AR + AR_LR);
    const float* cw = a.in[F.z + 10] + (size_t)l * 3 * 1920; const float* kk_w = a.in[F.z + 16] + (size_t)l * 512;
    const int lane = F.lane;
    for (int t = F.gw; t < T; t += F.NGW) {
        const int s = t & 4095; const bool hp = s > 0, hn = s < 4095;
#pragma unroll
        for (int j = 0; j < 4; ++j) {
            if (j == 3 && lane >= 48) continue;
            const int cb = 512 * j + 8 * lane;
            const v4u zc = {0u, 0u, 0u, 0u};
            const v4u cur = *(const v4u*)(CF + (size_t)t * 2048 + cb);
            const v4u prv = hp ? *(const v4u*)(CF + (size_t)(t - 1) * 2048 + cb) : zc;
            const v4u nxt = hn ? *(const v4u*)(CF + (size_t)(t + 1) * 2048 + cb) : zc;
            float o[8];
#pragma unroll
            for (int q = 0; q < 4; ++q) {
                const unsigned wc_ = cur[q], wp = prv[q], wn = nxt[q];
                const int c = cb + 2 * q;
                o[2 * q] = cw[c] * bf_lo(wp) + cw[1920 + c] * bf_lo(wc_) + cw[3840 + c] * bf_lo(wn);
                o[2 * q + 1] = cw[c + 1] * bf_hi(wp) + cw[1920 + c + 1] * bf_hi(wc_) + cw[3840 + c + 1] * bf_hi(wn);
            }
            if (j < 3) {
                v4u w; w.x = pkh2(o[0], o[1]); w.y = pkh2(o[2], o[3]); w.z = pkh2(o[4], o[5]); w.w = pkh2(o[6], o[7]);
                *(v4u*)(RK + (size_t)t * 2048 + cb) = w;
                if (j == 1) {
                    float kv[8]; float ss = 0.f;
#pragma unroll
                    for (int e = 0; e < 8; ++e) { kv[e] = o[e] * kk_w[8 * lane + e]; ss += kv[e] * kv[e]; }
                    ss += shfl_xor_(ss, 1); ss += shfl_xor_(ss, 2); ss += shfl_xor_(ss, 4);
                    const float rn = 1.0f / sqrtf(ss + 1e-12f);
                    v4u w2; w2.x = pkh2(kv[0] * rn, kv[1] * rn); w2.y = pkh2(kv[2] * rn, kv[3] * rn); w2.z = pkh2(kv[4] * rn, kv[5] * rn); w2.w = pkh2(kv[6] * rn, kv[7] * rn);
                    *(v4u*)(RK + (size_t)t * 2048 + 1536 + 8 * lane) = w2;
                }
            } else {
                if (lane < 16) {
#pragma unroll
                    for (int e = 0; e < 8; ++e) { const float ex = fexp(2.0f * o[e]); o[e] = 1.0f - 2.0f / (ex + 1.0f); }
                } else if (lane >= 32) {
#pragma unroll
                    for (int e = 0; e < 8; ++e) o[e] = fsigmoid(o[e]);
                }
                v4u w; w.x = pk2(o[0], o[1]); w.y = pk2(o[2], o[3]); w.z = pk2(o[4], o[5]); w.w = pk2(o[6], o[7]);
                *(v4u*)(LR + (size_t)t * 384 + 8 * lane) = w;
            }
        }
    }
}

__device__ __forceinline__ float dpp_red16(float x) {
    x += __builtin_bit_cast(float, __builtin_amdgcn_update_dpp(0, __builtin_bit_cast(int, x), 0xB1, 0xF, 0xF, true));
    x += __builtin_bit_cast(float, __builtin_amdgcn_update_dpp(0, __builtin_bit_cast(int, x), 0x4E, 0xF, 0xF, true));
    x += __builtin_bit_cast(float, __builtin_amdgcn_update_dpp(0, __builtin_bit_cast(int, x), 0x141, 0xF, 0xF, true));
    x += __builtin_bit_cast(float, __builtin_amdgcn_update_dpp(0, __builtin_bit_cast(int, x), 0x140, 0xF, 0xF, true));
    return x;
}
__device__ __forceinline__ void phase_rwkv_scan(const Frame& F, const Args& a, int l) {
    const unsigned short* EA = (const unsigned short*)(F.ws + WS_AR + AR_EA); const unsigned short* RK = (const unsigned short*)(F.ws + WS_AR + AR_RKVK);
    float* YS = (float*)(F.ws + WS_AR + AR_YS);
    const float* k_a = a.in[F.z + 17] + (size_t)l * 512;
    constexpr int TB = 32, BUF_F = TB * 384;
    LAS float* buf = (LAS float*)(F.lds + RING_OFF);
    LAS float* yo = buf + 2 * BUF_F;
    const int tid = F.tid, kq = tid & 15, rp = tid >> 4, c = tid & 63, ts = tid >> 6;
    for (int sc = F.bid; sc < 160; sc += F.G) {
        const int seq = sc >> 4, h = (sc >> 1) & 7, z = sc & 1;
        const float ka = k_a[h * 64 + c];
        float st[2][4];
#pragma unroll
        for (int r = 0; r < 2; ++r)
#pragma unroll
            for (int i = 0; i < 4; ++i) st[r][i] = 0.f;
        unsigned short raw[4][6];
#define SCAN_LOAD(nb) do { _Pragma("unroll") for (int i = 0; i < 4; ++i) { const int tau = (nb) * TB + ts + 8 * i; const int pos = z ? (SEQ - 1 - tau) : tau; const size_t tok = (size_t)seq * SEQ + pos; \
            raw[i][0] = EA[tok * 2048 + z * 512 + h * 64 + c]; raw[i][1] = EA[tok * 2048 + 1024 + z * 512 + h * 64 + c]; \
            raw[i][2] = RK[tok * 2048 + h * 64 + c]; raw[i][3] = RK[tok * 2048 + 512 + h * 64 + c]; raw[i][4] = RK[tok * 2048 + 1024 + h * 64 + c]; raw[i][5] = RK[tok * 2048 + 1536 + h * 64 + c]; } } while (0)
#define SCAN_STAGE(bi) do { LAS float* b_ = buf + (bi) * BUF_F; _Pragma("unroll") for (int i = 0; i < 4; ++i) { const int tl = ts + 8 * i; \
            const float e_ = h1(raw[i][0]), a_ = h1(raw[i][1]), r_ = h1(raw[i][2]), k_ = h1(raw[i][3]), v_ = h1(raw[i][4]), kk_ = h1(raw[i][5]); \
            b_[tl * 384 + c] = kk_; b_[tl * 384 + 64 + c] = fexp(-e_); b_[tl * 384 + 128 + c] = kk_ * a_; b_[tl * 384 + 192 + c] = k_ * (1.0f + (a_ - 1.0f) * ka); b_[tl * 384 + 256 + c] = r_; b_[tl * 384 + 320 + c] = v_; } } while (0)
        __syncthreads();
        SCAN_LOAD(0); SCAN_STAGE(0);
        __syncthreads();
        constexpr int NB = SEQ / TB;
        for (int nb = 0; nb < NB; ++nb) {
            if (nb + 1 < NB) SCAN_LOAD(nb + 1);
            const LAS float* b_ = buf + (nb & 1) * BUF_F;
#pragma unroll 4
            for (int stp = 0; stp < TB; ++stp) {
                const LAS float* op = b_ + stp * 384;
                const f32x4 kk4 = *(const LAS f32x4*)(op + 4 * kq), w4 = *(const LAS f32x4*)(op + 64 + 4 * kq), ka4 = *(const LAS f32x4*)(op + 128 + 4 * kq),
                            kd4 = *(const LAS f32x4*)(op + 192 + 4 * kq), r4 = *(const LAS f32x4*)(op + 256 + 4 * kq);
                const f32x2 v2 = *(const LAS f32x2*)(op + 320 + 2 * rp);
#pragma unroll
                for (int r = 0; r < 2; ++r) {
                    float sa = (st[r][0] * kk4.x + st[r][1] * kk4.y) + (st[r][2] * kk4.z + st[r][3] * kk4.w);
                    sa = -dpp_red16(sa);
                    const float vv = r ? v2.y : v2.x;
                    st[r][0] = st[r][0] * w4.x + sa * ka4.x + vv * kd4.x; st[r][1] = st[r][1] * w4.y + sa * ka4.y + vv * kd4.y;
                    st[r][2] = st[r][2] * w4.z + sa * ka4.z + vv * kd4.z; st[r][3] = st[r][3] * w4.w + sa * ka4.w + vv * kd4.w;
                    float y = (st[r][0] * r4.x + st[r][1] * r4.y) + (st[r][2] * r4.z + st[r][3] * r4.w);
                    y = dpp_red16(y);
                    if (kq == 0) yo[stp * 64 + 2 * rp + r] = y;
                }
            }
            if (nb + 1 < NB) SCAN_STAGE((nb + 1) & 1);
            __syncthreads();
#pragma unroll
            for (int i = 0; i < 4; ++i) { const int tl = ts + 8 * i, tau = nb * TB + tl; const int pos = z ? (SEQ - 1 - tau) : tau; const size_t tok = (size_t)seq * SEQ + pos;
                YS[((size_t)z * T + tok) * 512 + h * 64 + c] = yo[tl * 64 + c]; }
            __syncthreads();
        }
#undef SCAN_LOAD
#undef SCAN_STAGE
    }
}

constexpr int RW_CS = 64, RW_NSEG = (SEQ / 16) / RW_CS, RW_PBB = 12800;
__device__ __forceinline__ unsigned lds_u16(const LAS bf16* p) { return (unsigned)*p; }
__device__ __forceinline__ void phase_rwkv_prep(const Frame& F, const Args& a, int l, int seg) {
    const unsigned short* EA = (const unsigned short*)(F.ws + WS_AR + AR_EA); const unsigned short* RK = (const unsigned short*)(F.ws + WS_AR + AR_RKVK);
    unsigned char* PB = F.ws + WS_AR + AR_PB;
    const float* k_a = a.in[F.z + 17] + (size_t)l * 512;
    constexpr int LDA = 72, GLD = 36, M2D = 24;
    LAS unsigned char* pw = F.lds + RING_OFF + F.wave * 15360;
    LAS bf16* AR = (LAS bf16*)pw; LAS bf16* BK = (LAS bf16*)(pw + 4608); LAS float* GL = (LAS float*)(pw + 9216); LAS bf16* VL = (LAS bf16*)(pw + 9216); LAS bf16* M2 = (LAS bf16*)(pw + 13824);
    const int L = F.lane, li = L & 31, hh = L >> 5;
#define PREP_LOAD(dst, it_, hb_) do { const int sc_ = (it_) / RW_CS, c_ = seg * RW_CS + (it_) % RW_CS, seq_ = sc_ >> 4, h_ = (sc_ >> 1) & 7, z_ = sc_ & 1; \
        _Pragma("unroll") for (int t8 = 0; t8 < 8; ++t8) { const int tau = 16 * c_ + 8 * (hb_) + t8, pos = z_ ? (SEQ - 1 - tau) : tau; const size_t tok = (size_t)seq_ * SEQ + pos; \
            dst[t8][0] = EA[tok * 2048 + z_ * 512 + h_ * 64 + L]; dst[t8][1] = EA[tok * 2048 + 1024 + z_ * 512 + h_ * 64 + L]; \
            dst[t8][2] = RK[tok * 2048 + h_ * 64 + L]; dst[t8][3] = RK[tok * 2048 + 512 + h_ * 64 + L]; dst[t8][4] = RK[tok * 2048 + 1024 + h_ * 64 + L]; dst[t8][5] = RK[tok * 2048 + 1536 + h_ * 64 + L]; } } while (0)
#define PREP_HALF(src_, hb_) do { _Pragma("unroll") for (int t8 = 0; t8 < 8; ++t8) { const int t = 8 * (hb_) + t8; \
            const float e_ = h1(src_[t8][0]), a_ = h1(src_[t8][1]), r_ = h1(src_[t8][2]), k_ = h1(src_[t8][3]), v_ = h1(src_[t8][4]), kk_ = h1(src_[t8][5]); \
            cum += e_; gam = fexp(-cum); const float ig = fexp(cum); \
            const float at = -kk_ * gprev, bt = kk_ * a_ * ig, kt = k_ * (1.0f + (a_ - 1.0f) * ka) * ig, rt = r_ * gam; \
            atf[t] = at; \
            AR[t * LDA + L] = (bf16)f2bf(at); AR[(16 + t) * LDA + L] = (bf16)f2bf(rt); BK[t * LDA + L] = (bf16)f2bf(bt); BK[(16 + t) * LDA + L] = (bf16)f2bf(kt); VL[t * LDA + L] = (bf16)f2bf(v_); \
            gprev = gam; } } while (0)
    unsigned short raw0[8][6], raw1[8][6];
    if (F.gw < 160 * RW_CS) PREP_LOAD(raw0, F.gw, 0);
    for (int item = F.gw; item < 160 * RW_CS; item += F.NGW) {
        const int sc = item / RW_CS, cl = item % RW_CS, h = (sc >> 1) & 7;
        unsigned char* rec = PB + (size_t)(sc * RW_CS + cl) * RW_PBB;
        const float ka = k_a[h * 64 + L];
        float atf[16]; float cum = 0.f, gprev = 1.f, gam = 1.f;
        PREP_LOAD(raw1, item, 1);
        asm volatile("" ::: "memory");
        PREP_HALF(raw0, 0);
        { const int nit = (item + F.NGW < 160 * RW_CS) ? item + F.NGW : item; PREP_LOAD(raw0, nit, 0); }
        asm volatile("" ::: "memory");
        PREP_HALF(raw1, 1);
        *(float*)(rec + 12288 + 4 * L) = gam;
        LDS_WAIT(); asm volatile("" ::: "memory");
#pragma unroll
        for (int vt = 0; vt < 2; ++vt) { v4u w;
#pragma unroll
            for (int q = 0; q < 4; ++q) w[q] = lds_u16(VL + (8 * hh + 2 * q) * LDA + 32 * vt + li) | (lds_u16(VL + (8 * hh + 2 * q + 1) * LDA + 32 * vt + li) << 16);
            *(v4u*)(rec + 10240 + vt * 1024 + 16 * L) = w; }
#pragma unroll
        for (int kt = 0; kt < 2; ++kt) { v4u w, w2;
#pragma unroll
            for (int q = 0; q < 4; ++q) { w[q] = lds_u16(BK + (16 + 8 * hh + 2 * q) * LDA + 32 * kt + li) | (lds_u16(BK + (16 + 8 * hh + 2 * q + 1) * LDA + 32 * kt + li) << 16);
                const int j0 = 2 * q, j1 = 2 * q + 1, s0 = 8 * (j0 >> 2) + 4 * hh + (j0 & 3), s1 = 8 * (j1 >> 2) + 4 * hh + (j1 & 3);
                w2[q] = lds_u16(BK + s0 * LDA + 32 * kt + li) | (lds_u16(BK + s1 * LDA + 32 * kt + li) << 16); }
            *(v4u*)(rec + 7168 + kt * 1024 + 16 * L) = w; *(v4u*)(rec + 5120 + kt * 1024 + 16 * L) = w2; }
        f32x16 g;
#pragma unroll
        for (int e = 0; e < 16; ++e) g[e] = 0.f;
#pragma unroll
        for (int ks = 0; ks < 4; ++ks) { const bf16x8 af = *(const LAS bf16x8*)(AR + li * LDA + 16 * ks + 8 * hh); const bf16x8 bf = *(const LAS bf16x8*)(BK + li * LDA + 16 * ks + 8 * hh); g = MFMA32(af, bf, g); }
        LDS_WAIT(); asm volatile("" ::: "memory");
#pragma unroll
        for (int e = 0; e < 16; ++e) GL[((e & 3) + 8 * (e >> 2) + 4 * hh) * GLD + li] = g[e];
        LDS_WAIT(); asm volatile("" ::: "memory");
        float y2[16];
#pragma unroll
        for (int t = 0; t < 16; ++t) y2[t] = (L < 16 && L < t) ? GL[t * GLD + 16 + (L & 15)] : 0.f;
#pragma unroll
        for (int t = 1; t < 16; ++t) {
            float cf[16];
#pragma unroll
            for (int q = 0; q < 4; ++q) { if (4 * q < t) { const f32x4 c4 = *(const LAS f32x4*)(GL + t * GLD + 4 * q); cf[4 * q] = c4.x; cf[4 * q + 1] = c4.y; cf[4 * q + 2] = c4.z; cf[4 * q + 3] = c4.w; } }
#pragma unroll
            for (int s = 0; s < 16; ++s) if (s < t) { atf[t] += cf[s] * atf[s]; y2[t] += cf[s] * y2[s]; }
        }
#pragma unroll
        for (int t = 0; t < 16; ++t) { AR[t * LDA + L] = (bf16)f2bf(atf[t]); if (L < 16) M2[t * M2D + L] = (bf16)f2bf(y2[t]); }
        { const int t = L >> 2, s0 = 4 * (L & 3); const f32x4 c4 = *(const LAS f32x4*)(GL + (16 + t) * GLD + 16 + s0);
          v2u w; w.x = pk2(s0 <= t ? c4.x : 0.f, s0 + 1 <= t ? c4.y : 0.f); w.y = pk2(s0 + 2 <= t ? c4.z : 0.f, s0 + 3 <= t ? c4.w : 0.f);
          *(LAS v2u*)(M2 + (16 + t) * M2D + s0) = w; }
        LDS_WAIT(); asm volatile("" ::: "memory");
#pragma unroll
        for (int ks = 0; ks < 4; ++ks) { const v2u p0 = *(const LAS v2u*)(AR + li * LDA + 16 * ks + 4 * hh), p1 = *(const LAS v2u*)(AR + li * LDA + 16 * ks + 8 + 4 * hh);
            v4u w; w.x = p0.x; w.y = p0.y; w.z = p1.x; w.w = p1.y; *(v4u*)(rec + ks * 1024 + 16 * L) = w; }
        *(v4u*)(rec + 4096 + 16 * L) = *(const LAS v4u*)(M2 + li * M2D + 8 * hh);
        { v4u w = {0u, 0u, 0u, 0u};
          if (li >= 16) { const int t = li - 16; const f32x4 c0 = *(const LAS f32x4*)(GL + (16 + t) * GLD + 4 * hh), c1 = *(const LAS f32x4*)(GL + (16 + t) * GLD + 8 + 4 * hh); const int s0 = 4 * hh, s1 = 8 + 4 * hh;
              w.x = pk2(s0 <= t ? c0.x : 0.f, s0 + 1 <= t ? c0.y : 0.f); w.y = pk2(s0 + 2 <= t ? c0.z : 0.f, s0 + 3 <= t ? c0.w : 0.f);
              w.z = pk2(s1 <= t ? c1.x : 0.f, s1 + 1 <= t ? c1.y : 0.f); w.w = pk2(s1 + 2 <= t ? c1.z : 0.f, s1 + 3 <= t ? c1.w : 0.f); }
          *(v4u*)(rec + 9216 + 16 * L) = w; }
        LDS_WAIT(); asm volatile("" ::: "memory");
    }
#undef PREP_LOAD
#undef PREP_HALF
}
__device__ __forceinline__ void phase_rwkv_fused(const Frame& F, const Args& a, int l) {
    if (F.bid >= 160) return;
    const int sc = F.bid, seq = sc >> 4, h = (sc >> 1) & 7, z = sc & 1;
    constexpr int NCH = SEQ / 16, FR_RING = 6 * 15360, FR_FLAGS = FR_RING + 3 * RW_PBB;
    LAS unsigned char* ring = F.lds + RING_OFF + FR_RING;
    volatile LAS unsigned* ready = (volatile LAS unsigned*)(F.lds + RING_OFF + FR_FLAGS);
    volatile LAS unsigned* done = ready + 4;
    bf16* YS = (bf16*)(F.ws + WS_AR + AR_YSB);
    __syncthreads();
    if (F.tid < 16) ready[F.tid] = 0u;
    __syncthreads();
    if (F.wave >= 2) {
    const unsigned short* EA = (const unsigned short*)(F.ws + WS_AR + AR_EA); const unsigned short* RK = (const unsigned short*)(F.ws + WS_AR + AR_RKVK);
    const float* k_a = a.in[F.z + 17] + (size_t)l * 512;
    constexpr int LDA = 72, GLD = 36, M2D = 24;
    LAS unsigned char* pw = F.lds + RING_OFF + (F.wave - 2) * 15360;
    LAS bf16* AR = (LAS bf16*)pw; LAS bf16* BK = (LAS bf16*)(pw + 4608); LAS float* GL = (LAS float*)(pw + 9216); LAS bf16* VL = (LAS bf16*)(pw + 9216); LAS bf16* M2 = (LAS bf16*)(pw + 13824);
    const int L = F.lane, li = L & 31, hh = L >> 5;
#define PREP_LOAD(dst, it_, hb_) do { const int c_ = (it_), seq_ = seq, h_ = h, z_ = z; \
        _Pragma("unroll") for (int t8 = 0; t8 < 8; ++t8) { const int tau = 16 * c_ + 8 * (hb_) + t8, pos = z_ ? (SEQ - 1 - tau) : tau; const size_t tok = (size_t)seq_ * SEQ + pos; \
            dst[t8][0] = EA[tok * 2048 + z_ * 512 + h_ * 64 + L]; dst[t8][1] = EA[tok * 2048 + 1024 + z_ * 512 + h_ * 64 + L]; \
            dst[t8][2] = RK[tok * 2048 + h_ * 64 + L]; dst[t8][3] = RK[tok * 2048 + 512 + h_ * 64 + L]; dst[t8][4] = RK[tok * 2048 + 1024 + h_ * 64 + L]; dst[t8][5] = RK[tok * 2048 + 1536 + h_ * 64 + L]; } } while (0)
#define PREP_HALF(src_, hb_) do { _Pragma("unroll") for (int t8 = 0; t8 < 8; ++t8) { const int t = 8 * (hb_) + t8; \
            const float e_ = h1(src_[t8][0]), a_ = h1(src_[t8][1]), r_ = h1(src_[t8][2]), k_ = h1(src_[t8][3]), v_ = h1(src_[t8][4]), kk_ = h1(src_[t8][5]); \
            cum += e_; gam = fexp(-cum); const float ig = fexp(cum); \
            const float at = -kk_ * gprev, bt = kk_ * a_ * ig, kt = k_ * (1.0f + (a_ - 1.0f) * ka) * ig, rt = r_ * gam; \
            atf[t] = at; \
            AR[t * LDA + L] = (bf16)f2bf(at); AR[(16 + t) * LDA + L] = (bf16)f2bf(rt); BK[t * LDA + L] = (bf16)f2bf(bt); BK[(16 + t) * LDA + L] = (bf16)f2bf(kt); VL[t * LDA + L] = (bf16)f2bf(v_); \
            gprev = gam; } } while (0)
    unsigned short raw0[8][6], raw1[8][6];
    const float ka_ = k_a[h * 64 + L];
    PREP_LOAD(raw0, F.wave - 2, 0); PREP_LOAD(raw1, F.wave - 2, 1);
    for (int item = F.wave - 2; item < NCH; item += 6) {
        v4u frv[2]; float gamC;
        const float ka = ka_;
        float atf[16]; float cum = 0.f, gprev = 1.f, gam = 1.f;
        asm volatile("" ::: "memory");
        PREP_HALF(raw0, 0);
        PREP_HALF(raw1, 1);
        gamC = gam;
        LDS_WAIT(); asm volatile("" ::: "memory");
#pragma unroll
        for (int vt = 0; vt < 2; ++vt) { v4u w;
#pragma unroll
            for (int q = 0; q < 4; ++q) w[q] = lds_u16(VL + (8 * hh + 2 * q) * LDA + 32 * vt + li) | (lds_u16(VL + (8 * hh + 2 * q + 1) * LDA + 32 * vt + li) << 16);
            frv[vt] = w; }
        f32x16 g;
#pragma unroll
        for (int e = 0; e < 16; ++e) g[e] = 0.f;
#pragma unroll
        for (int ks = 0; ks < 4; ++ks) { const bf16x8 af = *(const LAS bf16x8*)(AR + li * LDA + 16 * ks + 8 * hh); const bf16x8 bf = *(const LAS bf16x8*)(BK + li * LDA + 16 * ks + 8 * hh); g = MFMA32(af, bf, g); }
        LDS_WAIT(); asm volatile("" ::: "memory");
#pragma unroll
        for (int e = 0; e < 16; ++e) GL[((e & 3) + 8 * (e >> 2) + 4 * hh) * GLD + li] = g[e];
        LDS_WAIT(); asm volatile("" ::: "memory");
        float y2[16];
#pragma unroll
        for (int t = 0; t < 16; ++t) y2[t] = (L < 16 && L < t) ? GL[t * GLD + 16 + (L & 15)] : 0.f;
#pragma unroll
        for (int t = 1; t < 16; ++t) {
            float cf[16];
#pragma unroll
            for (int q = 0; q < 4; ++q) { if (4 * q < t) { const f32x4 c4 = *(const LAS f32x4*)(GL + t * GLD + 4 * q); cf[4 * q] = c4.x; cf[4 * q + 1] = c4.y; cf[4 * q + 2] = c4.z; cf[4 * q + 3] = c4.w; } }
#pragma unroll
            for (int s = 0; s < 16; ++s) if (s < t) { atf[t] += cf[s] * atf[s]; y2[t] += cf[s] * y2[s]; }
        }
#pragma unroll
        for (int t = 0; t < 16; ++t) { AR[t * LDA + L] = (bf16)f2bf(atf[t]); if (L < 16) M2[t * M2D + L] = (bf16)f2bf(y2[t]); }
        { const int t = L >> 2, s0 = 4 * (L & 3); const f32x4 c4 = *(const LAS f32x4*)(GL + (16 + t) * GLD + 16 + s0);
          v2u w; w.x = pk2(s0 <= t ? c4.x : 0.f, s0 + 1 <= t ? c4.y : 0.f); w.y = pk2(s0 + 2 <= t ? c4.z : 0.f, s0 + 3 <= t ? c4.w : 0.f);
          *(LAS v2u*)(M2 + (16 + t) * M2D + s0) = w; }
        LDS_WAIT(); asm volatile("" ::: "memory");
        { const int nit = (item + 6 < NCH) ? item + 6 : item; PREP_LOAD(raw0, nit, 0); PREP_LOAD(raw1, nit, 1); }
        asm volatile("" ::: "memory");
        const int slot = item % 3;
        if (item >= 3) { unsigned sp = 0; while ((done[slot * 2] < (unsigned)(item - 2) || done[slot * 2 + 1] < (unsigned)(item - 2)) && ++sp < (1u << 22)) __builtin_amdgcn_s_sleep(1); }
        asm volatile("" ::: "memory");
        LAS unsigned char* rp = ring + slot * RW_PBB;
#pragma unroll
        for (int ks = 0; ks < 4; ++ks) { const v2u p0 = *(const LAS v2u*)(AR + li * LDA + 16 * ks + 4 * hh), p1 = *(const LAS v2u*)(AR + li * LDA + 16 * ks + 8 + 4 * hh);
            v4u w; w.x = p0.x; w.y = p0.y; w.z = p1.x; w.w = p1.y; *(LAS v4u*)(rp + ks * 1024 + 16 * L) = w; }
        { const v4u w4 = *(const LAS v4u*)(M2 + li * M2D + 8 * hh); *(LAS v4u*)(rp + 4096 + 16 * L) = w4; }
        { v4u w = {0u, 0u, 0u, 0u};
          if (li >= 16) { const int t = li - 16; const f32x4 c0 = *(const LAS f32x4*)(GL + (16 + t) * GLD + 4 * hh), c1 = *(const LAS f32x4*)(GL + (16 + t) * GLD + 8 + 4 * hh); const int s0 = 4 * hh, s1 = 8 + 4 * hh;
              w.x = pk2(s0 <= t ? c0.x : 0.f, s0 + 1 <= t ? c0.y : 0.f); w.y = pk2(s0 + 2 <= t ? c0.z : 0.f, s0 + 3 <= t ? c0.w : 0.f);
              w.z = pk2(s1 <= t ? c1.x : 0.f, s1 + 1 <= t ? c1.y : 0.f); w.w = pk2(s1 + 2 <= t ? c1.z : 0.f, s1 + 3 <= t ? c1.w : 0.f); }
          *(LAS v4u*)(rp + 9216 + 16 * L) = w; }
#pragma unroll
        for (int kt = 0; kt < 2; ++kt) { v4u w, w2;
#pragma unroll
            for (int q = 0; q < 4; ++q) { w[q] = lds_u16(BK + (16 + 8 * hh + 2 * q) * LDA + 32 * kt + li) | (lds_u16(BK + (16 + 8 * hh + 2 * q + 1) * LDA + 32 * kt + li) << 16);
                const int j0 = 2 * q, j1 = 2 * q + 1, s0 = 8 * (j0 >> 2) + 4 * hh + (j0 & 3), s1 = 8 * (j1 >> 2) + 4 * hh + (j1 & 3);
                w2[q] = lds_u16(BK + s0 * LDA + 32 * kt + li) | (lds_u16(BK + s1 * LDA + 32 * kt + li) << 16); }
            *(LAS v4u*)(rp + 7168 + kt * 1024 + 16 * L) = w; *(LAS v4u*)(rp + 5120 + kt * 1024 + 16 * L) = w2; }
        LDS_WAIT(); asm volatile("" ::: "memory");
        *(LAS v4u*)(rp + 10240 + 16 * L) = frv[0]; *(LAS v4u*)(rp + 11264 + 16 * L) = frv[1];
        *(LAS float*)(rp + 12288 + 4 * L) = gamC;
        LDS_WAIT(); asm volatile("" ::: "memory");
        if (L == 0) ready[slot] = (unsigned)(item + 1);
    }
#undef PREP_LOAD
#undef PREP_HALF
        return;
    }
    const int L = F.lane, li = L & 31, hh = L >> 5, vt = F.wave;
    f32x16 st[2];
#pragma unroll
    for (int kt = 0; kt < 2; ++kt)
#pragma unroll
        for (int e = 0; e < 16; ++e) st[kt][e] = 0.f;
    for (int cl = 0; cl < NCH; ++cl) {
        const int slot = cl % 3;
        { unsigned sp = 0; while (ready[slot] != (unsigned)(cl + 1) && ++sp < (1u << 22)) __builtin_amdgcn_s_sleep(1); }
        asm volatile("" ::: "memory");
        const LAS unsigned char* rec = ring + slot * RW_PBB;
        bf16x8 a1[4], btf[2], ktf[2]; f32x4 gm[2][4];
#pragma unroll
        for (int ks = 0; ks < 4; ++ks) a1[ks] = *(const LAS bf16x8*)(rec + ks * 1024 + 16 * L);
        const bf16x8 a2 = *(const LAS bf16x8*)(rec + 4096 + 16 * L), mbr = *(const LAS bf16x8*)(rec + 9216 + 16 * L), vc = *(const LAS bf16x8*)(rec + 10240 + vt * 1024 + 16 * L);
#pragma unroll
        for (int kt = 0; kt < 2; ++kt) { btf[kt] = *(const LAS bf16x8*)(rec + 5120 + kt * 1024 + 16 * L); ktf[kt] = *(const LAS bf16x8*)(rec + 7168 + kt * 1024 + 16 * L);
#pragma unroll
            for (int q4 = 0; q4 < 4; ++q4) gm[kt][q4] = *(const LAS f32x4*)(rec + 12288 + 4 * (32 * kt + 8 * q4 + 4 * hh)); }
        LDS_WAIT(); asm volatile("" ::: "memory");
        if (L == 0) done[slot * 2 + vt] = (unsigned)(cl + 1);
        f32x16 acc;
#pragma unroll
        for (int e = 0; e < 16; ++e) acc[e] = 0.f;
        acc = MFMA32(a2, vc, acc);
#pragma unroll
        for (int ks = 0; ks < 4; ++ks) { const int kt = ks >> 1, b8 = 8 * (ks & 1);
            v4u w; w.x = cvt_pk_bf16(st[kt][b8], st[kt][b8 + 1]); w.y = cvt_pk_bf16(st[kt][b8 + 2], st[kt][b8 + 3]); w.z = cvt_pk_bf16(st[kt][b8 + 4], st[kt][b8 + 5]); w.w = cvt_pk_bf16(st[kt][b8 + 6], st[kt][b8 + 7]);
            acc = MFMA32(a1[ks], __builtin_bit_cast(bf16x8, w), acc); }
        v4u uw; uw.x = cvt_pk_bf16(acc[0], acc[1]); uw.y = cvt_pk_bf16(acc[2], acc[3]); uw.z = cvt_pk_bf16(acc[4], acc[5]); uw.w = cvt_pk_bf16(acc[6], acc[7]);
        const bf16x8 uf = __builtin_bit_cast(bf16x8, uw);
        acc = MFMA32(mbr, uf, acc);
#pragma unroll
        for (int kt = 0; kt < 2; ++kt) { st[kt] = MFMA32(btf[kt], uf, st[kt]); st[kt] = MFMA32(ktf[kt], vc, st[kt]);
#pragma unroll
            for (int q4 = 0; q4 < 4; ++q4) { st[kt][4 * q4] *= gm[kt][q4].x; st[kt][4 * q4 + 1] *= gm[kt][q4].y; st[kt][4 * q4 + 2] *= gm[kt][q4].z; st[kt][4 * q4 + 3] *= gm[kt][q4].w; } }
#pragma unroll
        for (int e = 8; e < 16; ++e) { const int t = (e & 3) + 8 * ((e >> 2) - 2) + 4 * hh, tau = 16 * cl + t, pos = z ? (SEQ - 1 - tau) : tau; const size_t tok = (size_t)seq * SEQ + pos;
            YS[((size_t)z * T + tok) * 512 + h * 64 + 32 * vt + li] = (bf16)f2bf(acc[e]); }
    }
}

__device__ __forceinline__ void phase_rwkv_cscan(const Frame& F, int seg) {
    if (F.bid >= 160) return;
    const unsigned char* PB = F.ws + WS_AR + AR_PB; bf16* YS = (bf16*)(F.ws + WS_AR + AR_YSB); float* STS = (float*)(F.ws + WS_AR + AR_STS);
    LAS unsigned char* ring = F.lds + RING_OFF;
    volatile LAS unsigned* ready = (volatile LAS unsigned*)(F.lds + RING_OFF + 8 * RW_PBB);
    volatile LAS unsigned* done = ready + 8;
    const int L = F.lane, li = L & 31, hh = L >> 5, sc = F.bid, seq = sc >> 4, h = (sc >> 1) & 7, z = sc & 1;
    __syncthreads();
    if (F.tid < 24) ready[F.tid] = 0u;
    __syncthreads();
    if (F.wave >= 2) {
        for (int cl = F.wave - 2; cl < RW_CS; cl += 6) {
            const int slot = cl & 7;
            if (cl >= 8) { unsigned sp = 0; while ((done[slot * 2] < (unsigned)(cl - 7) || done[slot * 2 + 1] < (unsigned)(cl - 7)) && ++sp < (1u << 22)) __builtin_amdgcn_s_sleep(1); }
            asm volatile("" ::: "memory");
            const unsigned char* rec = PB + (size_t)(sc * RW_CS + cl) * RW_PBB;
            v4u r[13];
#pragma unroll
            for (int i = 0; i < 13; ++i) { const int o = (i * 64 + L) * 16; r[i] = (o < RW_PBB) ? *(const v4u*)(rec + o) : (v4u){0u, 0u, 0u, 0u}; }
#pragma unroll
            for (int i = 0; i < 13; ++i) { const int o = (i * 64 + L) * 16; if (o < RW_PBB) *(LAS v4u*)(ring + slot * RW_PBB + o) = r[i]; }
            LDS_WAIT(); asm volatile("" ::: "memory");
            if (L == 0) ready[slot] = (unsigned)(cl + 1);
        }
        return;
    }
    const int vt = F.wave;
    f32x16 st[2];
    float* sts = STS + ((size_t)(sc * 2 + vt) * 2) * 1024 + L;
#pragma unroll
    for (int kt = 0; kt < 2; ++kt)
#pragma unroll
        for (int e = 0; e < 16; ++e) st[kt][e] = (seg == 0) ? 0.f : sts[(kt * 16 + e) * 64];
    for (int cl = 0; cl < RW_CS; ++cl) {
        const int slot = cl & 7;
        { unsigned sp = 0; while (ready[slot] != (unsigned)(cl + 1) && ++sp < (1u << 22)) __builtin_amdgcn_s_sleep(1); }
        asm volatile("" ::: "memory");
        const LAS unsigned char* rec = ring + slot * RW_PBB;
        bf16x8 a1[4], btf[2], ktf[2]; f32x4 gm[2][4];
#pragma unroll
        for (int ks = 0; ks < 4; ++ks) a1[ks] = *(const LAS bf16x8*)(rec + ks * 1024 + 16 * L);
        const bf16x8 a2 = *(const LAS bf16x8*)(rec + 4096 + 16 * L), mbr = *(const LAS bf16x8*)(rec + 9216 + 16 * L), vc = *(const LAS bf16x8*)(rec + 10240 + vt * 1024 + 16 * L);
#pragma unroll
        for (int kt = 0; kt < 2; ++kt) { btf[kt] = *(const LAS bf16x8*)(rec + 5120 + kt * 1024 + 16 * L); ktf[kt] = *(const LAS bf16x8*)(rec + 7168 + kt * 1024 + 16 * L);
#pragma unroll
            for (int q4 = 0; q4 < 4; ++q4) gm[kt][q4] = *(const LAS f32x4*)(rec + 12288 + 4 * (32 * kt + 8 * q4 + 4 * hh)); }
        LDS_WAIT(); asm volatile("" ::: "memory");
        if (L == 0) done[slot * 2 + vt] = (unsigned)(cl + 1);
        f32x16 acc;
#pragma unroll
        for (int e = 0; e < 16; ++e) acc[e] = 0.f;
        acc = MFMA32(a2, vc, acc);
#pragma unroll
        for (int ks = 0; ks < 4; ++ks) { const int kt = ks >> 1, b8 = 8 * (ks & 1);
            v4u w; w.x = cvt_pk_bf16(st[kt][b8], st[kt][b8 + 1]); w.y = cvt_pk_bf16(st[kt][b8 + 2], st[kt][b8 + 3]); w.z = cvt_pk_bf16(st[kt][b8 + 4], st[kt][b8 + 5]); w.w = cvt_pk_bf16(st[kt][b8 + 6], st[kt][b8 + 7]);
            acc = MFMA32(a1[ks], __builtin_bit_cast(bf16x8, w), acc); }
        v4u uw; uw.x = cvt_pk_bf16(acc[0], acc[1]); uw.y = cvt_pk_bf16(acc[2], acc[3]); uw.z = cvt_pk_bf16(acc[4], acc[5]); uw.w = cvt_pk_bf16(acc[6], acc[7]);
        const bf16x8 uf = __builtin_bit_cast(bf16x8, uw);
        acc = MFMA32(mbr, uf, acc);
#pragma unroll
        for (int kt = 0; kt < 2; ++kt) { st[kt] = MFMA32(btf[kt], uf, st[kt]); st[kt] = MFMA32(ktf[kt], vc, st[kt]);
#pragma unroll
            for (int q4 = 0; q4 < 4; ++q4) { st[kt][4 * q4] *= gm[kt][q4].x; st[kt][4 * q4 + 1] *= gm[kt][q4].y; st[kt][4 * q4 + 2] *= gm[kt][q4].z; st[kt][4 * q4 + 3] *= gm[kt][q4].w; } }
        const int c = seg * RW_CS + cl;
#pragma unroll
        for (int e = 8; e < 16; ++e) { const int t = (e & 3) + 8 * ((e >> 2) - 2) + 4 * hh, tau = 16 * c + t, pos = z ? (SEQ - 1 - tau) : tau; const size_t tok = (size_t)seq * SEQ + pos;
            YS[((size_t)z * T + tok) * 512 + h * 64 + 32 * vt + li] = (bf16)f2bf(acc[e]); }
    }
#pragma unroll
    for (int kt = 0; kt < 2; ++kt)
#pragma unroll
        for (int e = 0; e < 16; ++e) sts[(kt * 16 + e) * 64] = st[kt][e];
}

__device__ __forceinline__ void phase_rwkv_post(const Frame& F, const Args& a, int l) {
    const unsigned short* EA = (const unsigned short*)(F.ws + WS_AR + AR_EA); const unsigned short* RK = (const unsigned short*)(F.ws + WS_AR + AR_RKVK);
    const bf16* GT = (const bf16*)(F.ws + WS_AR + AR_GT); const float* YS = (const float*)(F.ws + WS_AR + AR_YS); const bf16* YSB = (const bf16*)(F.ws + WS_AR + AR_YSB); bf16* YC = (bf16*)(F.ws + WS_AR + AR_YC); (void)YS; (void)YSB;
    const float* k_a = a.in[F.z + 17] + (size_t)l * 512; const float* r_k = a.in[F.z + 18] + (size_t)l * 512; const float* ln_w = a.in[F.z + 19] + (size_t)l * 512; const float* ln_b = a.in[F.z + 20] + (size_t)l * 512;
    const int lane = F.lane, c0 = 8 * lane;
    for (int t = F.gw; t < T; t += F.NGW) {
        float y[8];
#if MK_CHUNKED
        { const v4u p = *(const v4u*)(YSB + (size_t)t * 512 + c0), q = *(const v4u*)(YSB + ((size_t)T + t) * 512 + c0);
#pragma unroll
          for (int i = 0; i < 4; ++i) { y[2 * i] = bf_lo(p[i]) + bf_lo(q[i]); y[2 * i + 1] = bf_hi(p[i]) + bf_hi(q[i]); } }
#else
        { const f32x4 p0 = *(const f32x4*)(YS + (size_t)t * 512 + c0), p1 = *(const f32x4*)(YS + (size_t)t * 512 + c0 + 4);
          const f32x4 q0 = *(const f32x4*)(YS + ((size_t)T + t) * 512 + c0), q1 = *(const f32x4*)(YS + ((size_t)T + t) * 512 + c0 + 4);
          y[0] = p0.x + q0.x; y[1] = p0.y + q0.y; y[2] = p0.z + q0.z; y[3] = p0.w + q0.w; y[4] = p1.x + q1.x; y[5] = p1.y + q1.y; y[6] = p1.z + q1.z; y[7] = p1.w + q1.w; }
#endif
        const v4u rr = *(const v4u*)(RK + (size_t)t * 2048 + c0), kk = *(const v4u*)(RK + (size_t)t * 2048 + 512 + c0), vv = *(const v4u*)(RK + (size_t)t * 2048 + 1024 + c0);
        const v4u a0 = *(const v4u*)(EA + (size_t)t * 2048 + 1024 + c0), a1 = *(const v4u*)(EA + (size_t)t * 2048 + 1536 + c0);
        const v4u gg = *(const v4u*)(GT + (size_t)t * 512 + c0);
        float r[8], k[8], v[8], aa0[8], aa1[8], g[8];
#pragma unroll
        for (int q = 0; q < 4; ++q) { r[2 * q] = h_lo(rr[q]); r[2 * q + 1] = h_hi(rr[q]); k[2 * q] = h_lo(kk[q]); k[2 * q + 1] = h_hi(kk[q]); v[2 * q] = h_lo(vv[q]); v[2 * q + 1] = h_hi(vv[q]);
            aa0[2 * q] = h_lo(a0[q]); aa0[2 * q + 1] = h_hi(a0[q]); aa1[2 * q] = h_lo(a1[q]); aa1[2 * q + 1] = h_hi(a1[q]); g[2 * q] = bf_lo(gg[q]); g[2 * q + 1] = bf_hi(gg[q]); }
        float s = 0.f, bon = 0.f;
#pragma unroll
        for (int e = 0; e < 8; ++e) { s += y[e]; const float kaa = k_a[c0 + e]; bon += r[e] * k[e] * r_k[c0 + e] * ((1.0f + (aa0[e] - 1.0f) * kaa) + (1.0f + (aa1[e] - 1.0f) * kaa)); }
        s += shfl_xor_(s, 1); s += shfl_xor_(s, 2); s += shfl_xor_(s, 4);
        bon += shfl_xor_(bon, 1); bon += shfl_xor_(bon, 2); bon += shfl_xor_(bon, 4);
        const float mu = s * (1.0f / 64.0f); float q2 = 0.f;
#pragma unroll
        for (int e = 0; e < 8; ++e) { const float d_ = y[e] - mu; q2 += d_ * d_; }
        q2 += shfl_xor_(q2, 1); q2 += shfl_xor_(q2, 2); q2 += shfl_xor_(q2, 4);
        const float rstd = 1.0f / sqrtf(q2 * (1.0f / 64.0f) + 64e-5f);
        float o[8];
#pragma unroll
        for (int e = 0; e < 8; ++e) o[e] = (((y[e] - mu) * rstd) * ln_w[c0 + e] + ln_b[c0 + e] + bon * v[e]) * g[e];
        v4u w; w.x = pk2(o[0], o[1]); w.y = pk2(o[2], o[3]); w.z = pk2(o[4], o[5]); w.w = pk2(o[6], o[7]);
        *(v4u*)(YC + (size_t)t * 512 + c0) = w;
    }
}

__device__ __forceinline__ void phase_attn(const Frame& F, const Args& a) {
    const bf16* QA = (const bf16*)(F.ws + WS_AR + AR_QA); const bf16* KA = (const bf16*)(F.ws + WS_AR + AR_KA); const bf16* VTA = (const bf16*)(F.ws + WS_AR + AR_VTA);
    bf16* OA = (bf16*)(F.ws + WS_AR + AR_OA); float* LSE = (float*)(F.ws + WS_AR + AR_LSE);
    constexpr int PLD = 336;
    LAS unsigned char* Pw = F.lds + RING_OFF + F.wave * (32 * PLD);
    const int lane = F.lane, li = lane & 31, hh = lane >> 5;
    for (int w = F.gw; w < 15360; w += F.NGW) {
        const int h = w & 3, pq = (w >> 2) & 127, rest = w >> 9, seq = rest % 10, g = rest / 10;
        const int d = (g == 0) ? 1 : (g == 1 ? 4 : 16), Lg = SEQ / d, nqb = Lg / 32, p = pq / nqb, qb = pq % nqb;
        const size_t base = (size_t)seq * SEQ + (size_t)p * Lg;
        const float slope = __builtin_amdgcn_exp2f(-8.0f * (float)(g * 4 + h + 1) / 12.0f) * (float)d;
        const bf16* Qg = QA + (size_t)g * T * 512; const bf16* Kg = KA + (size_t)g * T * 512; const bf16* Vg = VTA + (size_t)g * 512 * T;
        f32x16 x[5]; bool tv[5]; int sc_[5];
#pragma unroll
        for (int kt = 0; kt < 5; ++kt) { const int s_t = 32 * qb - 64 + 32 * kt; tv[kt] = (s_t >= 0) && (s_t < Lg); sc_[kt] = tv[kt] ? s_t : 32 * qb;
#pragma unroll
            for (int e = 0; e < 16; ++e) x[kt][e] = 0.f; }
        { bf16x8 ka[8], kb[8];
          { bf16x8 qf[8];
#pragma unroll
            for (int ks = 0; ks < 8; ++ks) qf[ks] = *(const bf16x8*)(Qg + ((((base + 32 * qb) >> 5) * 4 + h) * 8 + ks) * 512 + lane * 8);
#pragma unroll
            for (int ks = 0; ks < 8; ++ks) *(LAS bf16x8*)(Pw + li * PLD + (16 * ks + 8 * hh) * 2) = qf[ks]; }
#pragma unroll
          for (int ks = 0; ks < 8; ++ks) { ka[ks] = *(const bf16x8*)(Kg + ((((base + sc_[0]) >> 5) * 4 + h) * 8 + ks) * 512 + lane * 8); kb[ks] = *(const bf16x8*)(Kg + ((((base + sc_[1]) >> 5) * 4 + h) * 8 + ks) * 512 + lane * 8); }
          asm volatile("" ::: "memory");
          LDS_WAIT(); asm volatile("" ::: "memory");
#pragma unroll
          for (int ks = 0; ks < 8; ++ks) { const bf16x8 q = *(const LAS bf16x8*)(Pw + li * PLD + (16 * ks + 8 * hh) * 2); x[0] = MFMA32(ka[ks], q, x[0]); x[1] = MFMA32(kb[ks], q, x[1]); }
#pragma unroll
          for (int ks = 0; ks < 8; ++ks) { ka[ks] = *(const bf16x8*)(Kg + ((((base + sc_[2]) >> 5) * 4 + h) * 8 + ks) * 512 + lane * 8); kb[ks] = *(const bf16x8*)(Kg + ((((base + sc_[3]) >> 5) * 4 + h) * 8 + ks) * 512 + lane * 8); }
          asm volatile("" ::: "memory");
#pragma unroll
          for (int ks = 0; ks < 8; ++ks) { const bf16x8 q = *(const LAS bf16x8*)(Pw + li * PLD + (16 * ks + 8 * hh) * 2); x[2] = MFMA32(ka[ks], q, x[2]); x[3] = MFMA32(kb[ks], q, x[3]); }
#pragma unroll
          for (int ks = 0; ks < 8; ++ks) ka[ks] = *(const bf16x8*)(Kg + ((((base + sc_[4]) >> 5) * 4 + h) * 8 + ks) * 512 + lane * 8);
          asm volatile("" ::: "memory");
#pragma unroll
          for (int ks = 0; ks < 8; ++ks) { const bf16x8 q = *(const LAS bf16x8*)(Pw + li * PLD + (16 * ks + 8 * hh) * 2); x[4] = MFMA32(ka[ks], q, x[4]); }
          LDS_WAIT(); asm volatile("" ::: "memory");
        }
        float mx = -1e30f;
#pragma unroll
        for (int kt = 0; kt < 5; ++kt)
#pragma unroll
            for (int e = 0; e < 16; ++e) { const int j = (e & 3) + 8 * (e >> 2) + 4 * hh; const int rel = 32 * kt - 64 + j - li; const int ar = rel < 0 ? -rel : rel;
                const bool ok = tv[kt] && ar <= 64; const float sv = ok ? (x[kt][e] - slope * (float)ar) : -1e30f; x[kt][e] = sv; mx = fmaxf(mx, sv); }
        mx = fmaxf(mx, shfl_xor_(mx, 32));
        float sum = 0.f;
#pragma unroll
        for (int kt = 0; kt < 5; ++kt)
#pragma unroll
            for (int e = 0; e < 16; ++e) { const float pv = (x[kt][e] > -1e29f) ? fexp(x[kt][e] - mx) : 0.f; x[kt][e] = pv; sum += pv; }
        sum += shfl_xor_(sum, 32);
        const float inv = 1.0f / sum;
        if (hh == 0) { const size_t tok = (size_t)seq * SEQ + (size_t)(32 * qb + li) * d + p; LSE[((size_t)g * T + tok) * 4 + h] = mx + __builtin_amdgcn_logf(sum) * 0.69314718056f; }
#pragma unroll
        for (int kt = 0; kt < 5; ++kt)
#pragma unroll
            for (int q4 = 0; q4 < 4; ++q4) { v2u pw; pw.x = cvt_pk_bf16(x[kt][4 * q4] * inv, x[kt][4 * q4 + 1] * inv); pw.y = cvt_pk_bf16(x[kt][4 * q4 + 2] * inv, x[kt][4 * q4 + 3] * inv);
                *(LAS v2u*)(Pw + li * PLD + (kt * 32 + 8 * q4 + 4 * hh) * 2) = pw; }
        LDS_WAIT(); asm volatile("" ::: "memory");
#pragma unroll
        for (int dt = 0; dt < 4; ++dt) {
            bf16x8 vf[5][2];
#pragma unroll
            for (int kt = 0; kt < 5; ++kt)
#pragma unroll
                for (int k2 = 0; k2 < 2; ++k2) vf[kt][k2] = *(const bf16x8*)(Vg + ((((size_t)(h * 4 + dt) * (T / 32) + ((base + sc_[kt]) >> 5)) * 2 + k2) * 512 + lane * 8));
            asm volatile("" ::: "memory");
            f32x16 o;
#pragma unroll
            for (int e = 0; e < 16; ++e) o[e] = 0.f;
#pragma unroll
            for (int kt = 0; kt < 5; ++kt)
#pragma unroll
                for (int k2 = 0; k2 < 2; ++k2) { const bf16x8 pf = *(const LAS bf16x8*)(Pw + li * PLD + (kt * 32 + 16 * k2 + 8 * hh) * 2); o = MFMA32(pf, vf[kt][k2], o); }
#pragma unroll
            for (int e = 0; e < 16; ++e) { const int i = (e & 3) + 8 * (e >> 2) + 4 * hh; const size_t tok = (size_t)seq * SEQ + (size_t)(32 * qb + i) * d + p;
                OA[((size_t)g * T + tok) * 512 + h * 128 + dt * 32 + li] = (bf16)f2bf(o[e]); }
        }
        LDS_WAIT(); asm volatile("" ::: "memory");
    }
}
__device__ __forceinline__ void phase_attn_post(const Frame& F, const Args& a) {
    const bf16* OA = (const bf16*)(F.ws + WS_AR + AR_OA); const float* LSE = (const float*)(F.ws + WS_AR + AR_LSE); bf16* YA = (bf16*)(F.ws + WS_AR + AR_YA);
    const int lane = F.lane, c0 = 8 * lane, h = lane >> 4;
    for (int t = F.gw; t < T; t += F.NGW) {
        const float l0 = LSE[((size_t)0 * T + t) * 4 + h], l1 = LSE[((size_t)1 * T + t) * 4 + h], l2 = LSE[((size_t)2 * T + t) * 4 + h];
        const float m = fmaxf(l0, fmaxf(l1, l2)); float w0 = fexp(l0 - m), w1 = fexp(l1 - m), w2 = fexp(l2 - m); const float inv = 1.0f / (w0 + w1 + w2); w0 *= inv; w1 *= inv; w2 *= inv;
        const v4u o0 = *(const v4u*)(OA + ((size_t)0 * T + t) * 512 + c0), o1 = *(const v4u*)(OA + ((size_t)1 * T + t) * 512 + c0), o2 = *(const v4u*)(OA + ((size_t)2 * T + t) * 512 + c0);
        v4u w;
#pragma unroll
        for (int q = 0; q < 4; ++q) w[q] = pk2(w0 * bf_lo(o0[q]) + w1 * bf_lo(o1[q]) + w2 * bf_lo(o2[q]), w0 * bf_hi(o0[q]) + w1 * bf_hi(o1[q]) + w2 * bf_hi(o2[q]));
        *(v4u*)(YA + (size_t)t * 512 + c0) = w;
    }
}

__device__ __forceinline__ void phase_ret_kv(const Frame& F) {
    const bf16* RKT = (const bf16*)(F.ws + WS_AR + AR_RKT); const bf16* RVT = (const bf16*)(F.ws + WS_AR + AR_RVT); bf16* SB = (bf16*)(F.ws + WS_AR + AR_SB);
    const int lane = F.lane, li = lane & 31, hh = lane >> 5, w = F.wave;
    for (int it = F.bid; it < 1280; it += F.G) {
        const int n = it & 31, h = (it >> 5) & 3, seq = it >> 7; const size_t tok0 = (size_t)seq * SEQ + 128 * n;
        const bf16* vrow = RVT + (size_t)(h * 256 + 32 * w + li) * T + tok0 + 8 * hh;
        bf16x8 vf[8];
#pragma unroll
        for (int ks = 0; ks < 8; ++ks) vf[ks] = *(const bf16x8*)(vrow + 16 * ks);
        bf16* sbase = SB + ((size_t)((seq * 4 + h) * 32 + n) * 256 + 32 * w) * 256;
#pragma unroll 1
        for (int t4 = 0; t4 < 4; ++t4) {
            const int z = t4 >> 1, dk0 = 2 * (t4 & 1);
            const bf16* krow = RKT + (size_t)(z * 512 + h * 128 + 32 * dk0 + li) * T + tok0 + 8 * hh;
            bf16x8 kfa[8], kfb[8];
#pragma unroll
            for (int ks = 0; ks < 8; ++ks) { kfa[ks] = *(const bf16x8*)(krow + 16 * ks); kfb[ks] = *(const bf16x8*)(krow + (size_t)32 * T + 16 * ks); }
            asm volatile("" ::: "memory");
            f32x16 acc0, acc1;
#pragma unroll
            for (int e = 0; e < 16; ++e) { acc0[e] = 0.f; acc1[e] = 0.f; }
#pragma unroll
            for (int ks = 0; ks < 8; ++ks) { acc0 = MFMA32(vf[ks], kfa[ks], acc0); acc1 = MFMA32(vf[ks], kfb[ks], acc1); }
#pragma unroll
            for (int e = 0; e < 16; ++e) { const int dv = (e & 3) + 8 * (e >> 2) + 4 * hh; sbase[(size_t)dv * 256 + z * 128 + 32 * dk0 + li] = (bf16)f2bf(acc0[e]); sbase[(size_t)dv * 256 + z * 128 + 32 * dk0 + 32 + li] = (bf16)f2bf(acc1[e]); }
        }
    }
}
__device__ __forceinline__ void phase_ret_prefix(const Frame& F, const Args& a, int l) {
    bf16* SB = (bf16*)(F.ws + WS_AR + AR_SB); const float* dlog = a.in[F.z + 8] + (size_t)l * 8;
    const int gt = F.bid * NTHR + F.tid, NGT = F.G * NTHR;
    for (int i = gt; i < 40 * 8192; i += NGT) {
        const int p = i >> 13, v = i & 8191, h = p & 3, z = (v >> 4) & 1;
        const float lg = dlog[z * 4 + h]; const float g = __builtin_amdgcn_exp2f(-__builtin_amdgcn_logf(1.0f + fexp(-lg)) * 128.0f);
        bf16* base = SB + (size_t)p * 32 * 65536 + (size_t)v * 8;
        float carry[8];
#pragma unroll
        for (int e = 0; e < 8; ++e) carry[e] = 0.f;
#pragma unroll 4
        for (int st = 0; st < 32; ++st) {
            const int n = z ? (31 - st) : st; v4u* ptr = (v4u*)(base + (size_t)n * 65536);
            const v4u kv = *ptr; v4u o;
#pragma unroll
            for (int q = 0; q < 4; ++q) { o[q] = pk2(carry[2 * q], carry[2 * q + 1]); carry[2 * q] = g * carry[2 * q] + bf_lo(kv[q]); carry[2 * q + 1] = g * carry[2 * q + 1] + bf_hi(kv[q]); }
            *ptr = o;
        }
    }
}
__device__ __forceinline__ void phase_ret_state(const Frame& F, const Args& a, int l) {
    const bf16* RKT = (const bf16*)(F.ws + WS_AR + AR_RKT); const bf16* RVT = (const bf16*)(F.ws + WS_AR + AR_RVT); bf16* SB = (bf16*)(F.ws + WS_AR + AR_SB);
    const float* dlog = a.in[F.z + 8] + (size_t)l * 8;
    const int lane = F.lane, li = lane & 31, hh = lane >> 5;
    if (F.wave >= 5) return;
    for (int q = F.bid * 5 + F.wave; q < 1280; q += F.G * 5) {
        const int kh = q & 1, dt = (q >> 1) & 7, z = (q >> 4) & 1, h = (q >> 5) & 3, seq = q >> 7;
        const float g = __builtin_amdgcn_exp2f(-__builtin_amdgcn_logf(1.0f + fexp(-dlog[z * 4 + h])) * 128.0f);
        const bf16* krow = RKT + ((size_t)((z * 4 + h) * 4 + 2 * kh) * (T / 16) + seq * (SEQ / 16)) * 512 + lane * 8;
        const bf16* vrow = RVT + ((size_t)(h * 8 + dt) * (T / 16) + seq * (SEQ / 16)) * 512 + lane * 8;
        bf16* srow = SB + ((((size_t)((seq * 4 + h) * 32) * 8 + dt) * 2 + z) * 8 + 4 * kh) * 512 + lane * 8;
        f32x16 acc0, acc1;
#pragma unroll
        for (int e = 0; e < 16; ++e) { acc0[e] = 0.f; acc1[e] = 0.f; }
        bf16x8 vf[8], kfa[8], kfb[8];
        { const int n0 = z ? 31 : 0;
#pragma unroll
          for (int ks = 0; ks < 8; ++ks) { vf[ks] = *(const bf16x8*)(vrow + 4096 * n0 + 512 * ks); kfa[ks] = *(const bf16x8*)(krow + 4096 * n0 + 512 * ks); kfb[ks] = *(const bf16x8*)(krow + (size_t)(T / 16) * 512 + 4096 * n0 + 512 * ks); } }
#pragma unroll 1
        for (int st = 0; st < 32; ++st) {
            const int n = z ? (31 - st) : st; const int st1 = st < 31 ? st + 1 : 31, nn = z ? (31 - st1) : st1;
            bf16* sp = srow + (size_t)n * 65536;
            *(v4u*)sp = pk8(acc0, 0); *(v4u*)(sp + 512) = pk8(acc0, 8); *(v4u*)(sp + 1024) = pk8(acc1, 0); *(v4u*)(sp + 1536) = pk8(acc1, 8);
#pragma unroll
            for (int e = 0; e < 16; ++e) { acc0[e] *= g; acc1[e] *= g; }
#pragma unroll
            for (int ks = 0; ks < 8; ++ks) acc0 = MFMA32(kfa[ks], vf[ks], acc0);
#pragma unroll
            for (int ks = 0; ks < 8; ++ks) kfa[ks] = *(const bf16x8*)(krow + 4096 * nn + 512 * ks);
#pragma unroll
            for (int ks = 0; ks < 8; ++ks) acc1 = MFMA32(kfb[ks], vf[ks], acc1);
#pragma unroll
            for (int ks = 0; ks < 8; ++ks) { kfb[ks] = *(const bf16x8*)(krow + (size_t)(T / 16) * 512 + 4096 * nn + 512 * ks); vf[ks] = *(const bf16x8*)(vrow + 4096 * nn + 512 * ks); }
        }
    }
}
__device__ __forceinline__ void phase_ret_out(const Frame& F, const Args& a, int l) {
    const bf16* RQ = (const bf16*)(F.ws + WS_AR + AR_RQ); const bf16* RKm = (const bf16*)(F.ws + WS_AR + AR_RK); const bf16* RVT = (const bf16*)(F.ws + WS_AR + AR_RVT);
    const bf16* RG = (const bf16*)(F.ws + WS_AR + AR_RG); const bf16* SB = (const bf16*)(F.ws + WS_AR + AR_SB); bf16* YB = (bf16*)(F.ws + WS_AR + AR_YB);
    const float* dlog = a.in[F.z + 8] + (size_t)l * 8; const float* rn = a.in[F.z + 9] + (size_t)l * 1024;
    constexpr int PLD = 272;
    LAS unsigned char* Pl = F.lds + RING_OFF;
    LAS f32x2* SX = (LAS f32x2*)(F.lds + RING_OFF + 4 * 32 * PLD);
    const int lane = F.lane, li = lane & 31, hh = lane >> 5, w = F.wave, qi = w & 3, dj = w >> 2;
    LAS unsigned char* stg = F.lds + RING_OFF + 40960 + w * (32 * PLD);
    for (int it = F.bid; it < 1280; it += F.G) {
        const int n = it & 31, h = (it >> 5) & 3, seq = it >> 7; const size_t tok0 = (size_t)seq * SEQ + 128 * n;
        const float l2g0 = -__builtin_amdgcn_logf(1.0f + fexp(-dlog[h])), l2g1 = -__builtin_amdgcn_logf(1.0f + fexp(-dlog[4 + h]));
        __syncthreads();
        const bf16* qrow = RQ + ((size_t)(((tok0 + 32 * qi) >> 5) * 4 + h) * 8) * 512 + lane * 8;
        bf16x8 qf[8];
#pragma unroll
        for (int ks = 0; ks < 8; ++ks) qf[ks] = *(const bf16x8*)(qrow + 512 * ks);
        const int ip = 32 * qi + li;
#pragma unroll 1
        for (int k2 = 0; k2 < 2; ++k2) {
            const int kt = 2 * dj + k2;
            const bf16* krow_ = RKm + ((size_t)(((tok0 + 32 * kt) >> 5) * 4 + h) * 8) * 512 + lane * 8;
            f32x16 x;
#pragma unroll
            for (int e = 0; e < 16; ++e) x[e] = 0.f;
#pragma unroll
            for (int ks = 0; ks < 8; ++ks) { const bf16x8 kf = *(const bf16x8*)(krow_ + 512 * ks); x = MFMA32(kf, qf[ks], x); }
#pragma unroll
            for (int q4 = 0; q4 < 4; ++q4) {
                float pv[4];
#pragma unroll
                for (int e = 0; e < 4; ++e) { const int jp = 32 * kt + e + 8 * q4 + 4 * hh; const int df = ip - jp;
                    const float f0 = (df >= 0) ? __builtin_amdgcn_exp2f(l2g0 * (float)df) : 0.f, f1 = (df <= 0) ? __builtin_amdgcn_exp2f(l2g1 * (float)(-df)) : 0.f;
                    pv[e] = x[4 * q4 + e] * (f0 + f1); }
                v2u pw; pw.x = cvt_pk_bf16(pv[0], pv[1]); pw.y = cvt_pk_bf16(pv[2], pv[3]);
                *(LAS v2u*)(Pl + (qi * 32 + li) * PLD + (kt * 32 + 8 * q4 + 4 * hh) * 2) = pw;
            }
        }
        LDS_WAIT(); __syncthreads();
        const float e0 = l2g0 * (float)(ip + 1), e1 = l2g1 * (float)(128 - ip);
        const float ratio = __builtin_amdgcn_exp2f(e0 - e1), xi1 = __builtin_amdgcn_exp2f(e1);
        f32x16 o[4]; float s1 = 0.f, s2 = 0.f;
#pragma unroll
        for (int dt = 0; dt < 4; ++dt) {
            const int dvr = 128 * dj + 32 * dt + li;
            const bf16* srow = SB + (((size_t)((seq * 4 + h) * 32 + n) * 8 + 4 * dj + dt) * 2) * 8 * 512 + lane * 8;
            const bf16* vrow = RVT + ((size_t)(h * 8 + 4 * dj + dt) * (T / 16) + (tok0 >> 4)) * 512 + lane * 8;
            f32x16 acc;
#pragma unroll
            for (int e = 0; e < 16; ++e) acc[e] = 0.f;
            bf16x8 s0f[8], s1f[8], vff[8];
#pragma unroll
            for (int ks = 0; ks < 8; ++ks) { s0f[ks] = *(const bf16x8*)(srow + 512 * ks); s1f[ks] = *(const bf16x8*)(srow + 4096 + 512 * ks); vff[ks] = *(const bf16x8*)(vrow + 512 * ks); }
            asm volatile("" ::: "memory");
#pragma unroll
            for (int ks = 0; ks < 8; ++ks) acc = MFMA32(s0f[ks], qf[ks], acc);
#pragma unroll
            for (int e = 0; e < 16; ++e) acc[e] *= ratio;
#pragma unroll
            for (int ks = 0; ks < 8; ++ks) acc = MFMA32(s1f[ks], qf[ks], acc);
#pragma unroll
            for (int e = 0; e < 16; ++e) acc[e] *= xi1;
#pragma unroll
            for (int ks = 0; ks < 8; ++ks) { const bf16x8 pf = *(const LAS bf16x8*)(Pl + (qi * 32 + li) * PLD + (16 * ks + 8 * hh) * 2); acc = MFMA32(vff[ks], pf, acc); }
#pragma unroll
            for (int e = 0; e < 16; ++e) { s1 += acc[e]; s2 += acc[e] * acc[e]; }
            o[dt] = acc;
        }
        s1 += shfl_xor_(s1, 32); s2 += shfl_xor_(s2, 32);
        if (hh == 0) SX[(dj * 4 + qi) * 32 + li] = (f32x2){s1, s2};
        LDS_WAIT(); __syncthreads();
        { const f32x2 ot = SX[((dj ^ 1) * 4 + qi) * 32 + li]; s1 += ot.x; s2 += ot.y; }
        const float mu = s1 * (1.0f / 256.0f); const float var = fmaxf(s2 * (1.0f / 256.0f) - mu * mu, 0.f); const float rstd = 1.0f / sqrtf(var + 1e-5f);
#pragma unroll
        for (int dt = 0; dt < 4; ++dt)
#pragma unroll
            for (int q4 = 0; q4 < 4; ++q4) { v2u pw; pw.x = cvt_pk_bf16((o[dt][4 * q4] - mu) * rstd, (o[dt][4 * q4 + 1] - mu) * rstd); pw.y = cvt_pk_bf16((o[dt][4 * q4 + 2] - mu) * rstd, (o[dt][4 * q4 + 3] - mu) * rstd);
                *(LAS v2u*)(stg + li * PLD + (32 * dt + 8 * q4 + 4 * hh) * 2) = pw; }
        LDS_WAIT(); asm volatile("" ::: "memory");
#pragma unroll
        for (int j = 0; j < 8; ++j) {
            const int idx = lane + 64 * j, q = idx >> 4, cv = idx & 15, col = h * 256 + 128 * dj + 8 * cv;
            const v4u ov = *(const LAS v4u*)(stg + q * PLD + cv * 16);
            const size_t tok = tok0 + 32 * qi + q;
            const v4u gv = *(const v4u*)(RG + tok * 1024 + col);
            const f32x4 r0 = *(const f32x4*)(rn + col), r1 = *(const f32x4*)(rn + col + 4);
            const float rr[8] = {r0.x, r0.y, r0.z, r0.w, r1.x, r1.y, r1.z, r1.w};
            v4u wv;
#pragma unroll
            for (int q2 = 0; q2 < 4; ++q2) { const float ga = bf_lo(gv[q2]), gb = bf_hi(gv[q2]);
                wv[q2] = pk2(ga * fsigmoid(ga) * bf_lo(ov[q2]) * rr[2 * q2], gb * fsigmoid(gb) * bf_hi(ov[q2]) * rr[2 * q2 + 1]); }
            *(v4u*)(YB + tok * 1024 + col) = wv;
        }
    }
    __syncthreads();
}
__device__ __forceinline__ void phase_zero(const Frame& F, void* p, size_t bytes) {
    v4u* q = (v4u*)p; const v4u z = {0u, 0u, 0u, 0u};
    for (size_t i = (size_t)F.bid * NTHR + F.tid; i < bytes / 16; i += (size_t)F.G * NTHR) q[i] = z;
}

__global__ void __launch_bounds__(NTHR, 2) mk_fwd(Args args) {
    extern __shared__ __attribute__((aligned(16))) unsigned char lds[];
    {
        const int t0 = threadIdx.x;
        for (int u = t0; u < (LDS_BYTES - LDSCTL_OFF) / 4; u += NTHR) ((LAS unsigned*)((LAS unsigned char*)lds + LDSCTL_OFF))[u] = 0u;
        __syncthreads();
    }
    XcdBarrier bar; bar.bar = (unsigned*)(args.ws + WS_CTL) + CW_BAR; bar.x = 0; bar.st = nullptr;
#if !MK_PER_PHASE_LAUNCH
    bar = xcd_barrier_post((unsigned*)(args.ws + WS_CTL) + CW_BAR, (volatile LAS unsigned*)((LAS unsigned char*)lds + MISC_OFF) + 8);
#endif
    const int wave_s = __builtin_amdgcn_readfirstlane((int)(threadIdx.x >> 6));
    const int lo = args.ph_lo, hi = args.ph_hi;
    int pc = 0;
#define PH_ON (pc >= lo && pc < hi)
#if MK_PER_PHASE_LAUNCH
#define PH_END do { ++pc; } while (0)
#else
#ifdef MK_NOBAR
#define PH_END do { __syncthreads(); ++pc; } while (0)
#else
#define PH_END do { if (pc >= lo && pc + 1 < hi) xcd_barrier(bar, wave_s == 0 && lane_id() == 0); ++pc; } while (0)
#endif
#endif
#define PH_REP(k) _Pragma("nounroll") for (int rep_ = 0; rep_ < (((MK_REPMASK) >> (k)) & 1) + 1; ++rep_)
#define PH_REPBAR(k) if ((((MK_REPMASK) >> (k)) & 1) && rep_ == 0) xcd_barrier(bar, wave_s == 0 && lane_id() == 0)
#define WTH wt
#define PH_FRAME Frame F; int z_; asm volatile("s_mov_b32 %0, 0" : "=s"(z_)); { int t_ = wave_s * 64 + lane_id(); asm volatile("" : "+v"(t_)); unsigned char* w_ = (unsigned char*)(GAS unsigned char*)ld_karg64(248); F.lds = (LAS unsigned char*)lds; F.ws = w_; F.z = z_; F.tid = t_; F.lane = t_ & 63; \
        F.wave = __builtin_amdgcn_readfirstlane(t_ >> 6); { int g_ = __builtin_amdgcn_readfirstlane((int)gridDim.x), b_ = __builtin_amdgcn_readfirstlane((int)blockIdx.x), g2_, b2_; asm volatile("s_mov_b32 %0, %2\n\ts_mov_b32 %1, %3" : "=&s"(g2_), "=&s"(b2_) : "s"(g_), "s"(b_)); F.G = g2_; F.bid = b2_; } F.gw = F.bid * NWAVES + F.wave; F.NGW = F.G * NWAVES; } \
        unsigned char* const wt = F.ws + WS_WT; unsigned char* const ar = F.ws + WS_AR; bf16* const XN = (bf16*)(F.ws + WS_XN); LAS unsigned char* const ring = F.lds + RING_OFF; \
        bf16* X = (bf16*)((GAS unsigned char*)ld_karg64(240) + XB_OFF); const int c = F.bid; (void)wt; (void)ar; (void)XN; (void)ring; (void)c;

#pragma nounroll
    for (int l = 0; l < DEPTH; ++l) {
        const bool ovl = gridDim.x > 160;
        if (l == 0 || !ovl) {
            if (PH_ON) { PH_FRAME; phase_wconv(F, args, l, wt, wt, ovl ? 1 : 3);
                if (l == 0) phase_norm_in(F, args.in[z_ + 0], args.in[z_ + 1], args.in[z_ + 2], XN, X); }
            PH_END;
        }
#pragma nounroll
        for (int f = 0; f < 2; ++f) {
            if (!(l == 0 && f == 0)) {
                if (PH_ON) { PH_FRAME; phase_norm(F, X, args.in[z_ + (f ? 25 : 2)] + (size_t)l * D, XN); }
                PH_END;
            }
#pragma nounroll
            for (int ck = 0; ck < FFN_NCK; ++ck) {
                const int r0 = ck * FFN_MC, mc = (T - r0 < FFN_MC) ? (T - r0) : FFN_MC;
                PH_REP(0) { if (PH_ON) { PH_FRAME;
                    SchedPlain S{(const char*)(XN + (size_t)r0 * D), (const char*)(f ? WTH + WO_UP2 : wt + WO_UP1), D, D, D, mc / 256, 44, F.G, c, 8};
                    EpiSwiglu E{(bf16*)(ar + AR_H)};
                    pg8::gemm_phase<EpiSwiglu, SchedPlain>(ring, S, E, F.tid);
                } PH_REPBAR(0); }
                PH_END;
                if (PH_ON) { PH_FRAME;
                    SchedPlain S{(const char*)(ar + AR_H), (const char*)(f ? WTH + WO_DN2 : wt + WO_DN1), FF, FF, FF, mc / 256, 8, F.G, c, MK_WGM_DN};
                    { const bool lastf = (l == DEPTH - 1 && f == 1);
                        EpiResid E{(lastf ? (bf16*)(ar + AR_XF) : X) + (size_t)r0 * D, X + (size_t)r0 * D, 0.5f};
                    pg8::gemm_phase<EpiResid, SchedPlain>(ring, S, E, F.tid); }
                }
                PH_END;
            }
            if (f == 0) {
                if (PH_ON) { PH_FRAME; phase_norm(F, X, args.in[z_ + 6] + (size_t)l * D, XN); }
                PH_END;
#if (MK_MIXER & 1)
                PH_REP(1) { if (PH_ON) { PH_FRAME;
                    SchedCF S{SchedPlain{(const char*)XN, (const char*)(WTH + WO_CF), D, D, D, 160, 8, F.G, c, 8}, (char*)(ar + AR_CF)};
                    EpiStore<1> E{nullptr, nullptr, nullptr};
                    pg8::gemm_phase<EpiStore<1>, SchedCF>(ring, S, E, F.tid);
                } PH_REPBAR(1); }
                PH_END;
                if (PH_ON) { PH_FRAME; phase_rwkv_pre(F, args, l); }
                PH_END;
                if (PH_ON) { PH_FRAME;
                    SchedLR S{SchedPlain{(const char*)(ar + AR_LR), (const char*)(WTH + WO_LR), 384, 384, 384, 160, 10, F.G, c, 8}, (char*)(ar + AR_EA), (char*)(ar + AR_GT)};
                    EpiStore<0x70> E{args.in[z_ + 11] + (size_t)l * 1024, args.in[z_ + 13] + (size_t)l * 1024, nullptr};
                    pg8::gemm_phase<EpiStore<0x70>, SchedLR>(ring, S, E, F.tid);
                }
                PH_END;
#if MK_CHUNKED && MK_FUSED_RWKV
                if (PH_ON) { PH_FRAME; phase_rwkv_fused(F, args, l);
                    if (F.bid >= 160) {
                        Frame F2 = F; F2.bid = F.bid - 160; F2.G = F.G - 160; F2.gw = F2.bid * NWAVES + F.wave; F2.NGW = F2.G * NWAVES;
                        phase_wconv(F2, args, l, wt, wt, 2);
                        if (l + 1 < DEPTH) phase_wconv(F2, args, l + 1, wt, wt, 1); } }
                PH_END;
#elif MK_CHUNKED
#pragma nounroll
                for (int seg = 0; seg < RW_NSEG; ++seg) {
                    if (PH_ON) { PH_FRAME; phase_rwkv_prep(F, args, l, seg); }
                    PH_END;
                    if (PH_ON) { PH_FRAME; phase_rwkv_cscan(F, seg); }
                    PH_END;
                }
#else
                if (PH_ON) { PH_FRAME; phase_rwkv_scan(F, args, l); }
                PH_END;
#endif
                if (PH_ON) { PH_FRAME; phase_rwkv_post(F, args, l); }
                PH_END;
#else
                if (PH_ON) { PH_FRAME; phase_zero(F, ar + AR_YC, (size_t)T * 512 * 2); }
                PH_END;
#endif
#if (MK_MIXER & 2)
                PH_REP(2) { if (PH_ON) { PH_FRAME;
                    SchedAtt S{(const char*)XN, (const char*)WTH, (char*)ar, F.G, c};
                    EpiStore<0x384> E{nullptr, nullptr, args.in[z_ + 8] + (size_t)l * 8};
                    pg8::gemm_phase<EpiStore<0x384>, SchedAtt>(ring, S, E, F.tid);
                } PH_REPBAR(2); }
                PH_END;
                if (PH_ON) { PH_FRAME; phase_attn(F, args); }
                PH_END;
#if !(MK_MIXER & 4)
                if (PH_ON) { PH_FRAME; phase_attn_post(F, args); }
                PH_END;
#endif
#else
                if (PH_ON) { PH_FRAME; phase_zero(F, ar + AR_YA, (size_t)T * 512 * 2); }
                PH_END;
#endif
#if (MK_MIXER & 4)
                PH_REP(3) { if (PH_ON) { PH_FRAME;
#if (MK_MIXER & 2)
                    if (rep_ == 0) phase_attn_post(F, args);
                    __syncthreads();
#endif
                    SchedRet S{(const char*)XN, (const char*)(WTH + WO_RET), (char*)ar, F.G, c};
                    EpiStore<0x401> E{nullptr, nullptr, nullptr};
                    pg8::gemm_phase<EpiStore<0x401>, SchedRet>(ring, S, E, F.tid);
                } PH_REPBAR(3); }
                PH_END;
                if (PH_ON) { PH_FRAME; phase_ret_state(F, args, l); }
                PH_END;
                if (PH_ON) { PH_FRAME; phase_ret_out(F, args, l); }
                PH_END;
#else
                if (PH_ON) { PH_FRAME; phase_zero(F, ar + AR_YB, (size_t)T * 1024 * 2); }
                PH_END;
#endif
                PH_REP(4) { if (PH_ON) { PH_FRAME;
                    SchedMerge S{(const char*)XN, (const char*)ar, (const char*)WTH, F.G, c};
                    v4u* scr = (v4u*)(ar + AR_SCR) + (size_t)F.bid * 2 * 16 * NTHR;
                    EpiMerge E{scr, scr + 16 * NTHR, (bf16*)(ar + AR_MG)};
                    pg8::gemm_phase<EpiMerge, SchedMerge>(ring, S, E, F.tid);
                } PH_REPBAR(4); }
                PH_END;
                if (PH_ON) { PH_FRAME;
                    SchedPlain S{(const char*)(ar + AR_MG), (const char*)(WTH + WO_OUT), D, D, D, 160, 8, F.G, c, 8};
                    { EpiResid E{X, X, 1.0f};
                    pg8::gemm_phase<EpiResid, SchedPlain>(ring, S, E, F.tid); }
                }
                PH_END;
            }
        }
    }
    if (PH_ON) { PH_FRAME; phase_final_norm(F, (const bf16*)(ar + AR_XF), args.in[z_ + 29], (float*)(GAS float*)ld_karg64(240)); }
    ++pc;
#undef PH_ON
#undef PH_END
#undef PH_FRAME
}

extern "C" void kernel_launch(void* const* d_in, const int* in_sizes, int n_in, void* d_out, int out_size, void* d_ws, size_t ws_size, hipStream_t stream) {
    static int grid = 0;
    if (grid == 0) {
        if (n_in != 30 || out_size != T * D || ws_size < WS_END) { fprintf(stderr, "kernel_launch: unexpected shapes (n_in %d, out %d, ws %zu < %zu); nothing launched\n", n_in, out_size, ws_size, (size_t)WS_END); grid = -1; return; }
        int dev = 0, cus = 0, per_cu = 0;
        if (hipGetDevice(&dev) != hipSuccess || hipDeviceGetAttribute(&cus, hipDeviceAttributeMultiprocessorCount, dev) != hipSuccess) { grid = -1; return; }
        if (hipFuncSetAttribute((const void*)mk_fwd, hipFuncAttributeMaxDynamicSharedMemorySize, LDS_BYTES) != hipSuccess) { fprintf(stderr, "kernel_launch: hipFuncSetAttribute failed\n"); grid = -1; return; }
        if (hipOccupancyMaxActiveBlocksPerMultiprocessor(&per_cu, (const void*)mk_fwd, NTHR, LDS_BYTES) != hipSuccess || per_cu < 1) { fprintf(stderr, "kernel_launch: occupancy query reports %d\n", per_cu); }
        (void)hipGetLastError();
        grid = cus;
#ifdef MK_GRID
        grid = MK_GRID;
#endif
    }
    if (grid < 0) return;
    hipMemsetAsync((char*)d_ws + WS_CTL, 0, CTL_ZERO_BYTES, stream);
    Args a{};
    for (int i = 0; i < 30; ++i) a.in[i] = (const float*)d_in[i];
    a.out = (float*)d_out; a.ws = (unsigned char*)d_ws;
#if MK_PER_PHASE_LAUNCH
#ifndef MK_NPH
#define MK_NPH 2
#endif
    for (int p = 0; p < MK_NPH; ++p) {    a.ph_lo = p; a.ph_hi = p + 1; hipLaunchKernelGGL(mk_fwd, dim3(grid), dim3(NTHR), LDS_BYTES, stream, a); }
#else
#ifdef MK_NPH1
    a.ph_lo = 0; a.ph_hi = MK_NPH1;
#else
    a.ph_lo = 0; a.ph_hi = 1 << 30;
#endif
    hipLaunchKernelGGL(mk_fwd, dim3(grid), dim3(NTHR), LDS_BYTES, stream, a);
#endif
}
```

```cpp
#include <hip/hip_runtime.h>
#include <cstdio>
#include <cstdint>

#ifndef MK_PER_PHASE_LAUNCH
#define MK_PER_PHASE_LAUNCH 0
#endif
#ifndef MK_REP_SCAN
#define MK_REP_SCAN 1
#endif
#ifndef MK_REP_ATT
#define MK_REP_ATT 1
#endif
#ifndef MK_REP_RET
#define MK_REP_RET 1
#endif
#ifndef MK_REP_EW
#define MK_REP_EW 1
#endif
#ifndef MK_REP_UP
#define MK_REP_UP 1
#endif
#ifndef MK_PROBE_RESID
#define MK_PROBE_RESID 0
#endif
#ifndef MK_REP_PROJ
#define MK_REP_PROJ 1
#endif
#ifndef MK_REP_MG
#define MK_REP_MG 1
#endif
#ifndef MK_REP_DN
#define MK_REP_DN 1
#endif
#ifndef MK_REP_OUT
#define MK_REP_OUT 1
#endif
#ifndef MK_REPMASK
#define MK_REPMASK 0
#endif
#ifndef MK_FUSED_RWKV
#define MK_FUSED_RWKV 1
#endif
#ifndef MK_WGM_DN
#define MK_WGM_DN 4
#endif
#ifndef MK_CHUNKED
#define MK_CHUNKED 1
#endif
#ifndef MK_MIXER
#define MK_MIXER 7
#endif

constexpr int T = 40960, D = 2048, FF = 5632, SEQ = 4096, NSEQ = 10, DEPTH = 2;
constexpr int NWAVES = 8, NTHR = 512;

#define GAS __attribute__((address_space(1)))
#define LAS __attribute__((address_space(3)))
typedef unsigned short bf16;
typedef unsigned v4u __attribute__((ext_vector_type(4)));
typedef unsigned v2u __attribute__((ext_vector_type(2)));
typedef float f32x4 __attribute__((ext_vector_type(4)));
typedef float f32x2 __attribute__((ext_vector_type(2)));
typedef float f32x16 __attribute__((ext_vector_type(16)));
typedef short bf16x8 __attribute__((ext_vector_type(8)));
typedef _Float16 h2 __attribute__((ext_vector_type(2)));
typedef GAS unsigned gu32;
#define RLX_AGENT __ATOMIC_RELAXED, __HIP_MEMORY_SCOPE_AGENT
#define LDS_WAIT() asm volatile("s_waitcnt lgkmcnt(0)" ::: "memory")
#define VM_WAIT() asm volatile("s_waitcnt vmcnt(0)" ::: "memory")
typedef __bf16 bf16v2_t __attribute__((ext_vector_type(2)));
__device__ __forceinline__ unsigned cvt_pk_bf16(float lo, float hi) { f32x2 v = {lo, hi}; bf16v2_t r = __builtin_convertvector(v, bf16v2_t); return __builtin_bit_cast(unsigned, r); }
__device__ __forceinline__ unsigned f2bf(float f) { return cvt_pk_bf16(f, f) & 0xffffu; }
__device__ __forceinline__ unsigned pk2(float lo, float hi) { return cvt_pk_bf16(lo, hi); }
__device__ __forceinline__ unsigned pkh2(float lo, float hi) { h2 v; v.x = (_Float16)lo; v.y = (_Float16)hi; return __builtin_bit_cast(unsigned, v); }
__device__ __forceinline__ float bf_lo(unsigned w) { return __builtin_bit_cast(float, w << 16); }
__device__ __forceinline__ float bf_hi(unsigned w) { return __builtin_bit_cast(float, w & 0xffff0000u); }
__device__ __forceinline__ float h_lo(unsigned w) { h2 v = __builtin_bit_cast(h2, w); return (float)v.x; }
__device__ __forceinline__ float h_hi(unsigned w) { h2 v = __builtin_bit_cast(h2, w); return (float)v.y; }
__device__ __forceinline__ float h1(unsigned short w) { return (float)__builtin_bit_cast(_Float16, w); }
__device__ __forceinline__ float fexp(float x) { return __builtin_amdgcn_exp2f(x * 1.44269504089f); }
__device__ __forceinline__ float fsigmoid(float x) { return __builtin_amdgcn_rcpf(1.0f + fexp(-x)); }
__device__ __forceinline__ unsigned long long opaque_u64(unsigned long long p) {
    const unsigned lo = __builtin_amdgcn_readfirstlane((unsigned)p), hi = __builtin_amdgcn_readfirstlane((unsigned)(p >> 32)); unsigned lo2, hi2;
    asm volatile("s_mov_b32 %0, %2\n\ts_mov_b32 %1, %3" : "=&s"(lo2), "=&s"(hi2) : "s"(lo), "s"(hi));
    return ((unsigned long long)hi2 << 32) | lo2;
}
__device__ __forceinline__ int lane_id() { int l; asm volatile("v_mbcnt_lo_u32_b32 %0, -1, 0\n\tv_mbcnt_hi_u32_b32 %0, -1, %0" : "=v"(l)); return l; }
__device__ __forceinline__ float shfl_xor_(float v, int m) { return __builtin_bit_cast(float, __builtin_amdgcn_ds_bpermute((lane_id() ^ m) << 2, __builtin_bit_cast(int, v))); }
__device__ __forceinline__ unsigned long long ld_karg64(int off) {
    unsigned long long r;
    asm volatile("s_load_dwordx2 %0, %1, %2\n\ts_waitcnt lgkmcnt(0)" : "=s"(r) : "s"(__builtin_amdgcn_kernarg_segment_ptr()), "n"(off) : "memory");
    return r;
}
__device__ __forceinline__ float wave_sum(float v) {
#pragma unroll
    for (int o = 1; o < 64; o <<= 1) v += shfl_xor_(v, o);
    return v;
}

#define XB_TMO      128
#define XB_XCNT(j)  (256  + 64 * (j))
#define XB_XSUB(j)  (1280 + 64 * (j))
#define XB_XGEN(j)  (2304 + 64 * (j))
#define XB_TOP      3328
#define XB_TOPGEN   3392
#define XCD_BAR_WORDS 3456
#define XB_SPIN_CAP (1u << 22)

__device__ __forceinline__ unsigned xb_ld(unsigned* p)              { return __hip_atomic_load(p, __ATOMIC_RELAXED, __HIP_MEMORY_SCOPE_AGENT); }
__device__ __forceinline__ unsigned xb_add(unsigned* p, unsigned v) { return __hip_atomic_fetch_add(p, v, __ATOMIC_RELAXED, __HIP_MEMORY_SCOPE_AGENT); }
__device__ __forceinline__ unsigned xb_xcc_id() { return (unsigned)__builtin_amdgcn_s_getreg((3 << 11) | 20) & 0xFu; }
#define XB_SPIN(cond, bar) do { unsigned _sp = 0; while (cond) { __builtin_amdgcn_s_sleep(1); \
    if ((++_sp & 255u) == 0u) { if (xb_ld(&(bar)[XB_TMO])) break; if (_sp > XB_SPIN_CAP) { atomicAdd(&(bar)[XB_TMO], 1u); break; } } } } while (0)

struct XcdBarrier { unsigned* bar; unsigned x; volatile LAS unsigned* st; };
__device__ __forceinline__ XcdBarrier xcd_barrier_post(unsigned* bar, volatile LAS unsigned* st) {
    XcdBarrier b; b.bar = bar; b.x = xb_xcc_id(); b.st = st;
    if (threadIdx.x == 0) (void)xb_add(&bar[XB_XCNT(b.x)], 1u);
    return b;
}
__device__ __forceinline__ void xcd_barrier_complete(unsigned* bar, unsigned x, unsigned& nloc, unsigned& nx) {
    const unsigned G = gridDim.x * gridDim.y * gridDim.z;
    unsigned sum, cnt, mine, sp = 0u;
    for (;;) {
        sum = 0u; cnt = 0u; mine = 0u;
#pragma unroll
        for (unsigned j = 0; j < 16; ++j) { const unsigned c = xb_ld(&bar[XB_XCNT(j)]); sum += c; cnt += (c > 0u) ? 1u : 0u; mine = (j == x) ? c : mine; }
        if (sum == G) break;
        __builtin_amdgcn_s_sleep(1);
        if ((++sp & 255u) == 0u) { if (xb_ld(&bar[XB_TMO])) break; if (sp > XB_SPIN_CAP) { atomicAdd(&bar[XB_TMO], 1u); break; } }
    }
    nloc = mine > 0u ? mine : 1u; nx = cnt > 0u ? cnt : 1u;
}
__device__ __forceinline__ void xcd_barrier(const XcdBarrier& b, bool thread0) {
    asm volatile("s_waitcnt vmcnt(0)" ::: "memory");
    __syncthreads();
    if (thread0) {
        unsigned* bar = (unsigned*)opaque_u64((unsigned long long)b.bar); const unsigned bx = xb_xcc_id();
        __builtin_amdgcn_s_waitcnt(0);
        unsigned nloc = b.st[0], nx = b.st[1];
        if (nloc == 0u) { xcd_barrier_complete(bar, bx, nloc, nx); b.st[0] = nloc; b.st[1] = nx; }
        const unsigned old = xb_add(&bar[XB_XSUB(bx)], 1u);
        const unsigned gen = old / nloc;
        if (old + 1u == (gen + 1u) * nloc) {
            __builtin_amdgcn_fence(__ATOMIC_RELEASE, "agent");
            asm volatile("s_waitcnt vmcnt(0)" ::: "memory");
            const unsigned og = xb_add(&bar[XB_TOP], 1u);
            const unsigned tg = og / nx;
            if (og + 1u == (tg + 1u) * nx) xb_add(&bar[XB_TOPGEN], 1u);
            else XB_SPIN(xb_ld(&bar[XB_TOPGEN]) == tg, bar);
            __builtin_amdgcn_fence(__ATOMIC_ACQUIRE, "agent");
            xb_add(&bar[XB_XGEN(bx)], 1u);
            asm volatile("s_waitcnt vmcnt(0)" ::: "memory");
        } else {
            XB_SPIN(xb_ld(&bar[XB_XGEN(bx)]) == gen, bar);
            __builtin_amdgcn_fence(__ATOMIC_ACQUIRE, "agent");
            asm volatile("s_waitcnt vmcnt(0)" ::: "memory");
        }
    }
    __syncthreads();
}

namespace pg8 {
#define PG8_LAS __attribute__((address_space(3)))
constexpr int BM = 256, BK = 64, HALF = 128, HTB = HALF * BK * 2, STAGE_BYTES = 8 * HTB;
__host__ __device__ __forceinline__ int lds_byte(int r, int c) { const int st = (r >> 4) * 2 + (c >> 5), rr = r & 15, cc = c & 31, ob = rr * 64 + cc * 2; return st * 1024 + (ob ^ (((ob >> 9) & 1) << 5)); }
__host__ __device__ __forceinline__ void stage_rc(int b, int& R, int& C) { const int st = b / 1024, sb = b % 1024, swz = sb ^ (((sb >> 9) & 1) << 5); R = (st >> 1) * 16 + swz / 64; C = (st & 1) * 32 + (swz % 64) / 2; }
__host__ __device__ __forceinline__ int perm32(int rho) { const int n = rho >> 4, i = rho & 15; return 8 * (i >> 2) + 4 * n + (i & 3); }

struct UnitG { const char* A; const char* B; int lda, ldb, K; char* O; int ldo, kind, x0, x1; };

__device__ __forceinline__ void tile_map(int L, int nM, int nN, int& pm, int& pn, int wgm = 8) {
    const int nwg = nM * nN; int wgid = L;
    { const int q = nwg / 8, r = nwg % 8, xcd = wgid % 8, off = wgid / 8; wgid = (xcd < r ? xcd * (q + 1) : r * (q + 1) + (xcd - r) * q) + off; }
    const int nig = wgm * nN, gid = wgid / nig, fm = gid * wgm, gsz = (nM - fm) < wgm ? (nM - fm) : wgm;
    pm = fm + ((wgid % nig) % gsz); pn = (wgid % nig) / gsz;
}

template <class Epi, class Sched>
__device__ __forceinline__ void gemm_phase(PG8_LAS unsigned char* lds, const Sched& S, const Epi& E, int tid_in) {
    int tid_ = tid_in; asm volatile("" : "+v"(tid_));
    const int tid = tid_, wid = __builtin_amdgcn_readfirstlane(tid >> 6), lane = tid & 63, wr = wid >> 2, wc = wid & 3, fr = lane & 15, fq = lane >> 4;
    int sR, sC; stage_rc(tid * 16, sR, sC);
    const int sRb = Epi::PERM ? ((sR & ~31) + perm32(sR & 31)) : sR;
    const size_t kstep = (size_t)(BK * 2);
    const unsigned ldsw = (unsigned)wid * 1024u;
    const int aoff = lds_byte(wr * 64 + fr, fq * 8), boff = lds_byte(wc * 32 + fr, fq * 8);
#define PG8_SA(b, h) (((b) * 2 + (h)) * HTB)
#define PG8_SB(b, h) ((4 + (b) * 2 + (h)) * HTB)
#define PG8_STAGE(bufoff, gbase, voff, q64) do { _Pragma("unroll") for (int _i = 0; _i < 2; ++_i) \
        __builtin_amdgcn_global_load_lds((const unsigned*)((const char*)(gbase) + (size_t)_i * (q64) + (voff)), (PG8_LAS unsigned*)(lds + (bufoff) + ldsw + _i * 8192), 16, 0, 0); } while (0)
#define PG8_LDA(dst, b, h) do { _Pragma("unroll") for (int m = 0; m < 4; ++m) _Pragma("unroll") for (int k = 0; k < 2; ++k) dst[m][k] = *(const PG8_LAS bf16x8*)(lds + PG8_SA(b, h) + aoff + m * 2048 + k * 1024); } while (0)
#define PG8_LDB(dst, b, h) do { _Pragma("unroll") for (int n = 0; n < 2; ++n) _Pragma("unroll") for (int k = 0; k < 2; ++k) dst[n][k] = *(const PG8_LAS bf16x8*)(lds + PG8_SB(b, h) + boff + n * 2048 + k * 1024); } while (0)
#define PG8_MMA(ai, bj, At, Bt) do { __builtin_amdgcn_s_setprio(1); _Pragma("unroll") for (int m = 0; m < 4; ++m) _Pragma("unroll") for (int n = 0; n < 2; ++n) _Pragma("unroll") for (int k = 0; k < 2; ++k) \
        acc[ai][bj][m][n] = __builtin_amdgcn_mfma_f32_16x16x32_bf16(Bt[n][k], At[m][k], acc[ai][bj][m][n], 0, 0, 0); __builtin_amdgcn_s_setprio(0); } while (0)
#define PG8_WAIT_V(n) asm volatile("s_waitcnt vmcnt(" #n ")" ::: "memory")
#define PG8_WAIT_L(n) asm volatile("s_waitcnt lgkmcnt(" #n ")" ::: "memory")
#define PG8_WAIT_VP() asm volatile("s_waitcnt vmcnt(%0)" :: "n"(8 + Epi::NST) : "memory")
#define PG8_BAR __builtin_amdgcn_s_barrier()
#define PG8_SCHED __builtin_amdgcn_sched_barrier(0)
    UnitG cur, nxt; int ui = 0;
    if (!S.next(0, cur)) return;
    f32x4 acc[2][2][4][2];
#pragma unroll
    for (int a = 0; a < 2; ++a)
#pragma unroll
        for (int b = 0; b < 2; ++b)
#pragma unroll
            for (int m = 0; m < 4; ++m)
#pragma unroll
                for (int n = 0; n < 2; ++n) acc[a][b][m][n] = (f32x4){0.f, 0.f, 0.f, 0.f};
    bf16x8 At[4][2], B0[2][2], B1[2][2];
    const char* cA = cur.A; const char* cB = cur.B;
    unsigned vA = (unsigned)(sR * cur.lda + sC) * 2u, vB = (unsigned)(sRb * cur.ldb + sC) * 2u;
    unsigned qA = (unsigned)cur.lda * 128u, qB = (unsigned)cur.ldb * 128u;
#define hA (2u * qA)
#define hB (2u * qB)
    PG8_STAGE(PG8_SB(0, 0), cB, vB, qB); PG8_STAGE(PG8_SB(0, 1), cB + hB, vB, qB); PG8_STAGE(PG8_SA(0, 0), cA, vA, qA); PG8_STAGE(PG8_SA(0, 1), cA + hA, vA, qA);
    if (wr == 1) PG8_BAR;
    PG8_WAIT_V(2); PG8_BAR;
    PG8_STAGE(PG8_SB(1, 0), cB + kstep, vB, qB); PG8_STAGE(PG8_SA(1, 0), cA + kstep, vA, qA); PG8_STAGE(PG8_SB(1, 1), cB + hB + kstep, vB, qB);
    PG8_WAIT_V(0); PG8_BAR;
    for (;;) {
        const bool has_next = S.next(ui + 1, nxt);
        const char* nA = has_next ? nxt.A : cA; const char* nB = has_next ? nxt.B : cB;
        const int nlda = has_next ? nxt.lda : cur.lda, nldb = has_next ? nxt.ldb : cur.ldb;
        unsigned nvA, nvB; { int r2, c2; stage_rc((wid * 64 + lane_id()) * 16, r2, c2); const int rb2 = Epi::PERM ? ((r2 & ~31) + perm32(r2 & 31)) : r2;
            nvA = (unsigned)(r2 * nlda + c2) * 2u; nvB = (unsigned)(rb2 * nldb + c2) * 2u; }
        const unsigned nqA = (unsigned)nlda * 128u, nqB = (unsigned)nldb * 128u;
        const int nt = cur.K / BK;
#define PG8_KITER(WV) do { \
            const bool last = (t == nt - 2); \
            const char* a1 = cA + (size_t)(t + 1) * kstep; \
            const char* a2 = last ? nA : cA + (size_t)(t + 2) * kstep; const char* b2 = last ? nB : cB + (size_t)(t + 2) * kstep; \
            const char* a3 = a2 + kstep; const char* b3 = b2 + kstep; \
            const unsigned va2 = last ? nvA : vA, vb2 = last ? nvB : vB; \
            const unsigned qa2 = last ? nqA : qA, qb2 = last ? nqB : qB, ha2 = 2u * qa2, hb2 = 2u * qb2; \
              \
            PG8_LDB(B0, 0, 0); PG8_LDB(B1, 0, 1); PG8_SCHED; PG8_LDA(At, 0, 0); PG8_STAGE(PG8_SA(1, 1), a1 + hA, vA, qA); \
            WV; PG8_WAIT_L(0); PG8_BAR; PG8_MMA(0, 0, At, B0); PG8_MMA(0, 1, At, B1); PG8_BAR; PG8_SCHED; \
              \
            PG8_LDA(At, 0, 1); PG8_STAGE(PG8_SB(0, 0), b2, vb2, qb2); PG8_STAGE(PG8_SB(0, 1), b2 + hb2, vb2, qb2); PG8_STAGE(PG8_SA(0, 0), a2, va2, qa2); \
            WV; PG8_WAIT_L(0); PG8_BAR; PG8_MMA(1, 0, At, B0); PG8_MMA(1, 1, At, B1); PG8_BAR; PG8_SCHED; \
              \
            PG8_LDB(B0, 1, 0); PG8_LDB(B1, 1, 1); PG8_SCHED; PG8_LDA(At, 1, 0); PG8_STAGE(PG8_SA(0, 1), a2 + ha2, va2, qa2); \
            PG8_WAIT_V(8); PG8_WAIT_L(0); PG8_BAR; PG8_MMA(0, 0, At, B0); PG8_MMA(0, 1, At, B1); PG8_BAR; PG8_SCHED; \
              \
            PG8_LDA(At, 1, 1); PG8_STAGE(PG8_SB(1, 0), b3, vb2, qb2); PG8_STAGE(PG8_SB(1, 1), b3 + hb2, vb2, qb2); PG8_STAGE(PG8_SA(1, 0), a3, va2, qa2); \
            PG8_WAIT_V(8); PG8_WAIT_L(0); PG8_BAR; PG8_MMA(1, 0, At, B0); PG8_MMA(1, 1, At, B1); PG8_BAR; PG8_SCHED; } while (0)
        { const int t = 0; PG8_KITER(PG8_WAIT_VP()); }
        for (int t = 2; t < nt; t += 2) PG8_KITER(PG8_WAIT_V(8));
#undef PG8_KITER
        if (wr == 0) PG8_BAR;
        { const int l2 = lane_id(); int fr2 = l2 & 15, fq2 = l2 >> 4; asm volatile("" : "+v"(fr2), "+v"(fq2)); E(acc, cur, wr, wc, fr2, fq2); }
        if (!has_next) break;
#pragma unroll
        for (int a = 0; a < 2; ++a)
#pragma unroll
            for (int b = 0; b < 2; ++b)
#pragma unroll
                for (int m = 0; m < 4; ++m)
#pragma unroll
                    for (int n = 0; n < 2; ++n) acc[a][b][m][n] = (f32x4){0.f, 0.f, 0.f, 0.f};
        cA = nA; cB = nB; vA = nvA; vB = nvB; qA = nqA; qB = nqB; ++ui;
        { int u2 = __builtin_amdgcn_readfirstlane(ui); asm volatile("" : "+s"(u2)); (void)S.next(u2, cur); }
        if (wr == 1) PG8_BAR;
    }
    PG8_WAIT_V(0);
    PG8_BAR;
#undef hA
#undef hB
#undef PG8_SA
#undef PG8_SB
#undef PG8_STAGE
#undef PG8_LDA
#undef PG8_LDB
#undef PG8_MMA
#undef PG8_WAIT_V
#undef PG8_WAIT_VP
#undef PG8_WAIT_L
#undef PG8_BAR
#undef PG8_SCHED
}
}
using pg8::UnitG;

constexpr size_t MiB = 1u << 20;
constexpr size_t WS_CTL = 0, CTL_ZERO_BYTES = 1 * MiB;
constexpr size_t WS_WT = 2 * MiB;
constexpr size_t WO_UP1 = 0, WO_DN1 = 44 * MiB, WO_UP2 = 66 * MiB, WO_DN2 = 110 * MiB, WO_ATT = 132 * MiB, WO_RET = 150 * MiB, WO_CF = 162 * MiB,
                 WO_GATE = 170 * MiB, WO_BA = 194 * MiB, WO_BB = 196 * MiB, WO_BC = 200 * MiB, WO_OUT = 202 * MiB, WO_LR = 210 * MiB, WT_BYTES = 212 * MiB;
constexpr size_t WS_XN = WS_WT + WT_BYTES;
constexpr size_t WS_AR = WS_XN + 160 * MiB;
constexpr size_t AR_YC = 0, AR_YA = 40 * MiB, AR_YB = 80 * MiB;
constexpr int FFN_MC = 40960, FFN_NCK = (T + FFN_MC - 1) / FFN_MC;
constexpr size_t AR_H = 0;
constexpr size_t AR_CF = 160 * MiB, AR_RKVK = 320 * MiB, AR_LR = 480 * MiB, AR_EA = 512 * MiB, AR_GT = 672 * MiB, AR_YS = 160 * MiB, AR_PB = 160 * MiB, AR_YSB = 40 * MiB, AR_STS = 120 * MiB;
static_assert((size_t)160 * 64 * 12800 <= 160 * MiB, "PB");
constexpr size_t AR_QA = 160 * MiB, AR_KA = 280 * MiB, AR_VTA = 400 * MiB, AR_OA = 40 * MiB, AR_LSE = 680 * MiB;
constexpr size_t AR_RQ = 520 * MiB, AR_RK = 560 * MiB, AR_RKT = 600 * MiB, AR_RVT = 160 * MiB, AR_RG = 240 * MiB, AR_SB = 320 * MiB;
constexpr size_t AR_SCR = 160 * MiB, AR_MG = 288 * MiB;
constexpr size_t XB_OFF = 160 * MiB;
constexpr size_t AR_XF = 480 * MiB;
constexpr size_t WS_END = WS_AR + 712 * MiB;
constexpr int CW_BAR = 4096;

constexpr int RING_OFF = 0, RING_BYTES = 131072;
constexpr int LDSCTL_OFF = RING_BYTES, MISC_OFF = LDSCTL_OFF + 320;
constexpr int LDS_BYTES = 147456;

struct Args { const float* in[30]; float* out; unsigned char* ws; int ph_lo, ph_hi; };
static_assert(__builtin_offsetof(Args, out) == 240 && __builtin_offsetof(Args, ws) == 248, "ld_karg64 offsets");

struct Frame { LAS unsigned char* lds; unsigned char* ws; int tid, lane, wave, G, gw, NGW, bid, z; };

__device__ __forceinline__ void transpose_item(const float* W, int ldw, int k0, int n0, bf16* WT, int Kdst, int dst_row0, LAS float* scr, int lane) {
    float tv[32];
#pragma unroll
    for (int i = 0; i < 32; ++i) { const int kk = 2 * i + (lane >> 5); tv[i] = W[(size_t)(k0 + kk) * ldw + n0 + (lane & 31)]; }
#pragma unroll
    for (int i = 0; i < 32; ++i) { const int kk = 2 * i + (lane >> 5); scr[kk * 33 + (lane & 31)] = tv[i]; }
    LDS_WAIT(); asm volatile("" ::: "memory");
    const int c = lane & 7;
#pragma unroll
    for (int j = 0; j < 4; ++j) { const int n = (lane >> 3) + 8 * j; const LAS float* s = scr + (8 * c) * 33 + n;
        v4u o; o.x = pk2(s[0 * 33], s[1 * 33]); o.y = pk2(s[2 * 33], s[3 * 33]); o.z = pk2(s[4 * 33], s[5 * 33]); o.w = pk2(s[6 * 33], s[7 * 33]);
        *(v4u*)(WT + (size_t)(dst_row0 + n) * Kdst + k0 + 8 * c) = o; }
    LDS_WAIT(); asm volatile("" ::: "memory");
}

__device__ __forceinline__ void phase_wconv(const Frame& F, const Args& a, int l, unsigned char* wt, unsigned char* wth, int part) {
    LAS float* scr = (LAS float*)(F.lds + RING_OFF + F.wave * 16384);
    constexpr int I_FF = 5632, I_A = 6 * I_FF, I_IN = 32 * 492, I_BA = 512, I_BB = 1024, I_BC = 512, I_OUT = 2048;
    constexpr int NITEMS = I_A + I_IN + I_BA + I_BB + I_BC + I_OUT;
    for (int it = F.gw; it < NITEMS; it += F.NGW) {
        int r = it;
        if (r < I_A) {
            const int m = r / I_FF, q = r % I_FF, f = m / 3, mm = m % 3;
            if (!((f ? 2 : 1) & part)) continue;
            if (mm < 2) {
                const float* W = a.in[F.z + (f ? 26 : 3) + mm] + (size_t)l * D * FF;
                const int kb = q / 176, nb = q % 176, n0 = 32 * nb;
                bf16* dst = (bf16*)(f ? wth + WO_UP2 : wt + WO_UP1);
                transpose_item(W, FF, 64 * kb, n0, dst, D, (n0 / 128) * 256 + mm * 128 + (n0 % 128), scr, F.lane);
            } else {
                const float* W = a.in[F.z + (f ? 28 : 5)] + (size_t)l * FF * D;
                const int kb = q / 64, nb = q % 64, n0 = 32 * nb;
                bf16* dst = (bf16*)(f ? wth + WO_DN2 : wt + WO_DN1);
                transpose_item(W, D, 64 * kb, n0, dst, FF, n0, scr, F.lane);
            }
            continue;
        }
        r -= I_A;
        if (r < I_IN) {
            const float* W = a.in[F.z + 7] + (size_t)l * D * 15744;
            const int kb = r / 492, nb = r % 492, n0 = 32 * nb;
            if (!(((n0 >= 7680 && n0 < 9600) ? 1 : 2) & part)) continue;
            bf16* dst; int row;
            if (n0 < 4608) { dst = (bf16*)(wth + WO_ATT); row = n0; }
            else if (n0 < 7680) { dst = (bf16*)(wth + WO_RET); row = n0 - 4608; }
            else if (n0 < 9600) { dst = (bf16*)(wth + WO_CF); row = n0 - 7680; }
            else { dst = (bf16*)(wth + WO_GATE); row = n0 - 9600; }
            transpose_item(W, 15744, 64 * kb, n0, dst, D, row, scr, F.lane);
            continue;
        }
        r -= I_IN;
        if (!(part & 2)) break;
        if (r < I_BA) { const int kb = r / 64, nb = r % 64; transpose_item(a.in[F.z + 21] + (size_t)l * 512 * D, D, 64 * kb, 32 * nb, (bf16*)(wth + WO_BA), 512, 32 * nb, scr, F.lane); continue; }
        r -= I_BA;
        if (r < I_BB) { const int kb = r / 64, nb = r % 64; transpose_item(a.in[F.z + 22] + (size_t)l * 1024 * D, D, 64 * kb, 32 * nb, (bf16*)(wth + WO_BB), 1024, 32 * nb, scr, F.lane); continue; }
        r -= I_BB;
        if (r < I_BC) { const int kb = r / 64, nb = r % 64; transpose_item(a.in[F.z + 23] + (size_t)l * 512 * D, D, 64 * kb, 32 * nb, (bf16*)(wth + WO_BC), 512, 32 * nb, scr, F.lane); continue; }
        r -= I_BC;
        { const int kb = r / 64, nb = r % 64; transpose_item(a.in[F.z + 24] + (size_t)l * D * D, D, 64 * kb, 32 * nb, (bf16*)(wth + WO_OUT), D, 32 * nb, scr, F.lane); }
    }
    if (!(part & 1)) return;
    const int gt = F.bid * NTHR + F.tid, NGT = F.G * NTHR;
    bf16* lr = (bf16*)(wth + WO_LR);
    const float* w2 = a.in[F.z + 12] + (size_t)l * 2 * 64 * 512; const float* a2 = a.in[F.z + 14] + (size_t)l * 2 * 64 * 512; const float* g2 = a.in[F.z + 15] + (size_t)l * 128 * 512;
    for (int i = gt; i < 2560 * 384; i += NGT) {
        const int n = i / 384, k = i % 384; float v = 0.f;
        if (n < 1024) { const int z = n >> 9, c = n & 511; if (k >= 64 * z && k < 64 * z + 64) v = w2[((size_t)z * 64 + (k - 64 * z)) * 512 + c]; }
        else if (n < 2048) { const int z = (n - 1024) >> 9, c = n & 511; if (k >= 128 + 64 * z && k < 192 + 64 * z) v = a2[((size_t)z * 64 + (k - 128 - 64 * z)) * 512 + c]; }
        else { const int c = n - 2048; if (k >= 256) v = g2[(size_t)(k - 256) * 512 + c]; }
        lr[i] = (bf16)f2bf(v);
    }
    bf16* cfz = (bf16*)(wth + WO_CF) + (size_t)1920 * D;
    for (int i = gt; i < 128 * D; i += NGT) cfz[i] = 0;
}

__device__ __forceinline__ void phase_norm_in(const Frame& F, const float* xp, const float* xs, const float* gain, bf16* xn, bf16* xb) {
    for (int m = F.gw; m < T; m += F.NGW) {
        const float* src_row = m < 8192 ? xp + (size_t)m * D : xs + (size_t)(m - 8192) * D;
        const f32x4* xr = (const f32x4*)src_row + F.lane; const f32x4* gr = (const f32x4*)gain + F.lane;
        f32x4 v[8]; float s = 0.f;
#pragma unroll
        for (int j = 0; j < 8; ++j) { v[j] = xr[64 * j]; s += (v[j].x * v[j].x + v[j].y * v[j].y) + (v[j].z * v[j].z + v[j].w * v[j].w); }
        const float rstd = 1.0f / sqrtf(wave_sum(s) * (1.0f / D) + 1e-6f);
        v2u* o8 = (v2u*)(xn + (size_t)m * D) + F.lane; v2u* b8 = (v2u*)(xb + (size_t)m * D) + F.lane;
#pragma unroll
        for (int j = 0; j < 8; ++j) { const f32x4 g = gr[64 * j]; v2u w; w.x = pk2(v[j].x * rstd * g.x, v[j].y * rstd * g.y); w.y = pk2(v[j].z * rstd * g.z, v[j].w * rstd * g.w); o8[64 * j] = w;
            v2u b; b.x = pk2(v[j].x, v[j].y); b.y = pk2(v[j].z, v[j].w); b8[64 * j] = b; }
    }
}
__device__ __forceinline__ void phase_norm(const Frame& F, const bf16* x, const float* gain, bf16* xn) {
    for (int m = 2 * F.gw; m < T; m += 2 * F.NGW) {
        v4u v[2][4]; float s[2] = {0.f, 0.f};
#pragma unroll
        for (int r = 0; r < 2; ++r) { const v4u* xr = (const v4u*)(x + (size_t)(m + r) * D) + F.lane;
#pragma unroll
            for (int j = 0; j < 4; ++j) v[r][j] = xr[64 * j]; }
#pragma unroll
        for (int r = 0; r < 2; ++r)
#pragma unroll
            for (int j = 0; j < 4; ++j)
#pragma unroll
                for (int q = 0; q < 4; ++q) { const float a = bf_lo(v[r][j][q]), b = bf_hi(v[r][j][q]); s[r] += a * a + b * b; }
        const f32x4* gr = (const f32x4*)gain + 2 * F.lane;
#pragma unroll
        for (int r = 0; r < 2; ++r) {
            const float rstd = 1.0f / sqrtf(wave_sum(s[r]) * (1.0f / D) + 1e-6f);
            v4u* o = (v4u*)(xn + (size_t)(m + r) * D) + F.lane;
#pragma unroll
            for (int j = 0; j < 4; ++j) { const f32x4 g0 = gr[128 * j], g1 = gr[128 * j + 1]; const v4u w = v[r][j]; v4u ow;
                ow.x = pk2(bf_lo(w.x) * rstd * g0.x, bf_hi(w.x) * rstd * g0.y); ow.y = pk2(bf_lo(w.y) * rstd * g0.z, bf_hi(w.y) * rstd * g0.w);
                ow.z = pk2(bf_lo(w.z) * rstd * g1.x, bf_hi(w.z) * rstd * g1.y); ow.w = pk2(bf_lo(w.w) * rstd * g1.z, bf_hi(w.w) * rstd * g1.w);
                o[64 * j] = ow; }
        }
    }
}
__device__ __forceinline__ void phase_final_norm(const Frame& F, const bf16* x, const float* gain, float* out) {
    for (int m = F.gw; m < T; m += F.NGW) {
        const v4u* xr = (const v4u*)(x + (size_t)m * D) + F.lane;
        v4u v[4]; float s = 0.f;
#pragma unroll
        for (int j = 0; j < 4; ++j) v[j] = xr[64 * j];
#pragma unroll
        for (int j = 0; j < 4; ++j)
#pragma unroll
            for (int q = 0; q < 4; ++q) { const float a = bf_lo(v[j][q]), b = bf_hi(v[j][q]); s += a * a + b * b; }
        const float rstd = 1.0f / sqrtf(wave_sum(s) * (1.0f / D) + 1e-6f);
        const f32x4* gr = (const f32x4*)gain + 2 * F.lane; f32x4* o = (f32x4*)(out + (size_t)m * D) + 2 * F.lane;
#pragma unroll
        for (int j = 0; j < 4; ++j) { const f32x4 g0 = gr[128 * j], g1 = gr[128 * j + 1]; const v4u w = v[j];
            f32x4 o0, o1; o0.x = bf_lo(w.x) * rstd * g0.x; o0.y = bf_hi(w.x) * rstd * g0.y; o0.z = bf_lo(w.y) * rstd * g0.z; o0.w = bf_hi(w.y) * rstd * g0.w;
            o1.x = bf_lo(w.z) * rstd * g1.x; o1.y = bf_hi(w.z) * rstd * g1.y; o1.z = bf_lo(w.w) * rstd * g1.z; o1.w = bf_hi(w.w) * rstd * g1.w;
            o[128 * j] = o0; o[128 * j + 1] = o1; }
    }
}

__device__ __forceinline__ int rperm(int r) { return (r & 0x13) | ((r & 4) << 1) | ((r & 8) >> 1); }
struct SchedPlain {
    const char* A; const char* B; int lda, ldb, K, nM, nN, G, c, wgm;
    __device__ __forceinline__ bool next(int i, UnitG& u) const {
        const int L = i * G + c; if (L >= nM * nN) return false;
        int pm, pn; pg8::tile_map(L, nM, nN, pm, pn, wgm);
        u.A = A + (size_t)pm * 256 * lda * 2; u.B = B + (size_t)pn * 256 * ldb * 2; u.lda = lda; u.ldb = ldb; u.K = K; u.O = nullptr; u.ldo = 0; u.kind = 0; u.x0 = pm; u.x1 = pn; return true;
    }
};
struct EpiSwiglu {
    static constexpr bool PERM = true; static constexpr int NST = 8;
    bf16* H;
    __device__ __forceinline__ void operator()(const f32x4 (&acc)[2][2][4][2], const UnitG& u, int wr, int wc, int fr, int fq) const {
        const int row0 = u.x0 * 256 + wr * 64 + fr, col0 = u.x1 * 128 + wc * 32 + 8 * fq;
#pragma unroll
        for (int ai = 0; ai < 2; ++ai)
#pragma unroll
            for (int m = 0; m < 4; ++m) {
                float h[8];
#pragma unroll
                for (int n = 0; n < 2; ++n)
#pragma unroll
                    for (int e = 0; e < 4; ++e) { const float g = acc[ai][0][m][n][e], up = acc[ai][1][m][n][e]; h[4 * n + e] = g * fsigmoid(g) * up; }
                v4u w; w.x = cvt_pk_bf16(h[0], h[1]); w.y = cvt_pk_bf16(h[2], h[3]); w.z = cvt_pk_bf16(h[4], h[5]); w.w = cvt_pk_bf16(h[6], h[7]);
                *(v4u*)(H + (size_t)(row0 + ai * 128 + m * 16) * FF + col0) = w;
            }
    }
};
struct EpiResid {
    static constexpr bool PERM = true; static constexpr int NST = 16;
    bf16* X; const bf16* R; float scale;
    __device__ __forceinline__ void operator()(const f32x4 (&acc)[2][2][4][2], const UnitG& u, int wr, int wc, int fr, int fq) const {
        const int row0 = u.x0 * 256 + wr * 64 + fr, col0 = u.x1 * 256 + wc * 32 + 8 * fq;
        v4u xv[2][4][2];
#pragma unroll
        for (int ai = 0; ai < 2; ++ai)
#pragma unroll
            for (int m = 0; m < 4; ++m) { const bf16* rowp = R + (size_t)(row0 + ai * 128 + m * 16) * D + col0;
#pragma unroll
                for (int bj = 0; bj < 2; ++bj) xv[ai][m][bj] = *(const v4u*)(rowp + bj * 128); }
        asm volatile("" ::: "memory");
#pragma unroll
        for (int ai = 0; ai < 2; ++ai)
#pragma unroll
            for (int m = 0; m < 4; ++m) { bf16* rowp = X + (size_t)(row0 + ai * 128 + m * 16) * D + col0;
#pragma unroll
                for (int bj = 0; bj < 2; ++bj) { const f32x4 a0 = acc[ai][bj][m][0], a1 = acc[ai][bj][m][1]; const v4u r = xv[ai][m][bj]; v4u w;
                    w.x = cvt_pk_bf16(bf_lo(r.x) + a0.x * scale, bf_hi(r.x) + a0.y * scale); w.y = cvt_pk_bf16(bf_lo(r.y) + a0.z * scale, bf_hi(r.y) + a0.w * scale);
                    w.z = cvt_pk_bf16(bf_lo(r.z) + a1.x * scale, bf_hi(r.z) + a1.y * scale); w.w = cvt_pk_bf16(bf_lo(r.w) + a1.z * scale, bf_hi(r.w) + a1.w * scale);
                    *(v4u*)(rowp + bj * 128) = w; } }
        asm volatile("" ::: "memory");
    }
};
template <int KM>
struct EpiStore {
    static constexpr bool PERM = true; static constexpr int NST = 16;
    const float* b0; const float* b1; const float* dlog;
    template <int KIND>
    __device__ __forceinline__ void run(const f32x4 (&acc)[2][2][4][2], const UnitG& u, int wr, int wc, int fr, int fq) const {
        const int row0 = wr * 64 + fr, col0 = wc * 32 + 8 * fq;
        bf16* O = (bf16*)u.O;
        const unsigned lof = (unsigned)((fq >> 1) * 512 + ((fq & 1) * 32 + ((KIND == 2 || KIND == 9) ? rperm(fr) : fr)) * 8);
        float l2g[2] = {0.f, 0.f}, l2h[2] = {0.f, 0.f};
        if (KIND == 2) {
#pragma unroll
            for (int ai = 0; ai < 2; ++ai) { const float lg = ((const GAS float*)dlog)[u.x0 + ai], lh = ((const GAS float*)dlog)[4 + u.x0 + ai];
                l2g[ai] = -__builtin_amdgcn_logf(1.0f + fexp(-lg)); l2h[ai] = -__builtin_amdgcn_logf(1.0f + fexp(-lh)); }
        }
#pragma unroll
        for (int ai = 0; ai < 2; ++ai)
#pragma unroll
            for (int m = 0; m < 4; ++m)
#pragma unroll
                for (int bj = 0; bj < 2; ++bj) {
                    float v[8];
#pragma unroll
                    for (int n = 0; n < 2; ++n)
#pragma unroll
                        for (int e = 0; e < 4; ++e) v[4 * n + e] = acc[ai][bj][m][n][e];
                    bf16* dst;
                    if (KIND == 7 || KIND == 8)
                        dst = O + ((size_t)(((u.x0 + 2 * wr + 4 * ai + (m >> 1)) * 4 + u.x1 + bj) * 8 + 2 * wc) * 512 + (m & 1) * 128) + lof;
                    else if (KIND == 9)
                        dst = O + ((size_t)((((2 * u.x0 + ai) * 4 + 2 * wr + (m >> 1)) * (T / 32) + u.x1 + 4 * bj + wc) * 2) * 512 + (m & 1) * 128) + lof;
                    else if (KIND == 2)
                        dst = O + ((size_t)(((u.x0 + ai) * 4 + 2 * wr + (m >> 1)) * (T / 16) + u.x1 + 8 * bj + 2 * wc) * 512 + (m & 1) * 128) + lof;
                    else if (KIND == 10)
                        dst = O + ((size_t)((u.x0 * 8 + 2 * wr + 4 * ai + (m >> 1)) * (T / 16) + u.x1 + 8 * bj + 2 * wc) * 512 + (m & 1) * 128) + lof;
                    else dst = O + (size_t)(row0 + ai * 128 + m * 16) * u.ldo + col0 + bj * 128;
                    v4u w;
                    if (KIND == 1 || KIND == 7) {
#pragma unroll
                        for (int e = 0; e < 8; ++e) v[e] *= 0.08838834764831845f;
                    } else if (KIND == 2) {
                        float v1[8];
#pragma unroll
                        for (int e = 0; e < 8; ++e) { const int pos = (col0 + e) & 127; const float b = v[e] * 0.08838834764831845f;
                            v1[e] = b * __builtin_amdgcn_exp2f(l2h[ai] * (float)pos); v[e] = b * __builtin_amdgcn_exp2f(l2g[ai] * (float)(127 - pos)); }
                        v4u w1; w1.x = cvt_pk_bf16(v1[0], v1[1]); w1.y = cvt_pk_bf16(v1[2], v1[3]); w1.z = cvt_pk_bf16(v1[4], v1[5]); w1.w = cvt_pk_bf16(v1[6], v1[7]);
                        *(v4u*)(dst + (size_t)16 * (T / 16) * 512) = w1;
                    } else if (KIND == 4) {
                        const int c = u.x1 * 256 + bj * 128 + col0;
#pragma unroll
                        for (int e = 0; e < 8; ++e) { const float xx = -(v[e] + b0[c + e]); const float sp = (xx > 15.f) ? xx : __builtin_amdgcn_logf(1.0f + fexp(xx)) * 0.69314718056f; v[e] = fexp(-sp - 0.5f); }
                    } else if (KIND == 5) {
                        const int c = u.x1 * 256 + bj * 128 + col0 - 1024;
#pragma unroll
                        for (int e = 0; e < 8; ++e) v[e] = fsigmoid(v[e] + b1[c + e]);
                    }
                    if (KIND == 4 || KIND == 5) { w.x = pkh2(v[0], v[1]); w.y = pkh2(v[2], v[3]); w.z = pkh2(v[4], v[5]); w.w = pkh2(v[6], v[7]); }
                    else { w.x = cvt_pk_bf16(v[0], v[1]); w.y = cvt_pk_bf16(v[2], v[3]); w.z = cvt_pk_bf16(v[4], v[5]); w.w = cvt_pk_bf16(v[6], v[7]); }
                    *(v4u*)dst = w; }
    }
    __device__ __forceinline__ void operator()(const f32x4 (&acc)[2][2][4][2], const UnitG& u, int wr, int wc, int fr, int fq) const {
        const int kind = u.kind;
#define ES_CASE(K) if (((KM >> (K)) & 1) && (kind == (K) || (KM & ~(1 << (K))) == 0)) { run<K>(acc, u, wr, wc, fr, fq); return; }
        ES_CASE(0) ES_CASE(1) ES_CASE(2) ES_CASE(4) ES_CASE(5) ES_CASE(7) ES_CASE(8) ES_CASE(9) ES_CASE(10)
        if ((KM >> 6) & 1) run<0>(acc, u, wr, wc, fr, fq);
#undef ES_CASE
    }
};
struct SchedCF {
    SchedPlain P; char* O;
    __device__ __forceinline__ bool next(int i, UnitG& u) const { if (!P.next(i, u)) return false; u.O = O + ((size_t)u.x0 * 256 * 2048 + (size_t)u.x1 * 256) * 2; u.ldo = 2048; u.kind = 0; return true; }
};
struct SchedLR {
    SchedPlain P; char* EA; char* GT;
    __device__ __forceinline__ bool next(int i, UnitG& u) const {
        if (!P.next(i, u)) return false;
        if (u.x1 < 8) { u.O = EA + ((size_t)u.x0 * 256 * 2048 + (size_t)u.x1 * 256) * 2; u.ldo = 2048; u.kind = u.x1 < 4 ? 4 : 5; }
        else { u.O = GT + ((size_t)u.x0 * 256 * 512 + (size_t)(u.x1 - 8) * 256) * 2; u.ldo = 512; u.kind = 6; }
        { const int sl = u.x1 < 4 ? 0 : (u.x1 < 8 ? 1 : 2); u.A += sl * 256; u.B += sl * 256; u.K = 128; }
        return true;
    }
};
__device__ __forceinline__ int panel_tok0(int pn, int d) { const int n0 = pn * 256, seq = n0 >> 12, within = n0 & 4095, Lg = SEQ / d, p = within / Lg, s0 = within % Lg; return seq * SEQ + s0 * d + p; }
struct SchedAtt {
    const char* XN; const char* wt; char* ar; int G, c;
    __device__ __forceinline__ bool next(int i, UnitG& u) const {
        const int L = i * G + c; if (L >= 3840) return false;
        u.K = D; u.x0 = 0; u.x1 = 0;
        if (L < 2880) {
            const char* W = wt + WO_ATT;
            const int g = L / 960, rem = L % 960, d = (g == 0) ? 1 : (g == 1 ? 4 : 16);
            if (rem < 640) {
                int pm, pn; pg8::tile_map(rem, 160, 4, pm, pn);
                const int t0 = panel_tok0(pm, d);
                u.A = XN + (size_t)t0 * D * 2; u.lda = d * D;
                const int isk = pn >> 1, ct = pn & 1;
                u.B = W + (size_t)(isk * 1536 + g * 512 + ct * 256) * D * 2; u.ldb = D;
                u.O = ar + (isk ? AR_KA : AR_QA) + (size_t)g * T * 512 * 2; u.ldo = 512; u.kind = isk ? 8 : 7; u.x0 = 8 * pm; u.x1 = 2 * ct;
            } else {
                int pm, pn; pg8::tile_map(rem - 640, 2, 160, pm, pn);
                const int t0 = panel_tok0(pn, d);
                u.A = W + (size_t)(3072 + g * 512 + pm * 256) * D * 2; u.lda = D;
                u.B = XN + (size_t)t0 * D * 2; u.ldb = d * D;
                u.O = ar + AR_VTA + (size_t)g * 512 * T * 2; u.ldo = T; u.kind = 9; u.x0 = pm; u.x1 = 8 * pn;
            }
        } else if (L < 3520) {
            const char* W = wt + WO_RET;
            int pm, pn; pg8::tile_map(L - 2880, 160, 4, pm, pn);
            u.A = XN + (size_t)pm * 256 * D * 2; u.lda = D; u.ldb = D; u.ldo = 512;
            u.x0 = 8 * pm;
            if (pn < 2) { u.B = W + (size_t)(pn * 256) * D * 2; u.O = ar + AR_RQ; u.kind = 8; u.x1 = 2 * pn; }
            else { u.B = W + (size_t)(512 + (pn - 2) * 256) * D * 2; u.O = ar + AR_RK; u.kind = 7; u.x1 = 2 * (pn - 2); }
        } else {
            const char* W = wt + WO_RET;
            int pm, pn; pg8::tile_map(L - 3520, 2, 160, pm, pn);
            u.B = XN + (size_t)pn * 256 * D * 2; u.ldb = D; u.lda = D; u.ldo = T;
            u.A = W + (size_t)(512 + pm * 256) * D * 2; u.O = ar + AR_RKT; u.kind = 2; u.x0 = 2 * pm; u.x1 = 16 * pn;
        }
        return true;
    }
};
struct SchedRet {
    const char* XN; const char* W; char* ar; int G, c;
    __device__ __forceinline__ bool next(int i, UnitG& u) const {
        const int L = i * G + c; if (L >= 1280) return false;
        u.K = D; u.x0 = 0; u.x1 = 0; u.kind = 0; u.lda = D; u.ldb = D;
        if (L < 640) {
            int pm, pn; pg8::tile_map(L, 4, 160, pm, pn);
            u.A = W + (size_t)(1024 + pm * 256) * D * 2; u.B = XN + (size_t)pn * 256 * D * 2;
            u.O = ar + AR_RVT; u.ldo = T; u.kind = 10; u.x0 = pm; u.x1 = 16 * pn;
        } else {
            int pm, pn; pg8::tile_map(L - 640, 160, 4, pm, pn);
            u.A = XN + (size_t)pm * 256 * D * 2; u.B = W + (size_t)(2048 + pn * 256) * D * 2;
            u.O = ar + AR_RG + ((size_t)pm * 256 * 1024 + pn * 256) * 2; u.ldo = 1024;
        }
        return true;
    }
};
struct SchedMerge {
    const char* XN; const char* ar; const char* wt; int G, c;
    __device__ __forceinline__ bool next(int i, UnitG& u) const {
        const int L = (i / 6) * G + c, su = i % 6; if (L >= 1280) return false;
        int pm, pn; pg8::tile_map(L, 160, 8, pm, pn);
        u.x0 = pm; u.x1 = pn; u.kind = su; u.O = nullptr; u.ldo = 0;
        const int b = su >> 1;
        if (su & 1) { u.A = XN + (size_t)pm * 256 * D * 2; u.lda = D; u.K = D; u.B = wt + WO_GATE + (size_t)(b * 2048 + pn * 256) * D * 2; u.ldb = D; }
        else {
            const int kb = 512 << (b == 1 ? 1 : 0);
            const size_t yoff = (size_t)((b + 1) % 3) * (40 * MiB);
            const size_t woff = WO_BA + (size_t)(2 * b + 2 * (b >> 1)) * MiB;
            u.A = ar + yoff + (size_t)pm * 256 * kb * 2; u.lda = kb; u.K = kb;
            u.B = wt + woff + (size_t)pn * 256 * kb * 2; u.ldb = kb;
        }
        return true;
    }
};
static_assert(AR_YA == 40 * MiB && AR_YB == 80 * MiB && AR_YC == 0 && WO_BB == WO_BA + 2 * MiB && WO_BC == WO_BA + 6 * MiB, "SchedMerge offsets");
struct EpiMerge {
    static constexpr bool PERM = true; static constexpr int NST = 16;
    v4u* scrP; v4u* scrM; bf16* MG;
    __device__ __forceinline__ void operator()(const f32x4 (&acc)[2][2][4][2], const UnitG& u, int wr, int wc, int fr, int fq) const {
        const int tid = (wr * 4 + wc) * 64 + fq * 16 + fr; const int su = u.kind;
        if ((su & 1) == 0) {
            GAS v4u* p = (GAS v4u*)scrP + tid;
#pragma unroll
            for (int ai = 0; ai < 2; ++ai)
#pragma unroll
                for (int bj = 0; bj < 2; ++bj)
#pragma unroll
                    for (int m = 0; m < 4; ++m) { const f32x4 a0 = acc[ai][bj][m][0], a1 = acc[ai][bj][m][1];
                        v4u w; w.x = cvt_pk_bf16(a0.x, a0.y); w.y = cvt_pk_bf16(a0.z, a0.w); w.z = cvt_pk_bf16(a1.x, a1.y); w.w = cvt_pk_bf16(a1.z, a1.w);
                        *p = w; p += NTHR; asm volatile("" : "+v"(p)); }
            return;
        }
        const int row0 = u.x0 * 256 + wr * 64 + fr, col0 = u.x1 * 256 + wc * 32 + 8 * fq;
        const GAS v4u* pp = (const GAS v4u*)scrP + tid; GAS v4u* pm_ = (GAS v4u*)scrM + tid;
#pragma unroll
        for (int ai = 0; ai < 2; ++ai)
#pragma unroll
            for (int bj = 0; bj < 2; ++bj)
#pragma unroll
                for (int m = 0; m < 4; ++m) {
                    const v4u pw = *pp; v4u mw = {0u, 0u, 0u, 0u}; if (su > 1) mw = *pm_;
                    const f32x4 g0 = acc[ai][bj][m][0], g1 = acc[ai][bj][m][1];
                    float v[8];
                    v[0] = fsigmoid(g0.x) * bf_lo(pw.x) + bf_lo(mw.x); v[1] = fsigmoid(g0.y) * bf_hi(pw.x) + bf_hi(mw.x);
                    v[2] = fsigmoid(g0.z) * bf_lo(pw.y) + bf_lo(mw.y); v[3] = fsigmoid(g0.w) * bf_hi(pw.y) + bf_hi(mw.y);
                    v[4] = fsigmoid(g1.x) * bf_lo(pw.z) + bf_lo(mw.z); v[5] = fsigmoid(g1.y) * bf_hi(pw.z) + bf_hi(mw.z);
                    v[6] = fsigmoid(g1.z) * bf_lo(pw.w) + bf_lo(mw.w); v[7] = fsigmoid(g1.w) * bf_hi(pw.w) + bf_hi(mw.w);
                    v4u w; w.x = cvt_pk_bf16(v[0], v[1]); w.y = cvt_pk_bf16(v[2], v[3]); w.z = cvt_pk_bf16(v[4], v[5]); w.w = cvt_pk_bf16(v[6], v[7]);
                    if (su < 5) *pm_ = w;
                    else *(v4u*)(MG + (size_t)(row0 + ai * 128 + m * 16) * D + col0 + bj * 128) = w;
                    pp += NTHR; pm_ += NTHR; asm volatile("" : "+v"(pp), "+v"(pm_) :: "memory");
                }
    }
};

#define MFMA32(a, b, c) __builtin_amdgcn_mfma_f32_32x32x16_bf16((a), (b), (c), 0, 0, 0)
__device__ __forceinline__ v4u pk8(const f32x16& o, int b) { v4u w; w.x = cvt_pk_bf16(o[b], o[b + 1]); w.y = cvt_pk_bf16(o[b + 2], o[b + 3]); w.z = cvt_pk_bf16(o[b + 4], o[b + 5]); w.w = cvt_pk_bf16(o[b + 6], o[b + 7]); return w; }
__device__ __forceinline__ void phase_rwkv_pre(const Frame& F, const Args& a, int l) {
    const bf16* CF = (const bf16*)(F.ws + WS_AR + AR_CF); unsigned short* RK = (unsigned short*)(F.ws + WS_AR + AR_RKVK); bf16* LR = (bf16*)(F.ws + WS_AR + AR_LR);
    const float* cw = a.in[F.z + 10] + (size_t)l * 3 * 1920; const float* kk_w = a.in[F.z + 16] + (size_t)l * 512;
    const int lane = F.lane;
    for (int t = F.gw; t < T; t += F.NGW) {
        const int s = t & 4095; const bool hp = s > 0, hn = s < 4095;
#pragma unroll
        for (int j = 0; j < 4; ++j) {
            if (j == 3 && lane >= 48) continue;
            const int cb = 512 * j + 8 * lane;
            const v4u zc = {0u, 0u, 0u, 0u};
            const v4u cur = *(const v4u*)(CF + (size_t)t * 2048 + cb);
            const v4u prv = hp ? *(const v4u*)(CF + (size_t)(t - 1) * 2048 + cb) : zc;
            const v4u nxt = hn ? *(const v4u*)(CF + (size_t)(t + 1) * 2048 + cb) : zc;
            float o[8];
#pragma unroll
            for (int q = 0; q < 4; ++q) {
                const unsigned wc_ = cur[q], wp = prv[q], wn = nxt[q];
                const int c = cb + 2 * q;
                o[2 * q] = cw[c] * bf_lo(wp) + cw[1920 + c] * bf_lo(wc_) + cw[3840 + c] * bf_lo(wn);
                o[2 * q + 1] = cw[c + 1] * bf_hi(wp) + cw[1920 + c + 1] * bf_hi(wc_) + cw[3840 + c + 1] * bf_hi(wn);
            }
            if (j < 3) {
                v4u w; w.x = pkh2(o[0], o[1]); w.y = pkh2(o[2], o[3]); w.z = pkh2(o[4], o[5]); w.w = pkh2(o[6], o[7]);
                *(v4u*)(RK + (size_t)t * 2048 + cb) = w;
                if (j == 1) {
                    float kv[8]; float ss = 0.f;
#pragma unroll
                    for (int e = 0; e < 8; ++e) { kv[e] = o[e] * kk_w[8 * lane + e]; ss += kv[e] * kv[e]; }
                    ss += shfl_xor_(ss, 1); ss += shfl_xor_(ss, 2); ss += shfl_xor_(ss, 4);
                    const float rn = 1.0f / sqrtf(ss + 1e-12f);
                    v4u w2; w2.x = pkh2(kv[0] * rn, kv[1] * rn); w2.y = pkh2(kv[2] * rn, kv[3] * rn); w2.z = pkh2(kv[4] * rn, kv[5] * rn); w2.w = pkh2(kv[6] * rn, kv[7] * rn);
                    *(v4u*)(RK + (size_t)t * 2048 + 1536 + 8 * lane) = w2;
                }
            } else {
                if (lane < 16) {
#pragma unroll
                    for (int e = 0; e < 8; ++e) { const float ex = fexp(2.0f * o[e]); o[e] = 1.0f - 2.0f / (ex + 1.0f); }
                } else if (lane >= 32) {
#pragma unroll
                    for (int e = 0; e < 8; ++e) o[e] = fsigmoid(o[e]);
                }
                v4u w; w.x = pk2(o[0], o[1]); w.y = pk2(o[2], o[3]); w.z = pk2(o[4], o[5]); w.w = pk2(o[6], o[7]);
                *(v4u*)(LR + (size_t)t * 384 + 8 * lane) = w;
            }
        }
    }
}

__device__ __forceinline__ float dpp_red16(float x) {
    x += __builtin_bit_cast(float, __builtin_amdgcn_update_dpp(0, __builtin_bit_cast(int, x), 0xB1, 0xF, 0xF, true));
    x += __builtin_bit_cast(float, __builtin_amdgcn_update_dpp(0, __builtin_bit_cast(int, x), 0x4E, 0xF, 0xF, true));
    x += __builtin_bit_cast(float, __builtin_amdgcn_update_dpp(0, __builtin_bit_cast(int, x), 0x141, 0xF, 0xF, true));
    x += __builtin_bit_cast(float, __builtin_amdgcn_update_dpp(0, __builtin_bit_cast(int, x), 0x140, 0xF, 0xF, true));
    return x;
}
__device__ __forceinline__ void phase_rwkv_scan(const Frame& F, const Args& a, int l) {
    const unsigned short* EA = (const unsigned short*)(F.ws + WS_AR + AR_EA); const unsigned short* RK = (const unsigned short*)(F.ws + WS_AR + AR_RKVK);
    float* YS = (float*)(F.ws + WS_AR + AR_YS);
    const float* k_a = a.in[F.z + 17] + (size_t)l * 512;
    constexpr int TB = 32, BUF_F = TB * 384;
    LAS float* buf = (LAS float*)(F.lds + RING_OFF);
    LAS float* yo = buf + 2 * BUF_F;
    const int tid = F.tid, kq = tid & 15, rp = tid >> 4, c = tid & 63, ts = tid >> 6;
    for (int sc = F.bid; sc < 160; sc += F.G) {
        const int seq = sc >> 4, h = (sc >> 1) & 7, z = sc & 1;
        const float ka = k_a[h * 64 + c];
        float st[2][4];
#pragma unroll
        for (int r = 0; r < 2; ++r)
#pragma unroll
            for (int i = 0; i < 4; ++i) st[r][i] = 0.f;
        unsigned short raw[4][6];
#define SCAN_LOAD(nb) do { _Pragma("unroll") for (int i = 0; i < 4; ++i) { const int tau = (nb) * TB + ts + 8 * i; const int pos = z ? (SEQ - 1 - tau) : tau; const size_t tok = (size_t)seq * SEQ + pos; \
            raw[i][0] = EA[tok * 2048 + z * 512 + h * 64 + c]; raw[i][1] = EA[tok * 2048 + 1024 + z * 512 + h * 64 + c]; \
            raw[i][2] = RK[tok * 2048 + h * 64 + c]; raw[i][3] = RK[tok * 2048 + 512 + h * 64 + c]; raw[i][4] = RK[tok * 2048 + 1024 + h * 64 + c]; raw[i][5] = RK[tok * 2048 + 1536 + h * 64 + c]; } } while (0)
#define SCAN_STAGE(bi) do { LAS float* b_ = buf + (bi) * BUF_F; _Pragma("unroll") for (int i = 0; i < 4; ++i) { const int tl = ts + 8 * i; \
            const float e_ = h1(raw[i][0]), a_ = h1(raw[i][1]), r_ = h1(raw[i][2]), k_ = h1(raw[i][3]), v_ = h1(raw[i][4]), kk_ = h1(raw[i][5]); \
            b_[tl * 384 + c] = kk_; b_[tl * 384 + 64 + c] = fexp(-e_); b_[tl * 384 + 128 + c] = kk_ * a_; b_[tl * 384 + 192 + c] = k_ * (1.0f + (a_ - 1.0f) * ka); b_[tl * 384 + 256 + c] = r_; b_[tl * 384 + 320 + c] = v_; } } while (0)
        __syncthreads();
        SCAN_LOAD(0); SCAN_STAGE(0);
        __syncthreads();
        constexpr int NB = SEQ / TB;
        for (int nb = 0; nb < NB; ++nb) {
            if (nb + 1 < NB) SCAN_LOAD(nb + 1);
            const LAS float* b_ = buf + (nb & 1) * BUF_F;
#pragma unroll 4
            for (int stp = 0; stp < TB; ++stp) {
                const LAS float* op = b_ + stp * 384;
                const f32x4 kk4 = *(const LAS f32x4*)(op + 4 * kq), w4 = *(const LAS f32x4*)(op + 64 + 4 * kq), ka4 = *(const LAS f32x4*)(op + 128 + 4 * kq),
                            kd4 = *(const LAS f32x4*)(op + 192 + 4 * kq), r4 = *(const LAS f32x4*)(op + 256 + 4 * kq);
                const f32x2 v2 = *(const LAS f32x2*)(op + 320 + 2 * rp);
#pragma unroll
                for (int r = 0; r < 2; ++r) {
                    float sa = (st[r][0] * kk4.x + st[r][1] * kk4.y) + (st[r][2] * kk4.z + st[r][3] * kk4.w);
                    sa = -dpp_red16(sa);
                    const float vv = r ? v2.y : v2.x;
                    st[r][0] = st[r][0] * w4.x + sa * ka4.x + vv * kd4.x; st[r][1] = st[r][1] * w4.y + sa * ka4.y + vv * kd4.y;
                    st[r][2] = st[r][2] * w4.z + sa * ka4.z + vv * kd4.z; st[r][3] = st[r][3] * w4.w + sa * ka4.w + vv * kd4.w;
                    float y = (st[r][0] * r4.x + st[r][1] * r4.y) + (st[r][2] * r4.z + st[r][3] * r4.w);
                    y = dpp_red16(y);
                    if (kq == 0) yo[stp * 64 + 2 * rp + r] = y;
                }
            }
            if (nb + 1 < NB) SCAN_STAGE((nb + 1) & 1);
            __syncthreads();
#pragma unroll
            for (int i = 0; i < 4; ++i) { const int tl = ts + 8 * i, tau = nb * TB + tl; const int pos = z ? (SEQ - 1 - tau) : tau; const size_t tok = (size_t)seq * SEQ + pos;
                YS[((size_t)z * T + tok) * 512 + h * 64 + c] = yo[tl * 64 + c]; }
            __syncthreads();
        }
#undef SCAN_LOAD
#undef SCAN_STAGE
    }
}

constexpr int RW_CS = 64, RW_NSEG = (SEQ / 16) / RW_CS, RW_PBB = 12800;
__device__ __forceinline__ unsigned lds_u16(const LAS bf16* p) { return (unsigned)*p; }
__device__ __forceinline__ void phase_rwkv_prep(const Frame& F, const Args& a, int l, int seg) {
    const unsigned short* EA = (const unsigned short*)(F.ws + WS_AR + AR_EA); const unsigned short* RK = (const unsigned short*)(F.ws + WS_AR + AR_RKVK);
    unsigned char* PB = F.ws + WS_AR + AR_PB;
    const float* k_a = a.in[F.z + 17] + (size_t)l * 512;
    constexpr int LDA = 72, GLD = 36, M2D = 24;
    LAS unsigned char* pw = F.lds + RING_OFF + F.wave * 15360;
    LAS bf16* AR = (LAS bf16*)pw; LAS bf16* BK = (LAS bf16*)(pw + 4608); LAS float* GL = (LAS float*)(pw + 9216); LAS bf16* VL = (LAS bf16*)(pw + 9216); LAS bf16* M2 = (LAS bf16*)(pw + 13824);
    const int L = F.lane, li = L & 31, hh = L >> 5;
#define PREP_LOAD(dst, it_, hb_) do { const int sc_ = (it_) / RW_CS, c_ = seg * RW_CS + (it_) % RW_CS, seq_ = sc_ >> 4, h_ = (sc_ >> 1) & 7, z_ = sc_ & 1; \
        _Pragma("unroll") for (int t8 = 0; t8 < 8; ++t8) { const int tau = 16 * c_ + 8 * (hb_) + t8, pos = z_ ? (SEQ - 1 - tau) : tau; const size_t tok = (size_t)seq_ * SEQ + pos; \
            dst[t8][0] = EA[tok * 2048 + z_ * 512 + h_ * 64 + L]; dst[t8][1] = EA[tok * 2048 + 1024 + z_ * 512 + h_ * 64 + L]; \
            dst[t8][2] = RK[tok * 2048 + h_ * 64 + L]; dst[t8][3] = RK[tok * 2048 + 512 + h_ * 64 + L]; dst[t8][4] = RK[tok * 2048 + 1024 + h_ * 64 + L]; dst[t8][5] = RK[tok * 2048 + 1536 + h_ * 64 + L]; } } while (0)
#define PREP_HALF(src_, hb_) do { _Pragma("unroll") for (int t8 = 0; t8 < 8; ++t8) { const int t = 8 * (hb_) + t8; \
            const float e_ = h1(src_[t8][0]), a_ = h1(src_[t8][1]), r_ = h1(src_[t8][2]), k_ = h1(src_[t8][3]), v_ = h1(src_[t8][4]), kk_ = h1(src_[t8][5]); \
            cum += e_; gam = fexp(-cum); const float ig = fexp(cum); \
            const float at = -kk_ * gprev, bt = kk_ * a_ * ig, kt = k_ * (1.0f + (a_ - 1.0f) * ka) * ig, rt = r_ * gam; \
            atf[t] = at; \
            AR[t * LDA + L] = (bf16)f2bf(at); AR[(16 + t) * LDA + L] = (bf16)f2bf(rt); BK[t * LDA + L] = (bf16)f2bf(bt); BK[(16 + t) * LDA + L] = (bf16)f2bf(kt); VL[t * LDA + L] = (bf16)f2bf(v_); \
            gprev = gam; } } while (0)
    unsigned short raw0[8][6], raw1[8][6];
    if (F.gw < 160 * RW_CS) PREP_LOAD(raw0, F.gw, 0);
    for (int item = F.gw; item < 160 * RW_CS; item += F.NGW) {
        const int sc = item / RW_CS, cl = item % RW_CS, h = (sc >> 1) & 7;
        unsigned char* rec = PB + (size_t)(sc * RW_CS + cl) * RW_PBB;
        const float ka = k_a[h * 64 + L];
        float atf[16]; float cum = 0.f, gprev = 1.f, gam = 1.f;
        PREP_LOAD(raw1, item, 1);
        asm volatile("" ::: "memory");
        PREP_HALF(raw0, 0);
        { const int nit = (item + F.NGW < 160 * RW_CS) ? item + F.NGW : item; PREP_LOAD(raw0, nit, 0); }
        asm volatile("" ::: "memory");
        PREP_HALF(raw1, 1);
        *(float*)(rec + 12288 + 4 * L) = gam;
        LDS_WAIT(); asm volatile("" ::: "memory");
#pragma unroll
        for (int vt = 0; vt < 2; ++vt) { v4u w;
#pragma unroll
            for (int q = 0; q < 4; ++q) w[q] = lds_u16(VL + (8 * hh + 2 * q) * LDA + 32 * vt + li) | (lds_u16(VL + (8 * hh + 2 * q + 1) * LDA + 32 * vt + li) << 16);
            *(v4u*)(rec + 10240 + vt * 1024 + 16 * L) = w; }
#pragma unroll
        for (int kt = 0; kt < 2; ++kt) { v4u w, w2;
#pragma unroll
            for (int q = 0; q < 4; ++q) { w[q] = lds_u16(BK + (16 + 8 * hh + 2 * q) * LDA + 32 * kt + li) | (lds_u16(BK + (16 + 8 * hh + 2 * q + 1) * LDA + 32 * kt + li) << 16);
                const int j0 = 2 * q, j1 = 2 * q + 1, s0 = 8 * (j0 >> 2) + 4 * hh + (j0 & 3), s1 = 8 * (j1 >> 2) + 4 * hh + (j1 & 3);
                w2[q] = lds_u16(BK + s0 * LDA + 32 * kt + li) | (lds_u16(BK + s1 * LDA + 32 * kt + li) << 16); }
            *(v4u*)(rec + 7168 + kt * 1024 + 16 * L) = w; *(v4u*)(rec + 5120 + kt * 1024 + 16 * L) = w2; }
        f32x16 g;
#pragma unroll
        for (int e = 0; e < 16; ++e) g[e] = 0.f;
#pragma unroll
        for (int ks = 0; ks < 4; ++ks) { const bf16x8 af = *(const LAS bf16x8*)(AR + li * LDA + 16 * ks + 8 * hh); const bf16x8 bf = *(const LAS bf16x8*)(BK + li * LDA + 16 * ks + 8 * hh); g = MFMA32(af, bf, g); }
        LDS_WAIT(); asm volatile("" ::: "memory");
#pragma unroll
        for (int e = 0; e < 16; ++e) GL[((e & 3) + 8 * (e >> 2) + 4 * hh) * GLD + li] = g[e];
        LDS_WAIT(); asm volatile("" ::: "memory");
        float y2[16];
#pragma unroll
        for (int t = 0; t < 16; ++t) y2[t] = (L < 16 && L < t) ? GL[t * GLD + 16 + (L & 15)] : 0.f;
#pragma unroll
        for (int t = 1; t < 16; ++t) {
            float cf[16];
#pragma unroll
            for (int q = 0; q < 4; ++q) { if (4 * q < t) { const f32x4 c4 = *(const LAS f32x4*)(GL + t * GLD + 4 * q); cf[4 * q] = c4.x; cf[4 * q + 1] = c4.y; cf[4 * q + 2] = c4.z; cf[4 * q + 3] = c4.w; } }
#pragma unroll
            for (int s = 0; s < 16; ++s) if (s < t) { atf[t] += cf[s] * atf[s]; y2[t] += cf[s] * y2[s]; }
        }
#pragma unroll
        for (int t = 0; t < 16; ++t) { AR[t * LDA + L] = (bf16)f2bf(atf[t]); if (L < 16) M2[t * M2D + L] = (bf16)f2bf(y2[t]); }
        { const int t = L >> 2, s0 = 4 * (L & 3); const f32x4 c4 = *(const LAS f32x4*)(GL + (16 + t) * GLD + 16 + s0);
          v2u w; w.x = pk2(s0 <= t ? c4.x : 0.f, s0 + 1 <= t ? c4.y : 0.f); w.y = pk2(s0 + 2 <= t ? c4.z : 0.f, s0 + 3 <= t ? c4.w : 0.f);
          *(LAS v2u*)(M2 + (16 + t) * M2D + s0) = w; }
        LDS_WAIT(); asm volatile("" ::: "memory");
#pragma unroll
        for (int ks = 0; ks < 4; ++ks) { const v2u p0 = *(const LAS v2u*)(AR + li * LDA + 16 * ks + 4 * hh), p1 = *(const LAS v2u*)(AR + li * LDA + 16 * ks + 8 + 4 * hh);
            v4u w; w.x = p0.x; w.y = p0.y; w.z = p1.x; w.w = p1.y; *(v4u*)(rec + ks * 1024 + 16 * L) = w; }
        *(v4u*)(rec + 4096 + 16 * L) = *(const LAS v4u*)(M2 + li * M2D + 8 * hh);
        { v4u w = {0u, 0u, 0u, 0u};
          if (li >= 16) { const int t = li - 16; const f32x4 c0 = *(const LAS f32x4*)(GL + (16 + t) * GLD + 4 * hh), c1 = *(const LAS f32x4*)(GL + (16 + t) * GLD + 8 + 4 * hh); const int s0 = 4 * hh, s1 = 8 + 4 * hh;
              w.x = pk2(s0 <= t ? c0.x : 0.f, s0 + 1 <= t ? c0.y : 0.f); w.y = pk2(s0 + 2 <= t ? c0.z : 0.f, s0 + 3 <= t ? c0.w : 0.f);
              w.z = pk2(s1 <= t ? c1.x : 0.f, s1 + 1 <= t ? c1.y : 0.f); w.w = pk2(s1 + 2 <= t ? c1.z : 0.f, s1 + 3 <= t ? c1.w : 0.f); }
          *(v4u*)(rec + 9216 + 16 * L) = w; }
        LDS_WAIT(); asm volatile("" ::: "memory");
    }
#undef PREP_LOAD
#undef PREP_HALF
}
__device__ __forceinline__ void phase_rwkv_fused(const Frame& F, const Args& a, int l) {
    if (F.bid >= 160) return;
    const int sc = F.bid, seq = sc >> 4, h = (sc >> 1) & 7, z = sc & 1;
    constexpr int NCH = SEQ / 16, FR_RING = 6 * 15360, FR_FLAGS = FR_RING + 3 * RW_PBB;
    LAS unsigned char* ring = F.lds + RING_OFF + FR_RING;
    volatile LAS unsigned* ready = (volatile LAS unsigned*)(F.lds + RING_OFF + FR_FLAGS);
    volatile LAS unsigned* done = ready + 4;
    bf16* YS = (bf16*)(F.ws + WS_AR + AR_YSB);
    __syncthreads();
    if (F.tid < 16) ready[F.tid] = 0u;
    __syncthreads();
    if (F.wave >= 2) {
    const unsigned short* EA = (const unsigned short*)(F.ws + WS_AR + AR_EA); const unsigned short* RK = (const unsigned short*)(F.ws + WS_AR + AR_RKVK);
    const float* k_a = a.in[F.z + 17] + (size_t)l * 512;
    constexpr int LDA = 72, GLD = 36, M2D = 24;
    LAS unsigned char* pw = F.lds + RING_OFF + (F.wave - 2) * 15360;
    LAS bf16* AR = (LAS bf16*)pw; LAS bf16* BK = (LAS bf16*)(pw + 4608); LAS float* GL = (LAS float*)(pw + 9216); LAS bf16* VL = (LAS bf16*)(pw + 9216); LAS bf16* M2 = (LAS bf16*)(pw + 13824);
    const int L = F.lane, li = L & 31, hh = L >> 5;
#define PREP_LOAD(dst, it_, hb_) do { const int c_ = (it_), seq_ = seq, h_ = h, z_ = z; \
        _Pragma("unroll") for (int t8 = 0; t8 < 8; ++t8) { const int tau = 16 * c_ + 8 * (hb_) + t8, pos = z_ ? (SEQ - 1 - tau) : tau; const size_t tok = (size_t)seq_ * SEQ + pos; \
            dst[t8][0] = EA[tok * 2048 + z_ * 512 + h_ * 64 + L]; dst[t8][1] = EA[tok * 2048 + 1024 + z_ * 512 + h_ * 64 + L]; \
            dst[t8][2] = RK[tok * 2048 + h_ * 64 + L]; dst[t8][3] = RK[tok * 2048 + 512 + h_ * 64 + L]; dst[t8][4] = RK[tok * 2048 + 1024 + h_ * 64 + L]; dst[t8][5] = RK[tok * 2048 + 1536 + h_ * 64 + L]; } } while (0)
#define PREP_HALF(src_, hb_) do { _Pragma("unroll") for (int t8 = 0; t8 < 8; ++t8) { const int t = 8 * (hb_) + t8; \
            const float e_ = h1(src_[t8][0]), a_ = h1(src_[t8][1]), r_ = h1(src_[t8][2]), k_ = h1(src_[t8][3]), v_ = h1(src_[t8][4]), kk_ = h1(src_[t8][5]); \
            cum += e_; gam = fexp(-cum); const float ig = fexp(cum); \
            const float at = -kk_ * gprev, bt = kk_ * a_ * ig, kt = k_ * (1.0f + (a_ - 1.0f) * ka) * ig, rt = r_ * gam; \
            atf[t] = at; \
            AR[t * LDA + L] = (bf16)f2bf(at); AR[(16 + t) * LDA + L] = (bf16)f2bf(rt); BK[t * LDA + L] = (bf16)f2bf(bt); BK[(16 + t) * LDA + L] = (bf16)f2bf(kt); VL[t * LDA + L] = (bf16)f2bf(v_); \
            gprev = gam; } } while (0)
    unsigned short raw0[8][6], raw1[8][6];
    const float ka_ = k_a[h * 64 + L];
    PREP_LOAD(raw0, F.wave - 2, 0); PREP_LOAD(raw1, F.wave - 2, 1);
    for (int item = F.wave - 2; item < NCH; item += 6) {
        v4u frv[2]; float gamC;
        const float ka = ka_;
        float atf[16]; float cum = 0.f, gprev = 1.f, gam = 1.f;
        asm volatile("" ::: "memory");
        PREP_HALF(raw0, 0);
        PREP_HALF(raw1, 1);
        gamC = gam;
        LDS_WAIT(); asm volatile("" ::: "memory");
#pragma unroll
        for (int vt = 0; vt < 2; ++vt) { v4u w;
#pragma unroll
            for (int q = 0; q < 4; ++q) w[q] = lds_u16(VL + (8 * hh + 2 * q) * LDA + 32 * vt + li) | (lds_u16(VL + (8 * hh + 2 * q + 1) * LDA + 32 * vt + li) << 16);
            frv[vt] = w; }
        f32x16 g;
#pragma unroll
        for (int e = 0; e < 16; ++e) g[e] = 0.f;
#pragma unroll
        for (int ks = 0; ks < 4; ++ks) { const bf16x8 af = *(const LAS bf16x8*)(AR + li * LDA + 16 * ks + 8 * hh); const bf16x8 bf = *(const LAS bf16x8*)(BK + li * LDA + 16 * ks + 8 * hh); g = MFMA32(af, bf, g); }
        LDS_WAIT(); asm volatile("" ::: "memory");
#pragma unroll
        for (int e = 0; e < 16; ++e) GL[((e & 3) + 8 * (e >> 2) + 4 * hh) * GLD + li] = g[e];
        LDS_WAIT(); asm volatile("" ::: "memory");
        float y2[16];
#pragma unroll
        for (int t = 0; t < 16; ++t) y2[t] = (L < 16 && L < t) ? GL[t * GLD + 16 + (L & 15)] : 0.f;
#pragma unroll
        for (int t = 1; t < 16; ++t) {
            float cf[16];
#pragma unroll
            for (int q = 0; q < 4; ++q) { if (4 * q < t) { const f32x4 c4 = *(const LAS f32x4*)(GL + t * GLD + 4 * q); cf[4 * q] = c4.x; cf[4 * q + 1] = c4.y; cf[4 * q + 2] = c4.z; cf[4 * q + 3] = c4.w; } }
#pragma unroll
            for (int s = 0; s < 16; ++s) if (s < t) { atf[t] += cf[s] * atf[s]; y2[t] += cf[s] * y2[s]; }
        }
#pragma unroll
        for (int t = 0; t < 16; ++t) { AR[t * LDA + L] = (bf16)f2bf(atf[t]); if (L < 16) M2[t * M2D + L] = (bf16)f2bf(y2[t]); }
        { const int t = L >> 2, s0 = 4 * (L & 3); const f32x4 c4 = *(const LAS f32x4*)(GL + (16 + t) * GLD + 16 + s0);
          v2u w; w.x = pk2(s0 <= t ? c4.x : 0.f, s0 + 1 <= t ? c4.y : 0.f); w.y = pk2(s0 + 2 <= t ? c4.z : 0.f, s0 + 3 <= t ? c4.w : 0.f);
          *(LAS v2u*)(M2 + (16 + t) * M2D + s0) = w; }
        LDS_WAIT(); asm volatile("" ::: "memory");
        { const int nit = (item + 6 < NCH) ? item + 6 : item; PREP_LOAD(raw0, nit, 0); PREP_LOAD(raw1, nit, 1); }
        asm volatile("" ::: "memory");
        const int slot = item % 3;
        if (item >= 3) { unsigned sp = 0; while ((done[slot * 2] < (unsigned)(item - 2) || done[slot * 2 + 1] < (unsigned)(item - 2)) && ++sp < (1u << 22)) __builtin_amdgcn_s_sleep(1); }
        asm volatile("" ::: "memory");
        LAS unsigned char* rp = ring + slot * RW_PBB;
#pragma unroll
        for (int ks = 0; ks < 4; ++ks) { const v2u p0 = *(const LAS v2u*)(AR + li * LDA + 16 * ks + 4 * hh), p1 = *(const LAS v2u*)(AR + li * LDA + 16 * ks + 8 + 4 * hh);
            v4u w; w.x = p0.x; w.y = p0.y; w.z = p1.x; w.w = p1.y; *(LAS v4u*)(rp + ks * 1024 + 16 * L) = w; }
        { const v4u w4 = *(const LAS v4u*)(M2 + li * M2D + 8 * hh); *(LAS v4u*)(rp + 4096 + 16 * L) = w4; }
        { v4u w = {0u, 0u, 0u, 0u};
          if (li >= 16) { const int t = li - 16; const f32x4 c0 = *(const LAS f32x4*)(GL + (16 + t) * GLD + 4 * hh), c1 = *(const LAS f32x4*)(GL + (16 + t) * GLD + 8 + 4 * hh); const int s0 = 4 * hh, s1 = 8 + 4 * hh;
              w.x = pk2(s0 <= t ? c0.x : 0.f, s0 + 1 <= t ? c0.y : 0.f); w.y = pk2(s0 + 2 <= t ? c0.z : 0.f, s0 + 3 <= t ? c0.w : 0.f);
              w.z = pk2(s1 <= t ? c1.x : 0.f, s1 + 1 <= t ? c1.y : 0.f); w.w = pk2(s1 + 2 <= t ? c1.z : 0.f, s1 + 3 <= t ? c1.w : 0.f); }
          *(LAS v4u*)(rp + 9216 + 16 * L) = w; }
#pragma unroll
        for (int kt = 0; kt < 2; ++kt) { v4u w, w2;
#pragma unroll
            for (int q = 0; q < 4; ++q) { w[q] = lds_u16(BK + (16 + 8 * hh + 2 * q) * LDA + 32 * kt + li) | (lds_u16(BK + (16 + 8 * hh + 2 * q + 1) * LDA + 32 * kt + li) << 16);
                const int j0 = 2 * q, j1 = 2 * q + 1, s0 = 8 * (j0 >> 2) + 4 * hh + (j0 & 3), s1 = 8 * (j1 >> 2) + 4 * hh + (j1 & 3);
                w2[q] = lds_u16(BK + s0 * LDA + 32 * kt + li) | (lds_u16(BK + s1 * LDA + 32 * kt + li) << 16); }
            *(LAS v4u*)(rp + 7168 + kt * 1024 + 16 * L) = w; *(LAS v4u*)(rp + 5120 + kt * 1024 + 16 * L) = w2; }
        LDS_WAIT(); asm volatile("" ::: "memory");
        *(LAS v4u*)(rp + 10240 + 16 * L) = frv[0]; *(LAS v4u*)(rp + 11264 + 16 * L) = frv[1];
        *(LAS float*)(rp + 12288 + 4 * L) = gamC;
        LDS_WAIT(); asm volatile("" ::: "memory");
        if (L == 0) ready[slot] = (unsigned)(item + 1);
    }
#undef PREP_LOAD
#undef PREP_HALF
        return;
    }
    const int L = F.lane, li = L & 31, hh = L >> 5, vt = F.wave;
    f32x16 st[2];
#pragma unroll
    for (int kt = 0; kt < 2; ++kt)
#pragma unroll
        for (int e = 0; e < 16; ++e) st[kt][e] = 0.f;
    for (int cl = 0; cl < NCH; ++cl) {
        const int slot = cl % 3;
        { unsigned sp = 0; while (ready[slot] != (unsigned)(cl + 1) && ++sp < (1u << 22)) __builtin_amdgcn_s_sleep(1); }
        asm volatile("" ::: "memory");
        const LAS unsigned char* rec = ring + slot * RW_PBB;
        bf16x8 a1[4], btf[2], ktf[2]; f32x4 gm[2][4];
#pragma unroll
        for (int ks = 0; ks < 4; ++ks) a1[ks] = *(const LAS bf16x8*)(rec + ks * 1024 + 16 * L);
        const bf16x8 a2 = *(const LAS bf16x8*)(rec + 4096 + 16 * L), mbr = *(const LAS bf16x8*)(rec + 9216 + 16 * L), vc = *(const LAS bf16x8*)(rec + 10240 + vt * 1024 + 16 * L);
#pragma unroll
        for (int kt = 0; kt < 2; ++kt) { btf[kt] = *(const LAS bf16x8*)(rec + 5120 + kt * 1024 + 16 * L); ktf[kt] = *(const LAS bf16x8*)(rec + 7168 + kt * 1024 + 16 * L);
#pragma unroll
            for (int q4 = 0; q4 < 4; ++q4) gm[kt][q4] = *(const LAS f32x4*)(rec + 12288 + 4 * (32 * kt + 8 * q4 + 4 * hh)); }
        LDS_WAIT(); asm volatile("" ::: "memory");
        if (L == 0) done[slot * 2 + vt] = (unsigned)(cl + 1);
        f32x16 acc;
#pragma unroll
        for (int e = 0; e < 16; ++e) acc[e] = 0.f;
        acc = MFMA32(a2, vc, acc);
#pragma unroll
        for (int ks = 0; ks < 4; ++ks) { const int kt = ks >> 1, b8 = 8 * (ks & 1);
            v4u w; w.x = cvt_pk_bf16(st[kt][b8], st[kt][b8 + 1]); w.y = cvt_pk_bf16(st[kt][b8 + 2], st[kt][b8 + 3]); w.z = cvt_pk_bf16(st[kt][b8 + 4], st[kt][b8 + 5]); w.w = cvt_pk_bf16(st[kt][b8 + 6], st[kt][b8 + 7]);
            acc = MFMA32(a1[ks], __builtin_bit_cast(bf16x8, w), acc); }
        v4u uw; uw.x = cvt_pk_bf16(acc[0], acc[1]); uw.y = cvt_pk_bf16(acc[2], acc[3]); uw.z = cvt_pk_bf16(acc[4], acc[5]); uw.w = cvt_pk_bf16(acc[6], acc[7]);
        const bf16x8 uf = __builtin_bit_cast(bf16x8, uw);
        acc = MFMA32(mbr, uf, acc);
#pragma unroll
        for (int kt = 0; kt < 2; ++kt) { st[kt] = MFMA32(btf[kt], uf, st[kt]); st[kt] = MFMA32(ktf[kt], vc, st[kt]);
#pragma unroll
            for (int q4 = 0; q4 < 4; ++q4) { st[kt][4 * q4] *= gm[kt][q4].x; st[kt][4 * q4 + 1] *= gm[kt][q4].y; st[kt][4 * q4 + 2] *= gm[kt][q4].z; st[kt][4 * q4 + 3] *= gm[kt][q4].w; } }
#pragma unroll
        for (int e = 8; e < 16; ++e) { const int t = (e & 3) + 8 * ((e >> 2) - 2) + 4 * hh, tau = 16 * cl + t, pos = z ? (SEQ - 1 - tau) : tau; const size_t tok = (size_t)seq * SEQ + pos;
            YS[((size_t)z * T + tok) * 512 + h * 64 + 32 * vt + li] = (bf16)f2bf(acc[e]); }
    }
}

__device__ __forceinline__ void phase_rwkv_cscan(const Frame& F, int seg) {
    if (F.bid >= 160) return;
    const unsigned char* PB = F.ws + WS_AR + AR_PB; bf16* YS = (bf16*)(F.ws + WS_AR + AR_YSB); float* STS = (float*)(F.ws + WS_AR + AR_STS);
    LAS unsigned char* ring = F.lds + RING_OFF;
    volatile LAS unsigned* ready = (volatile LAS unsigned*)(F.lds + RING_OFF + 8 * RW_PBB);
    volatile LAS unsigned* done = ready + 8;
    const int L = F.lane, li = L & 31, hh = L >> 5, sc = F.bid, seq = sc >> 4, h = (sc >> 1) & 7, z = sc & 1;
    __syncthreads();
    if (F.tid < 24) ready[F.tid] = 0u;
    __syncthreads();
    if (F.wave >= 2) {
        for (int cl = F.wave - 2; cl < RW_CS; cl += 6) {
            const int slot = cl & 7;
            if (cl >= 8) { unsigned sp = 0; while ((done[slot * 2] < (unsigned)(cl - 7) || done[slot * 2 + 1] < (unsigned)(cl - 7)) && ++sp < (1u << 22)) __builtin_amdgcn_s_sleep(1); }
            asm volatile("" ::: "memory");
            const unsigned char* rec = PB + (size_t)(sc * RW_CS + cl) * RW_PBB;
            v4u r[13];
#pragma unroll
            for (int i = 0; i < 13; ++i) { const int o = (i * 64 + L) * 16; r[i] = (o < RW_PBB) ? *(const v4u*)(rec + o) : (v4u){0u, 0u, 0u, 0u}; }
#pragma unroll
            for (int i = 0; i < 13; ++i) { const int o = (i * 64 + L) * 16; if (o < RW_PBB) *(LAS v4u*)(ring + slot * RW_PBB + o) = r[i]; }
            LDS_WAIT(); asm volatile("" ::: "memory");
            if (L == 0) ready[slot] = (unsigned)(cl + 1);
        }
        return;
    }
    const int vt = F.wave;
    f32x16 st[2];
    float* sts = STS + ((size_t)(sc * 2 + vt) * 2) * 1024 + L;
#pragma unroll
    for (int kt = 0; kt < 2; ++kt)
#pragma unroll
        for (int e = 0; e < 16; ++e) st[kt][e] = (seg == 0) ? 0.f : sts[(kt * 16 + e) * 64];
    for (int cl = 0; cl < RW_CS; ++cl) {
        const int slot = cl & 7;
        { unsigned sp = 0; while (ready[slot] != (unsigned)(cl + 1) && ++sp < (1u << 22)) __builtin_amdgcn_s_sleep(1); }
        asm volatile("" ::: "memory");
        const LAS unsigned char* rec = ring + slot * RW_PBB;
        bf16x8 a1[4], btf[2], ktf[2]; f32x4 gm[2][4];
#pragma unroll
        for (int ks = 0; ks < 4; ++ks) a1[ks] = *(const LAS bf16x8*)(rec + ks * 1024 + 16 * L);
        const bf16x8 a2 = *(const LAS bf16x8*)(rec + 4096 + 16 * L), mbr = *(const LAS bf16x8*)(rec + 9216 + 16 * L), vc = *(const LAS bf16x8*)(rec + 10240 + vt * 1024 + 16 * L);
#pragma unroll
        for (int kt = 0; kt < 2; ++kt) { btf[kt] = *(const LAS bf16x8*)(rec + 5120 + kt * 1024 + 16 * L); ktf[kt] = *(const LAS bf16x8*)(rec + 7168 + kt * 1024 + 16 * L);
#pragma unroll
            for (int q4 = 0; q4 < 4; ++q4) gm[kt][q4] = *(const LAS f32x4*)(rec + 12288 + 4 * (32 * kt + 8 * q4 + 4 * hh)); }
        LDS_WAIT(); asm volatile("" ::: "memory");
        if (L == 0) done[slot * 2 + vt] = (unsigned)(cl + 1);
        f32x16 acc;
#pragma unroll
        for (int e = 0; e < 16; ++e) acc[e] = 0.f;
        acc = MFMA32(a2, vc, acc);
#pragma unroll
        for (int ks = 0; ks < 4; ++ks) { const int kt = ks >> 1, b8 = 8 * (ks & 1);
            v4u w; w.x = cvt_pk_bf16(st[kt][b8], st[kt][b8 + 1]); w.y = cvt_pk_bf16(st[kt][b8 + 2], st[kt][b8 + 3]); w.z = cvt_pk_bf16(st[kt][b8 + 4], st[kt][b8 + 5]); w.w = cvt_pk_bf16(st[kt][b8 + 6], st[kt][b8 + 7]);
            acc = MFMA32(a1[ks], __builtin_bit_cast(bf16x8, w), acc); }
        v4u uw; uw.x = cvt_pk_bf16(acc[0], acc[1]); uw.y = cvt_pk_bf16(acc[2], acc[3]); uw.z = cvt_pk_bf16(acc[4], acc[5]); uw.w = cvt_pk_bf16(acc[6], acc[7]);
        const bf16x8 uf = __builtin_bit_cast(bf16x8, uw);
        acc = MFMA32(mbr, uf, acc);
#pragma unroll
        for (int kt = 0; kt < 2; ++kt) { st[kt] = MFMA32(btf[kt], uf, st[kt]); st[kt] = MFMA32(ktf[kt], vc, st[kt]);
#pragma unroll
            for (int q4 = 0; q4 < 4; ++q4) { st[kt][4 * q4] *= gm[kt][q4].x; st[kt][4 * q4 + 1] *= gm[kt][q4].y; st[kt][4 * q4 + 2] *= gm[kt][q4].z; st[kt][4 * q4 + 3] *= gm[kt][q4].w; } }
        const int c = seg * RW_CS + cl;
#pragma unroll
        for (int e = 8; e < 16; ++e) { const int t = (e & 3) + 8 * ((e >> 2) - 2) + 4 * hh, tau = 16 * c + t, pos = z ? (SEQ - 1 - tau) : tau; const size_t tok = (size_t)seq * SEQ + pos;
            YS[((size_t)z * T + tok) * 512 + h * 64 + 32 * vt + li] = (bf16)f2bf(acc[e]); }
    }
#pragma unroll
    for (int kt = 0; kt < 2; ++kt)
#pragma unroll
        for (int e = 0; e < 16; ++e) sts[(kt * 16 + e) * 64] = st[kt][e];
}

__device__ __forceinline__ void phase_rwkv_post(const Frame& F, const Args& a, int l) {
    const unsigned short* EA = (const unsigned short*)(F.ws + WS_AR + AR_EA); const unsigned short* RK = (const unsigned short*)(F.ws + WS_AR + AR_RKVK);
    const bf16* GT = (const bf16*)(F.ws + WS_AR + AR_GT); const float* YS = (const float*)(F.ws + WS_AR + AR_YS); const bf16* YSB = (const bf16*)(F.ws + WS_AR + AR_YSB); bf16* YC = (bf16*)(F.ws + WS_AR + AR_YC); (void)YS; (void)YSB;
    const float* k_a = a.in[F.z + 17] + (size_t)l * 512; const float* r_k = a.in[F.z + 18] + (size_t)l * 512; const float* ln_w = a.in[F.z + 19] + (size_t)l * 512; const float* ln_b = a.in[F.z + 20] + (size_t)l * 512;
    const int lane = F.lane, c0 = 8 * lane;
    for (int t = F.gw; t < T; t += F.NGW) {
        float y[8];
#if MK_CHUNKED
        { const v4u p = *(const v4u*)(YSB + (size_t)t * 512 + c0), q = *(const v4u*)(YSB + ((size_t)T + t) * 512 + c0);
#pragma unroll
          for (int i = 0; i < 4; ++i) { y[2 * i] = bf_lo(p[i]) + bf_lo(q[i]); y[2 * i + 1] = bf_hi(p[i]) + bf_hi(q[i]); } }
#else
        { const f32x4 p0 = *(const f32x4*)(YS + (size_t)t * 512 + c0), p1 = *(const f32x4*)(YS + (size_t)t * 512 + c0 + 4);
          const f32x4 q0 = *(const f32x4*)(YS + ((size_t)T + t) * 512 + c0), q1 = *(const f32x4*)(YS + ((size_t)T + t) * 512 + c0 + 4);
          y[0] = p0.x + q0.x; y[1] = p0.y + q0.y; y[2] = p0.z + q0.z; y[3] = p0.w + q0.w; y[4] = p1.x + q1.x; y[5] = p1.y + q1.y; y[6] = p1.z + q1.z; y[7] = p1.w + q1.w; }
#endif
        const v4u rr = *(const v4u*)(RK + (size_t)t * 2048 + c0), kk = *(const v4u*)(RK + (size_t)t * 2048 + 512 + c0), vv = *(const v4u*)(RK + (size_t)t * 2048 + 1024 + c0);
        const v4u a0 = *(const v4u*)(EA + (size_t)t * 2048 + 1024 + c0), a1 = *(const v4u*)(EA + (size_t)t * 2048 + 1536 + c0);
        const v4u gg = *(const v4u*)(GT + (size_t)t * 512 + c0);
        float r[8], k[8], v[8], aa0[8], aa1[8], g[8];
#pragma unroll
        for (int q = 0; q < 4; ++q) { r[2 * q] = h_lo(rr[q]); r[2 * q + 1] = h_hi(rr[q]); k[2 * q] = h_lo(kk[q]); k[2 * q + 1] = h_hi(kk[q]); v[2 * q] = h_lo(vv[q]); v[2 * q + 1] = h_hi(vv[q]);
            aa0[2 * q] = h_lo(a0[q]); aa0[2 * q + 1] = h_hi(a0[q]); aa1[2 * q] = h_lo(a1[q]); aa1[2 * q + 1] = h_hi(a1[q]); g[2 * q] = bf_lo(gg[q]); g[2 * q + 1] = bf_hi(gg[q]); }
        float s = 0.f, bon = 0.f;
#pragma unroll
        for (int e = 0; e < 8; ++e) { s += y[e]; const float kaa = k_a[c0 + e]; bon += r[e] * k[e] * r_k[c0 + e] * ((1.0f + (aa0[e] - 1.0f) * kaa) + (1.0f + (aa1[e] - 1.0f) * kaa)); }
        s += shfl_xor_(s, 1); s += shfl_xor_(s, 2); s += shfl_xor_(s, 4);
        bon += shfl_xor_(bon, 1); bon += shfl_xor_(bon, 2); bon += shfl_xor_(bon, 4);
        const float mu = s * (1.0f / 64.0f); float q2 = 0.f;
#pragma unroll
        for (int e = 0; e < 8; ++e) { const float d_ = y[e] - mu; q2 += d_ * d_; }
        q2 += shfl_xor_(q2, 1); q2 += shfl_xor_(q2, 2); q2 += shfl_xor_(q2, 4);
        const float rstd = 1.0f / sqrtf(q2 * (1.0f / 64.0f) + 64e-5f);
        float o[8];
#pragma unroll
        for (int e = 0; e < 8; ++e) o[e] = (((y[e] - mu) * rstd) * ln_w[c0 + e] + ln_b[c0 + e] + bon * v[e]) * g[e];
        v4u w; w.x = pk2(o[0], o[1]); w.y = pk2(o[2], o[3]); w.z = pk2(o[4], o[5]); w.w = pk2(o[6], o[7]);
        *(v4u*)(YC + (size_t)t * 512 + c0) = w;
    }
}

__device__ __forceinline__ void phase_attn(const Frame& F, const Args& a) {
    const bf16* QA = (const bf16*)(F.ws + WS_AR + AR_QA); const bf16* KA = (const bf16*)(F.ws + WS_AR + AR_KA); const bf16* VTA = (const bf16*)(F.ws + WS_AR + AR_VTA);
    bf16* OA = (bf16*)(F.ws + WS_AR + AR_OA); float* LSE = (float*)(F.ws + WS_AR + AR_LSE);
    constexpr int PLD = 336;
    LAS unsigned char* Pw = F.lds + RING_OFF + F.wave * (32 * PLD);
    const int lane = F.lane, li = lane & 31, hh = lane >> 5;
    for (int w = F.gw; w < 15360; w += F.NGW) {
        const int h = w & 3, pq = (w >> 2) & 127, rest = w >> 9, seq = rest % 10, g = rest / 10;
        const int d = (g == 0) ? 1 : (g == 1 ? 4 : 16), Lg = SEQ / d, nqb = Lg / 32, p = pq / nqb, qb = pq % nqb;
        const size_t base = (size_t)seq * SEQ + (size_t)p * Lg;
        const float slope = __builtin_amdgcn_exp2f(-8.0f * (float)(g * 4 + h + 1) / 12.0f) * (float)d;
        const bf16* Qg = QA + (size_t)g * T * 512; const bf16* Kg = KA + (size_t)g * T * 512; const bf16* Vg = VTA + (size_t)g * 512 * T;
        f32x16 x[5]; bool tv[5]; int sc_[5];
#pragma unroll
        for (int kt = 0; kt < 5; ++kt) { const int s_t = 32 * qb - 64 + 32 * kt; tv[kt] = (s_t >= 0) && (s_t < Lg); sc_[kt] = tv[kt] ? s_t : 32 * qb;
#pragma unroll
            for (int e = 0; e < 16; ++e) x[kt][e] = 0.f; }
        { bf16x8 ka[8], kb[8];
          { bf16x8 qf[8];
#pragma unroll
            for (int ks = 0; ks < 8; ++ks) qf[ks] = *(const bf16x8*)(Qg + ((((base + 32 * qb) >> 5) * 4 + h) * 8 + ks) * 512 + lane * 8);
#pragma unroll
            for (int ks = 0; ks < 8; ++ks) *(LAS bf16x8*)(Pw + li * PLD + (16 * ks + 8 * hh) * 2) = qf[ks]; }
#pragma unroll
          for (int ks = 0; ks < 8; ++ks) { ka[ks] = *(const bf16x8*)(Kg + ((((base + sc_[0]) >> 5) * 4 + h) * 8 + ks) * 512 + lane * 8); kb[ks] = *(const bf16x8*)(Kg + ((((base + sc_[1]) >> 5) * 4 + h) * 8 + ks) * 512 + lane * 8); }
          asm volatile("" ::: "memory");
          LDS_WAIT(); asm volatile("" ::: "memory");
#pragma unroll
          for (int ks = 0; ks < 8; ++ks) { const bf16x8 q = *(const LAS bf16x8*)(Pw + li * PLD + (16 * ks + 8 * hh) * 2); x[0] = MFMA32(ka[ks], q, x[0]); x[1] = MFMA32(kb[ks], q, x[1]); }
#pragma unroll
          for (int ks = 0; ks < 8; ++ks) { ka[ks] = *(const bf16x8*)(Kg + ((((base + sc_[2]) >> 5) * 4 + h) * 8 + ks) * 512 + lane * 8); kb[ks] = *(const bf16x8*)(Kg + ((((base + sc_[3]) >> 5) * 4 + h) * 8 + ks) * 512 + lane * 8); }
          asm volatile("" ::: "memory");
#pragma unroll
          for (int ks = 0; ks < 8; ++ks) { const bf16x8 q = *(const LAS bf16x8*)(Pw + li * PLD + (16 * ks + 8 * hh) * 2); x[2] = MFMA32(ka[ks], q, x[2]); x[3] = MFMA32(kb[ks], q, x[3]); }
#pragma unroll
          for (int ks = 0; ks < 8; ++ks) ka[ks] = *(const bf16x8*)(Kg + ((((base + sc_[4]) >> 5) * 4 + h) * 8 + ks) * 512 + lane * 8);
          asm volatile("" ::: "memory");
#pragma unroll
          for (int ks = 0; ks < 8; ++ks) { const bf16x8 q = *(const LAS bf16x8*)(Pw + li * PLD + (16 * ks + 8 * hh) * 2); x[4] = MFMA32(ka[ks], q, x[4]); }
          LDS_WAIT(); asm volatile("" ::: "memory");
        }
        float mx = -1e30f;
#pragma unroll
        for (int kt = 0; kt < 5; ++kt)
#pragma unroll
            for (int e = 0; e < 16; ++e) { const int j = (e & 3) + 8 * (e >> 2) + 4 * hh; const int rel = 32 * kt - 64 + j - li; const int ar = rel < 0 ? -rel : rel;
                const bool ok = tv[kt] && ar <= 64; const float sv = ok ? (x[kt][e] - slope * (float)ar) : -1e30f; x[kt][e] = sv; mx = fmaxf(mx, sv); }
        mx = fmaxf(mx, shfl_xor_(mx, 32));
        float sum = 0.f;
#pragma unroll
        for (int kt = 0; kt < 5; ++kt)
#pragma unroll
            for (int e = 0; e < 16; ++e) { const float pv = (x[kt][e] > -1e29f) ? fexp(x[kt][e] - mx) : 0.f; x[kt][e] = pv; sum += pv; }
        sum += shfl_xor_(sum, 32);
        const float inv = 1.0f / sum;
        if (hh == 0) { const size_t tok = (size_t)seq * SEQ + (size_t)(32 * qb + li) * d + p; LSE[((size_t)g * T + tok) * 4 + h] = mx + __builtin_amdgcn_logf(sum) * 0.69314718056f; }
#pragma unroll
        for (int kt = 0; kt < 5; ++kt)
#pragma unroll
            for (int q4 = 0; q4 < 4; ++q4) { v2u pw; pw.x = cvt_pk_bf16(x[kt][4 * q4] * inv, x[kt][4 * q4 + 1] * inv); pw.y = cvt_pk_bf16(x[kt][4 * q4 + 2] * inv, x[kt][4 * q4 + 3] * inv);
                *(LAS v2u*)(Pw + li * PLD + (kt * 32 + 8 * q4 + 4 * hh) * 2) = pw; }
        LDS_WAIT(); asm volatile("" ::: "memory");
#pragma unroll
        for (int dt = 0; dt < 4; ++dt) {
            bf16x8 vf[5][2];
#pragma unroll
            for (int kt = 0; kt < 5; ++kt)
#pragma unroll
                for (int k2 = 0; k2 < 2; ++k2) vf[kt][k2] = *(const bf16x8*)(Vg + ((((size_t)(h * 4 + dt) * (T / 32) + ((base + sc_[kt]) >> 5)) * 2 + k2) * 512 + lane * 8));
            asm volatile("" ::: "memory");
            f32x16 o;
#pragma unroll
            for (int e = 0; e < 16; ++e) o[e] = 0.f;
#pragma unroll
            for (int kt = 0; kt < 5; ++kt)
#pragma unroll
                for (int k2 = 0; k2 < 2; ++k2) { const bf16x8 pf = *(const LAS bf16x8*)(Pw + li * PLD + (kt * 32 + 16 * k2 + 8 * hh) * 2); o = MFMA32(vf[kt][k2], pf, o); }
            { const size_t tok = (size_t)seq * SEQ + (size_t)(32 * qb + li) * d + p; bf16* orow = OA + ((size_t)g * T + tok) * 512 + h * 128 + dt * 32 + 8 * hh;
              *(v4u*)orow = pk8(o, 0); *(v4u*)(orow + 16) = pk8(o, 8); }
        }
        LDS_WAIT(); asm volatile("" ::: "memory");
    }
}
__device__ __forceinline__ void phase_attn_post(const Frame& F, const Args& a) {
    const bf16* OA = (const bf16*)(F.ws + WS_AR + AR_OA); const float* LSE = (const float*)(F.ws + WS_AR + AR_LSE); bf16* YA = (bf16*)(F.ws + WS_AR + AR_YA);
    const int lane = F.lane, c0 = 8 * lane, h = lane >> 4;
    for (int t = F.gw; t < T; t += F.NGW) {
        const float l0 = LSE[((size_t)0 * T + t) * 4 + h], l1 = LSE[((size_t)1 * T + t) * 4 + h], l2 = LSE[((size_t)2 * T + t) * 4 + h];
        const float m = fmaxf(l0, fmaxf(l1, l2)); float w0 = fexp(l0 - m), w1 = fexp(l1 - m), w2 = fexp(l2 - m); const float inv = 1.0f / (w0 + w1 + w2); w0 *= inv; w1 *= inv; w2 *= inv;
        const v4u o0 = *(const v4u*)(OA + ((size_t)0 * T + t) * 512 + c0), o1 = *(const v4u*)(OA + ((size_t)1 * T + t) * 512 + c0), o2 = *(const v4u*)(OA + ((size_t)2 * T + t) * 512 + c0);
        v4u w;
#pragma unroll
        for (int q = 0; q < 4; ++q) w[q] = pk2(w0 * bf_lo(o0[q]) + w1 * bf_lo(o1[q]) + w2 * bf_lo(o2[q]), w0 * bf_hi(o0[q]) + w1 * bf_hi(o1[q]) + w2 * bf_hi(o2[q]));
        *(v4u*)(YA + (size_t)t * 512 + c0) = w;
    }
}

__device__ __forceinline__ void phase_ret_kv(const Frame& F) {
    const bf16* RKT = (const bf16*)(F.ws + WS_AR + AR_RKT); const bf16* RVT = (const bf16*)(F.ws + WS_AR + AR_RVT); bf16* SB = (bf16*)(F.ws + WS_AR + AR_SB);
    const int lane = F.lane, li = lane & 31, hh = lane >> 5, w = F.wave;
    for (int it = F.bid; it < 1280; it += F.G) {
        const int n = it & 31, h = (it >> 5) & 3, seq = it >> 7; const size_t tok0 = (size_t)seq * SEQ + 128 * n;
        const bf16* vrow = RVT + (size_t)(h * 256 + 32 * w + li) * T + tok0 + 8 * hh;
        bf16x8 vf[8];
#pragma unroll
        for (int ks = 0; ks < 8; ++ks) vf[ks] = *(const bf16x8*)(vrow + 16 * ks);
        bf16* sbase = SB + ((size_t)((seq * 4 + h) * 32 + n) * 256 + 32 * w) * 256;
#pragma unroll 1
        for (int t4 = 0; t4 < 4; ++t4) {
            const int z = t4 >> 1, dk0 = 2 * (t4 & 1);
            const bf16* krow = RKT + (size_t)(z * 512 + h * 128 + 32 * dk0 + li) * T + tok0 + 8 * hh;
            bf16x8 kfa[8], kfb[8];
#pragma unroll
            for (int ks = 0; ks < 8; ++ks) { kfa[ks] = *(const bf16x8*)(krow + 16 * ks); kfb[ks] = *(const bf16x8*)(krow + (size_t)32 * T + 16 * ks); }
            asm volatile("" ::: "memory");
            f32x16 acc0, acc1;
#pragma unroll
            for (int e = 0; e < 16; ++e) { acc0[e] = 0.f; acc1[e] = 0.f; }
#pragma unroll
            for (int ks = 0; ks < 8; ++ks) { acc0 = MFMA32(vf[ks], kfa[ks], acc0); acc1 = MFMA32(vf[ks], kfb[ks], acc1); }
#pragma unroll
            for (int e = 0; e < 16; ++e) { const int dv = (e & 3) + 8 * (e >> 2) + 4 * hh; sbase[(size_t)dv * 256 + z * 128 + 32 * dk0 + li] = (bf16)f2bf(acc0[e]); sbase[(size_t)dv * 256 + z * 128 + 32 * dk0 + 32 + li] = (bf16)f2bf(acc1[e]); }
        }
    }
}
__device__ __forceinline__ void phase_ret_prefix(const Frame& F, const Args& a, int l) {
    bf16* SB = (bf16*)(F.ws + WS_AR + AR_SB); const float* dlog = a.in[F.z + 8] + (size_t)l * 8;
    const int gt = F.bid * NTHR + F.tid, NGT = F.G * NTHR;
    for (int i = gt; i < 40 * 8192; i += NGT) {
        const int p = i >> 13, v = i & 8191, h = p & 3, z = (v >> 4) & 1;
        const float lg = dlog[z * 4 + h]; const float g = __builtin_amdgcn_exp2f(-__builtin_amdgcn_logf(1.0f + fexp(-lg)) * 128.0f);
        bf16* base = SB + (size_t)p * 32 * 65536 + (size_t)v * 8;
        float carry[8];
#pragma unroll
        for (int e = 0; e < 8; ++e) carry[e] = 0.f;
#pragma unroll 4
        for (int st = 0; st < 32; ++st) {
            const int n = z ? (31 - st) : st; v4u* ptr = (v4u*)(base + (size_t)n * 65536);
            const v4u kv = *ptr; v4u o;
#pragma unroll
            for (int q = 0; q < 4; ++q) { o[q] = pk2(carry[2 * q], carry[2 * q + 1]); carry[2 * q] = g * carry[2 * q] + bf_lo(kv[q]); carry[2 * q + 1] = g * carry[2 * q + 1] + bf_hi(kv[q]); }
            *ptr = o;
        }
    }
}
__device__ __forceinline__ void phase_ret_state(const Frame& F, const Args& a, int l) {
    const bf16* RKT = (const bf16*)(F.ws + WS_AR + AR_RKT); const bf16* RVT = (const bf16*)(F.ws + WS_AR + AR_RVT); bf16* SB = (bf16*)(F.ws + WS_AR + AR_SB);
    const float* dlog = a.in[F.z + 8] + (size_t)l * 8;
    const int lane = F.lane, li = lane & 31, hh = lane >> 5;
    if (F.wave >= 5) return;
    for (int q = F.bid * 5 + F.wave; q < 1280; q += F.G * 5) {
        const int kh = q & 1, dt = (q >> 1) & 7, z = (q >> 4) & 1, h = (q >> 5) & 3, seq = q >> 7;
        const float g = __builtin_amdgcn_exp2f(-__builtin_amdgcn_logf(1.0f + fexp(-dlog[z * 4 + h])) * 128.0f);
        const bf16* krow = RKT + ((size_t)((z * 4 + h) * 4 + 2 * kh) * (T / 16) + seq * (SEQ / 16)) * 512 + lane * 8;
        const bf16* vrow = RVT + ((size_t)(h * 8 + dt) * (T / 16) + seq * (SEQ / 16)) * 512 + lane * 8;
        bf16* srow = SB + ((((size_t)((seq * 4 + h) * 32) * 8 + dt) * 2 + z) * 8 + 4 * kh) * 512 + lane * 8;
        f32x16 acc0, acc1;
#pragma unroll
        for (int e = 0; e < 16; ++e) { acc0[e] = 0.f; acc1[e] = 0.f; }
        bf16x8 vf[8], kfa[8], kfb[8];
        { const int n0 = z ? 31 : 0;
#pragma unroll
          for (int ks = 0; ks < 8; ++ks) { vf[ks] = *(const bf16x8*)(vrow + 4096 * n0 + 512 * ks); kfa[ks] = *(const bf16x8*)(krow + 4096 * n0 + 512 * ks); kfb[ks] = *(const bf16x8*)(krow + (size_t)(T / 16) * 512 + 4096 * n0 + 512 * ks); } }
#pragma unroll 1
        for (int st = 0; st < 32; ++st) {
            const int n = z ? (31 - st) : st; const int st1 = st < 31 ? st + 1 : 31, nn = z ? (31 - st1) : st1;
            bf16* sp = srow + (size_t)n * 65536;
            *(v4u*)sp = pk8(acc0, 0); *(v4u*)(sp + 512) = pk8(acc0, 8); *(v4u*)(sp + 1024) = pk8(acc1, 0); *(v4u*)(sp + 1536) = pk8(acc1, 8);
#pragma unroll
            for (int e = 0; e < 16; ++e) { acc0[e] *= g; acc1[e] *= g; }
#pragma unroll
            for (int ks = 0; ks < 8; ++ks) acc0 = MFMA32(kfa[ks], vf[ks], acc0);
#pragma unroll
            for (int ks = 0; ks < 8; ++ks) kfa[ks] = *(const bf16x8*)(krow + 4096 * nn + 512 * ks);
#pragma unroll
            for (int ks = 0; ks < 8; ++ks) acc1 = MFMA32(kfb[ks], vf[ks], acc1);
#pragma unroll
            for (int ks = 0; ks < 8; ++ks) { kfb[ks] = *(const bf16x8*)(krow + (size_t)(T / 16) * 512 + 4096 * nn + 512 * ks); vf[ks] = *(const bf16x8*)(vrow + 4096 * nn + 512 * ks); }
        }
    }
}
__device__ __forceinline__ void phase_ret_out(const Frame& F, const Args& a, int l) {
    const bf16* RQ = (const bf16*)(F.ws + WS_AR + AR_RQ); const bf16* RKm = (const bf16*)(F.ws + WS_AR + AR_RK); const bf16* RVT = (const bf16*)(F.ws + WS_AR + AR_RVT);
    const bf16* RG = (const bf16*)(F.ws + WS_AR + AR_RG); const bf16* SB = (const bf16*)(F.ws + WS_AR + AR_SB); bf16* YB = (bf16*)(F.ws + WS_AR + AR_YB);
    const float* dlog = a.in[F.z + 8] + (size_t)l * 8; const float* rn = a.in[F.z + 9] + (size_t)l * 1024;
    constexpr int PLD = 272;
    LAS unsigned char* Pl = F.lds + RING_OFF;
    LAS f32x2* SX = (LAS f32x2*)(F.lds + RING_OFF + 4 * 32 * PLD);
    const int lane = F.lane, li = lane & 31, hh = lane >> 5, w = F.wave, qi = w & 3, dj = w >> 2;
    LAS unsigned char* stg = F.lds + RING_OFF + 40960 + w * (32 * PLD);
    for (int it = F.bid; it < 1280; it += F.G) {
        const int n = it & 31, h = (it >> 5) & 3, seq = it >> 7; const size_t tok0 = (size_t)seq * SEQ + 128 * n;
        const float l2g0 = -__builtin_amdgcn_logf(1.0f + fexp(-dlog[h])), l2g1 = -__builtin_amdgcn_logf(1.0f + fexp(-dlog[4 + h]));
        __syncthreads();
        const bf16* qrow = RQ + ((size_t)(((tok0 + 32 * qi) >> 5) * 4 + h) * 8) * 512 + lane * 8;
        bf16x8 qf[8];
#pragma unroll
        for (int ks = 0; ks < 8; ++ks) qf[ks] = *(const bf16x8*)(qrow + 512 * ks);
        const int ip = 32 * qi + li;
#pragma unroll 1
        for (int k2 = 0; k2 < 2; ++k2) {
            const int kt = 2 * dj + k2;
            const bf16* krow_ = RKm + ((size_t)(((tok0 + 32 * kt) >> 5) * 4 + h) * 8) * 512 + lane * 8;
            f32x16 x;
#pragma unroll
            for (int e = 0; e < 16; ++e) x[e] = 0.f;
#pragma unroll
            for (int ks = 0; ks < 8; ++ks) { const bf16x8 kf = *(const bf16x8*)(krow_ + 512 * ks); x = MFMA32(kf, qf[ks], x); }
#pragma unroll
            for (int q4 = 0; q4 < 4; ++q4) {
                float pv[4];
#pragma unroll
                for (int e = 0; e < 4; ++e) { const int jp = 32 * kt + e + 8 * q4 + 4 * hh; const int df = ip - jp;
                    const float f0 = (df >= 0) ? __builtin_amdgcn_exp2f(l2g0 * (float)df) : 0.f, f1 = (df <= 0) ? __builtin_amdgcn_exp2f(l2g1 * (float)(-df)) : 0.f;
                    pv[e] = x[4 * q4 + e] * (f0 + f1); }
                v2u pw; pw.x = cvt_pk_bf16(pv[0], pv[1]); pw.y = cvt_pk_bf16(pv[2], pv[3]);
                *(LAS v2u*)(Pl + (qi * 32 + li) * PLD + (kt * 32 + 8 * q4 + 4 * hh) * 2) = pw;
            }
        }
        LDS_WAIT(); __syncthreads();
        const float e0 = l2g0 * (float)(ip + 1), e1 = l2g1 * (float)(128 - ip);
        const float ratio = __builtin_amdgcn_exp2f(e0 - e1), xi1 = __builtin_amdgcn_exp2f(e1);
        f32x16 o[4]; float s1 = 0.f, s2 = 0.f;
#pragma unroll
        for (int dt = 0; dt < 4; ++dt) {
            const int dvr = 128 * dj + 32 * dt + li;
            const bf16* srow = SB + (((size_t)((seq * 4 + h) * 32 + n) * 8 + 4 * dj + dt) * 2) * 8 * 512 + lane * 8;
            const bf16* vrow = RVT + ((size_t)(h * 8 + 4 * dj + dt) * (T / 16) + (tok0 >> 4)) * 512 + lane * 8;
            f32x16 acc;
#pragma unroll
            for (int e = 0; e < 16; ++e) acc[e] = 0.f;
            bf16x8 s0f[8], s1f[8], vff[8];
#pragma unroll
            for (int ks = 0; ks < 8; ++ks) { s0f[ks] = *(const bf16x8*)(srow + 512 * ks); s1f[ks] = *(const bf16x8*)(srow + 4096 + 512 * ks); vff[ks] = *(const bf16x8*)(vrow + 512 * ks); }
            asm volatile("" ::: "memory");
#pragma unroll
            for (int ks = 0; ks < 8; ++ks) acc = MFMA32(s0f[ks], qf[ks], acc);
#pragma unroll
            for (int e = 0; e < 16; ++e) acc[e] *= ratio;
#pragma unroll
            for (int ks = 0; ks < 8; ++ks) acc = MFMA32(s1f[ks], qf[ks], acc);
#pragma unroll
            for (int e = 0; e < 16; ++e) acc[e] *= xi1;
#pragma unroll
            for (int ks = 0; ks < 8; ++ks) { const bf16x8 pf = *(const LAS bf16x8*)(Pl + (qi * 32 + li) * PLD + (16 * ks + 8 * hh) * 2); acc = MFMA32(vff[ks], pf, acc); }
#pragma unroll
            for (int e = 0; e < 16; ++e) { s1 += acc[e]; s2 += acc[e] * acc[e]; }
            o[dt] = acc;
        }
        s1 += shfl_xor_(s1, 32); s2 += shfl_xor_(s2, 32);
        if (hh == 0) SX[(dj * 4 + qi) * 32 + li] = (f32x2){s1, s2};
        LDS_WAIT(); __syncthreads();
        { const f32x2 ot = SX[((dj ^ 1) * 4 + qi) * 32 + li]; s1 += ot.x; s2 += ot.y; }
        const float mu = s1 * (1.0f / 256.0f); const float var = fmaxf(s2 * (1.0f / 256.0f) - mu * mu, 0.f); const float rstd = 1.0f / sqrtf(var + 1e-5f);
#pragma unroll
        for (int dt = 0; dt < 4; ++dt)
#pragma unroll
            for (int q4 = 0; q4 < 4; ++q4) { v2u pw; pw.x = cvt_pk_bf16((o[dt][4 * q4] - mu) * rstd, (o[dt][4 * q4 + 1] - mu) * rstd); pw.y = cvt_pk_bf16((o[dt][4 * q4 + 2] - mu) * rstd, (o[dt][4 * q4 + 3] - mu) * rstd);
                *(LAS v2u*)(stg + li * PLD + (32 * dt + 8 * q4 + 4 * hh) * 2) = pw; }
        LDS_WAIT(); asm volatile("" ::: "memory");
#pragma unroll
        for (int j = 0; j < 8; ++j) {
            const int idx = lane + 64 * j, q = idx >> 4, cv = idx & 15, col = h * 256 + 128 * dj + 8 * cv;
            const v4u ov = *(const LAS v4u*)(stg + q * PLD + cv * 16);
            const size_t tok = tok0 + 32 * qi + q;
            const v4u gv = *(const v4u*)(RG + tok * 1024 + col);
            const f32x4 r0 = *(const f32x4*)(rn + col), r1 = *(const f32x4*)(rn + col + 4);
            const float rr[8] = {r0.x, r0.y, r0.z, r0.w, r1.x, r1.y, r1.z, r1.w};
            v4u wv;
#pragma unroll
            for (int q2 = 0; q2 < 4; ++q2) { const float ga = bf_lo(gv[q2]), gb = bf_hi(gv[q2]);
                wv[q2] = pk2(ga * fsigmoid(ga) * bf_lo(ov[q2]) * rr[2 * q2], gb * fsigmoid(gb) * bf_hi(ov[q2]) * rr[2 * q2 + 1]); }
            *(v4u*)(YB + tok * 1024 + col) = wv;
        }
    }
    __syncthreads();
}
__device__ __forceinline__ void phase_zero(const Frame& F, void* p, size_t bytes) {
    v4u* q = (v4u*)p; const v4u z = {0u, 0u, 0u, 0u};
    for (size_t i = (size_t)F.bid * NTHR + F.tid; i < bytes / 16; i += (size_t)F.G * NTHR) q[i] = z;
}

__global__ void __launch_bounds__(NTHR, 2) mk_fwd(Args args) {
    extern __shared__ __attribute__((aligned(16))) unsigned char lds[];
    {
        const int t0 = threadIdx.x;
        for (int u = t0; u < (LDS_BYTES - LDSCTL_OFF) / 4; u += NTHR) ((LAS unsigned*)((LAS unsigned char*)lds + LDSCTL_OFF))[u] = 0u;
        __syncthreads();
    }
    XcdBarrier bar; bar.bar = (unsigned*)(args.ws + WS_CTL) + CW_BAR; bar.x = 0; bar.st = nullptr;
#if !MK_PER_PHASE_LAUNCH
    bar = xcd_barrier_post((unsigned*)(args.ws + WS_CTL) + CW_BAR, (volatile LAS unsigned*)((LAS unsigned char*)lds + MISC_OFF) + 8);
#endif
    const int wave_s = __builtin_amdgcn_readfirstlane((int)(threadIdx.x >> 6));
    const int lo = args.ph_lo, hi = args.ph_hi;
    int pc = 0;
#define PH_ON (pc >= lo && pc < hi)
#if MK_PER_PHASE_LAUNCH
#define PH_END do { ++pc; } while (0)
#else
#ifdef MK_NOBAR
#define PH_END do { __syncthreads(); ++pc; } while (0)
#else
#define PH_END do { if (pc >= lo && pc + 1 < hi) xcd_barrier(bar, wave_s == 0 && lane_id() == 0); ++pc; } while (0)
#endif
#endif
#define PH_REP(k) _Pragma("nounroll") for (int rep_ = 0; rep_ < (((MK_REPMASK) >> (k)) & 1) + 1; ++rep_)
#define PH_REPBAR(k) if ((((MK_REPMASK) >> (k)) & 1) && rep_ == 0) xcd_barrier(bar, wave_s == 0 && lane_id() == 0)
#define WTH wt
#define PH_FRAME Frame F; int z_; asm volatile("s_mov_b32 %0, 0" : "=s"(z_)); { int t_ = wave_s * 64 + lane_id(); asm volatile("" : "+v"(t_)); unsigned char* w_ = (unsigned char*)(GAS unsigned char*)ld_karg64(248); F.lds = (LAS unsigned char*)lds; F.ws = w_; F.z = z_; F.tid = t_; F.lane = t_ & 63; \
        F.wave = __builtin_amdgcn_readfirstlane(t_ >> 6); { int g_ = __builtin_amdgcn_readfirstlane((int)gridDim.x), b_ = __builtin_amdgcn_readfirstlane((int)blockIdx.x), g2_, b2_; asm volatile("s_mov_b32 %0, %2\n\ts_mov_b32 %1, %3" : "=&s"(g2_), "=&s"(b2_) : "s"(g_), "s"(b_)); F.G = g2_; F.bid = b2_; } F.gw = F.bid * NWAVES + F.wave; F.NGW = F.G * NWAVES; } \
        unsigned char* const wt = F.ws + WS_WT; unsigned char* const ar = F.ws + WS_AR; bf16* const XN = (bf16*)(F.ws + WS_XN); LAS unsigned char* const ring = F.lds + RING_OFF; \
        bf16* X = (bf16*)((GAS unsigned char*)ld_karg64(240) + XB_OFF); const int c = F.bid; (void)wt; (void)ar; (void)XN; (void)ring; (void)c;

#pragma nounroll
    for (int l = 0; l < DEPTH; ++l) {
        const bool ovl = gridDim.x > 160;
        if (l == 0 || !ovl) {
            if (PH_ON) { PH_FRAME; phase_wconv(F, args, l, wt, wt, ovl ? 1 : 3);
                if (l == 0) phase_norm_in(F, args.in[z_ + 0], args.in[z_ + 1], args.in[z_ + 2], XN, X); }
            PH_END;
        }
#pragma nounroll
        for (int f = 0; f < 2; ++f) {
            if (!(l == 0 && f == 0)) {
                if (PH_ON) { PH_FRAME; phase_norm(F, X, args.in[z_ + (f ? 25 : 2)] + (size_t)l * D, XN); }
                PH_END;
            }
#pragma nounroll
            for (int ck = 0; ck < FFN_NCK; ++ck) {
                const int r0 = ck * FFN_MC, mc = (T - r0 < FFN_MC) ? (T - r0) : FFN_MC;
                PH_REP(0) { if (PH_ON) { PH_FRAME;
                    SchedPlain S{(const char*)(XN + (size_t)r0 * D), (const char*)(f ? WTH + WO_UP2 : wt + WO_UP1), D, D, D, mc / 256, 44, F.G, c, 8};
                    EpiSwiglu E{(bf16*)(ar + AR_H)};
                    pg8::gemm_phase<EpiSwiglu, SchedPlain>(ring, S, E, F.tid);
                } PH_REPBAR(0); }
                PH_END;
                if (PH_ON) { PH_FRAME;
                    SchedPlain S{(const char*)(ar + AR_H), (const char*)(f ? WTH + WO_DN2 : wt + WO_DN1), FF, FF, FF, mc / 256, 8, F.G, c, MK_WGM_DN};
                    { const bool lastf = (l == DEPTH - 1 && f == 1);
                        EpiResid E{(lastf ? (bf16*)(ar + AR_XF) : X) + (size_t)r0 * D, X + (size_t)r0 * D, 0.5f};
                    pg8::gemm_phase<EpiResid, SchedPlain>(ring, S, E, F.tid); }
                }
                PH_END;
            }
            if (f == 0) {
                if (PH_ON) { PH_FRAME; phase_norm(F, X, args.in[z_ + 6] + (size_t)l * D, XN); }
                PH_END;
#if (MK_MIXER & 1)
                PH_REP(1) { if (PH_ON) { PH_FRAME;
                    SchedCF S{SchedPlain{(const char*)XN, (const char*)(WTH + WO_CF), D, D, D, 160, 8, F.G, c, 8}, (char*)(ar + AR_CF)};
                    EpiStore<1> E{nullptr, nullptr, nullptr};
                    pg8::gemm_phase<EpiStore<1>, SchedCF>(ring, S, E, F.tid);
                } PH_REPBAR(1); }
                PH_END;
                if (PH_ON) { PH_FRAME; phase_rwkv_pre(F, args, l); }
                PH_END;
                if (PH_ON) { PH_FRAME;
                    SchedLR S{SchedPlain{(const char*)(ar + AR_LR), (const char*)(WTH + WO_LR), 384, 384, 384, 160, 10, F.G, c, 8}, (char*)(ar + AR_EA), (char*)(ar + AR_GT)};
                    EpiStore<0x70> E{args.in[z_ + 11] + (size_t)l * 1024, args.in[z_ + 13] + (size_t)l * 1024, nullptr};
                    pg8::gemm_phase<EpiStore<0x70>, SchedLR>(ring, S, E, F.tid);
                }
                PH_END;
#if MK_CHUNKED && MK_FUSED_RWKV
                if (PH_ON) { PH_FRAME; phase_rwkv_fused(F, args, l);
                    if (F.bid >= 160) {
                        Frame F2 = F; F2.bid = F.bid - 160; F2.G = F.G - 160; F2.gw = F2.bid * NWAVES + F.wave; F2.NGW = F2.G * NWAVES;
                        phase_wconv(F2, args, l, wt, wt, 2);
                        if (l + 1 < DEPTH) phase_wconv(F2, args, l + 1, wt, wt, 1); } }
                PH_END;
#elif MK_CHUNKED
#pragma nounroll
                for (int seg = 0; seg < RW_NSEG; ++seg) {
                    if (PH_ON) { PH_FRAME; phase_rwkv_prep(F, args, l, seg); }
                    PH_END;
                    if (PH_ON) { PH_FRAME; phase_rwkv_cscan(F, seg); }
                    PH_END;
                }
#else
                if (PH_ON) { PH_FRAME; phase_rwkv_scan(F, args, l); }
                PH_END;
#endif
                if (PH_ON) { PH_FRAME; phase_rwkv_post(F, args, l); }
                PH_END;
#else
                if (PH_ON) { PH_FRAME; phase_zero(F, ar + AR_YC, (size_t)T * 512 * 2); }
                PH_END;
#endif
#if (MK_MIXER & 2)
                PH_REP(2) { if (PH_ON) { PH_FRAME;
                    SchedAtt S{(const char*)XN, (const char*)WTH, (char*)ar, F.G, c};
                    EpiStore<0x384> E{nullptr, nullptr, args.in[z_ + 8] + (size_t)l * 8};
                    pg8::gemm_phase<EpiStore<0x384>, SchedAtt>(ring, S, E, F.tid);
                } PH_REPBAR(2); }
                PH_END;
                if (PH_ON) { PH_FRAME; phase_attn(F, args); }
                PH_END;
#if !(MK_MIXER & 4)
                if (PH_ON) { PH_FRAME; phase_attn_post(F, args); }
                PH_END;
#endif
#else
                if (PH_ON) { PH_FRAME; phase_zero(F, ar + AR_YA, (size_t)T * 512 * 2); }
                PH_END;
#endif
#if (MK_MIXER & 4)
                PH_REP(3) { if (PH_ON) { PH_FRAME;
#if (MK_MIXER & 2)
                    if (rep_ == 0) phase_attn_post(F, args);
                    __syncthreads();
#endif
                    SchedRet S{(const char*)XN, (const char*)(WTH + WO_RET), (char*)ar, F.G, c};
                    EpiStore<0x401> E{nullptr, nullptr, nullptr};
                    pg8::gemm_phase<EpiStore<0x401>, SchedRet>(ring, S, E, F.tid);
                } PH_REPBAR(3); }
                PH_END;
                if (PH_ON) { PH_FRAME; phase_ret_state(F, args, l); }
                PH_END;
                if (PH_ON) { PH_FRAME; phase_ret_out(F, args, l); }
                PH_END;
#else
                if (PH_ON) { PH_FRAME; phase_zero(F, ar + AR_YB, (size_t)T * 1024 * 2); }
                PH_END;
#endif
                PH_REP(4) { if (PH_ON) { PH_FRAME;
                    SchedMerge S{(const char*)XN, (const char*)ar, (const char*)WTH, F.G, c};
                    v4u* scr = (v4u*)(ar + AR_SCR) + (size_t)F.bid * 2 * 16 * NTHR;
                    EpiMerge E{scr, scr + 16 * NTHR, (bf16*)(ar + AR_MG)};
                    pg8::gemm_phase<EpiMerge, SchedMerge>(ring, S, E, F.tid);
                } PH_REPBAR(4); }
                PH_END;
                if (PH_ON) { PH_FRAME;
                    SchedPlain S{(const char*)(ar + AR_MG), (const char*)(WTH + WO_OUT), D, D, D, 160, 8, F.G, c, 8};
                    { EpiResid E{X, X, 1.0f};
                    pg8::gemm_phase<EpiResid, SchedPlain>(ring, S, E, F.tid); }
                }
                PH_END;
            }
        }
    }
    if (PH_ON) { PH_FRAME; phase_final_norm(F, (const bf16*)(ar + AR_XF), args.in[z_ + 29], (float*)(GAS float*)ld_karg64(240)); }
    ++pc;
#undef PH_ON
#undef PH_END
#undef PH_FRAME
}

extern "C" void kernel_launch(void* const* d_in, const int* in_sizes, int n_in, void* d_out, int out_size, void* d_ws, size_t ws_size, hipStream_t stream) {
    static int grid = 0;
    if (grid == 0) {
        if (n_in != 30 || out_size != T * D || ws_size < WS_END) { fprintf(stderr, "kernel_launch: unexpected shapes (n_in %d, out %d, ws %zu < %zu); nothing launched\n", n_in, out_size, ws_size, (size_t)WS_END); grid = -1; return; }
        int dev = 0, cus = 0, per_cu = 0;
        if (hipGetDevice(&dev) != hipSuccess || hipDeviceGetAttribute(&cus, hipDeviceAttributeMultiprocessorCount, dev) != hipSuccess) { grid = -1; return; }
        if (hipFuncSetAttribute((const void*)mk_fwd, hipFuncAttributeMaxDynamicSharedMemorySize, LDS_BYTES) != hipSuccess) { fprintf(stderr, "kernel_launch: hipFuncSetAttribute failed\n"); grid = -1; return; }
        if (hipOccupancyMaxActiveBlocksPerMultiprocessor(&per_cu, (const void*)mk_fwd, NTHR, LDS_BYTES) != hipSuccess || per_cu < 1) { fprintf(stderr, "kernel_launch: occupancy query reports %d\n", per_cu); }
        (void)hipGetLastError();
        grid = cus;
#ifdef MK_GRID
        grid = MK_GRID;
#endif
    }
    if (grid < 0) return;
    hipMemsetAsync((char*)d_ws + WS_CTL, 0, CTL_ZERO_BYTES, stream);
    Args a{};
    for (int i = 0; i < 30; ++i) a.in[i] = (const float*)d_in[i];
    a.out = (float*)d_out; a.ws = (unsigned char*)d_ws;
#if MK_PER_PHASE_LAUNCH
#ifndef MK_NPH
#define MK_NPH 2
#endif
    for (int p = 0; p < MK_NPH; ++p) {    a.ph_lo = p; a.ph_hi = p + 1; hipLaunchKernelGGL(mk_fwd, dim3(grid), dim3(NTHR), LDS_BYTES, stream, a); }
#else
#ifdef MK_NPH1
    a.ph_lo = 0; a.ph_hi = MK_NPH1;
#else
    a.ph_lo = 0; a.ph_hi = 1 << 30;
#endif
    hipLaunchKernelGGL(mk_fwd, dim3(grid), dim3(NTHR), LDS_BYTES, stream, a);
#endif
}
```
